# Optimizing an MI355X kernel written in HIP

```python
import jax
import jax.numpy as jnp
from jax import lax
import numpy as np

D_MODEL = 1024
BATCH = 2
SEQ = 8192
DEPTH = 2

HEAD_DIM = 64
N_MIXERS = 4
HEADS_PER_MIXER = D_MODEL // (N_MIXERS * HEAD_DIM)
GROUP_WIDTH = HEADS_PER_MIXER * HEAD_DIM
MIX_WIDTH = N_MIXERS * GROUP_WIDTH
BLOCK = 128
NORM_EPS = 1e-6
MLA_Q_RANK = 192
MLA_KV_RANK = 128
MLA_NOPE = 32
MLA_ROPE = 32
MLA_V = HEAD_DIM
ROPE_BASE = 10000.0
DILATED_PAIRS = ((128, 1), (512, 4), (2048, 16))
DIL_ALIGN = BLOCK * 16
SWA_WINDOW = 128
SWA_KV_HEADS = 2
SWA_GROUP = HEADS_PER_MIXER // SWA_KV_HEADS
N_GROUPS = 4
EXPERTS_PER_GROUP = 8
N_EXPERTS = N_GROUPS * EXPERTS_PER_GROUP
TOP_K = 2
D_EXPERT = 256
EXPERT_BLOCK = 128
IN_SPLITS = (MLA_Q_RANK, MLA_KV_RANK, MLA_ROPE, 3 * GROUP_WIDTH, 3 * GROUP_WIDTH, HEADS_PER_MIXER, GROUP_WIDTH, 2 * SWA_KV_HEADS * HEAD_DIM)
IN_WIDTH = sum(IN_SPLITS)

kernel_name = 'hybrid_headgroup_mla_dilated_fox_swa_hmoe'


def rmsnorm(x, g):
    xf = x.astype(jnp.float32)
    y = xf * lax.rsqrt(jnp.mean(xf * xf, axis=-1, keepdims=True) + NORM_EPS)
    return (y * g.astype(jnp.float32)).astype(x.dtype)


def rope(x):
    S, dr = x.shape[1], x.shape[-1]
    inv = ROPE_BASE ** (-jnp.arange(0, dr, 2, dtype=jnp.float32) / dr)
    ang = jnp.arange(S, dtype=jnp.float32)[:, None] * inv[None, :]
    cos = jnp.cos(ang)[None, :, None, :]
    sin = jnp.sin(ang)[None, :, None, :]
    xf = x.astype(jnp.float32)
    x1, x2 = xf[..., : dr // 2], xf[..., dr // 2:]
    return jnp.concatenate([x1 * cos - x2 * sin, x2 * cos + x1 * sin], axis=-1).astype(x.dtype)


def alibi_slopes():
    n = 2 * HEADS_PER_MIXER
    s = 2.0 ** (-8.0 * jnp.arange(1, n + 1, dtype=jnp.float32) / n)
    return s[HEADS_PER_MIXER:], s[:HEADS_PER_MIXER]


def banded_attention(q, k, v, max_dist, unit, slopes, sink=None):
    b, L, hk, g, dh = q.shape
    nb = L // BLOCK
    qb = q.reshape(b, nb, BLOCK, hk, g, dh)

    def band(t):
        t = t.reshape(b, nb, BLOCK, hk, dh)
        prev = jnp.concatenate([jnp.zeros_like(t[:, :1]), t[:, :-1]], axis=1)
        return jnp.concatenate([prev, t], axis=2)

    kc, vc = band(k), band(v)
    s = jnp.einsum('bnqhgd,bnkhd->bnhgqk', qb, kc).astype(jnp.float32) * (dh ** -0.5)
    dist = jnp.arange(BLOCK)[:, None] + BLOCK - jnp.arange(2 * BLOCK)[None, :]
    kpos = jnp.arange(nb)[:, None] * BLOCK + jnp.arange(2 * BLOCK)[None, :] - BLOCK
    valid = ((dist >= 0) & (dist <= max_dist))[None] & (kpos >= 0)[:, None, :]
    s = s - slopes[:, :, None, None] * (dist * unit).astype(jnp.float32)
    s = jnp.where(valid[None, :, None, None], s, -jnp.inf)
    lse = jax.nn.logsumexp(s, axis=-1)
    if sink is not None:
        lse = jnp.logaddexp(lse, sink.astype(jnp.float32)[:, :, None])
    p = jnp.exp(s - lse[..., None]).astype(v.dtype)
    out = jnp.einsum('bnhgqk,bnkhd->bnqhgd', p, vc).reshape(b, L, hk, g, dh)
    lse = jnp.moveaxis(lse, -1, 2).reshape(b, L, hk, g)
    return out, lse


def causal_block_attention(q, k, v, cum=None):
    b, S, h, dk = q.shape
    nb = S // BLOCK
    kpos = jnp.arange(S)
    cum_t = None if cum is None else jnp.swapaxes(cum, 1, 2)

    def one_block(n):
        start = n * BLOCK
        qblk = lax.dynamic_slice_in_dim(q, start, BLOCK, axis=1)
        s = jnp.einsum('bqhd,bkhd->bhqk', qblk, k).astype(jnp.float32) * (dk ** -0.5)
        if cum_t is not None:
            cq = lax.dynamic_slice_in_dim(cum_t, start, BLOCK, axis=2)
            s = s + cq[..., None] - cum_t[:, :, None, :]
        qpos = start + jnp.arange(BLOCK)
        s = jnp.where(kpos[None, :] <= qpos[:, None], s, -jnp.inf)
        p = jax.nn.softmax(s, axis=-1).astype(v.dtype)
        return jnp.einsum('bhqk,bkhd->bqhd', p, v)

    out = lax.map(one_block, jnp.arange(nb))
    return jnp.moveaxis(out, 0, 1).reshape(b, S, h, v.shape[-1])


def dilated_attention(q, k, v, slopes):
    b, S, h, dh = q.shape
    Sp = -(-S // DIL_ALIGN) * DIL_ALIGN
    pad = ((0, 0), (0, Sp - S), (0, 0), (0, 0))
    q, k, v = (jnp.pad(t, pad) for t in (q, k, v))
    outs, lses = [], []
    for window, dil in DILATED_PAIRS:
        L = Sp // dil

        def fold(t):
            return t.reshape(b, L, dil, h, dh).transpose(0, 2, 1, 3, 4).reshape(b * dil, L, h, dh)

        o, lse = banded_attention(fold(q)[:, :, :, None], fold(k), fold(v), window // dil, dil, slopes[:, None])
        outs.append(o[:, :, :, 0].reshape(b, dil, L, h, dh).transpose(0, 2, 1, 3, 4).reshape(b, Sp, h, dh))
        lses.append(lse[..., 0].reshape(b, dil, L, h).transpose(0, 2, 1, 3).reshape(b, Sp, h))
    w = jax.nn.softmax(jnp.stack(lses), axis=0).astype(q.dtype)
    out = jnp.einsum('nbsh,nbshd->bshd', w, jnp.stack(outs))
    return out[:, :S]


def hierarchical_moe(xn, w_rg, b_rg, w_re, b_re, w1, w3, w2):
    b, S, d = xn.shape
    xt = xn.reshape(-1, d)
    T = xt.shape[0]
    g_prob = jax.nn.softmax((xt @ w_rg).astype(jnp.float32) + b_rg.astype(jnp.float32), axis=-1)
    g_sel = jnp.argmax(g_prob, axis=-1)
    p_g = jnp.max(g_prob, axis=-1)
    e_logit = ((xt @ w_re).astype(jnp.float32) + b_re.astype(jnp.float32)).reshape(T, N_GROUPS, EXPERTS_PER_GROUP)
    e_logit = jnp.take_along_axis(e_logit, g_sel[:, None, None], axis=1)[:, 0]
    top_p, top_i = lax.top_k(jax.nn.softmax(e_logit, axis=-1), TOP_K)
    gate = p_g[:, None] * top_p / jnp.sum(top_p, axis=-1, keepdims=True)
    expert = g_sel[:, None] * EXPERTS_PER_GROUP + top_i

    A = T * TOP_K
    flat_e = expert.reshape(-1)
    flat_tok = jnp.repeat(jnp.arange(T), TOP_K)
    flat_gate = gate.reshape(-1)
    order = jnp.argsort(flat_e)
    se = flat_e[order]
    counts = jnp.bincount(flat_e, length=N_EXPERTS)
    start = jnp.cumsum(counts) - counts
    padded = (counts + EXPERT_BLOCK - 1) // EXPERT_BLOCK * EXPERT_BLOCK
    pend = jnp.cumsum(padded)
    pstart = pend - padded
    dest = pstart[se] + jnp.arange(A) - start[se]
    nblk = -(-A // EXPERT_BLOCK) + N_EXPERTS
    P = nblk * EXPERT_BLOCK
    buf_tok = jnp.zeros((P,), jnp.int32).at[dest].set(flat_tok[order])
    buf_gate = jnp.zeros((P,), jnp.float32).at[dest].set(flat_gate[order])
    blk_e = jnp.minimum(jnp.searchsorted(pend, jnp.arange(nblk) * EXPERT_BLOCK, side='right'), N_EXPERTS - 1)
    xbuf = xt[buf_tok].reshape(nblk, EXPERT_BLOCK, d)

    def expert_block(args):
        xb, e = args
        hid = jax.nn.silu(xb @ w1[e]) * (xb @ w3[e])
        return hid @ w2[e]

    ybuf = lax.map(expert_block, (xbuf, blk_e)).reshape(P, d)
    y = jnp.zeros((T, d), xn.dtype).at[buf_tok].add(ybuf * buf_gate[:, None].astype(ybuf.dtype))
    return y.reshape(b, S, d)


def hybrid_layer(x, norm1_g, w_in, mla_gcq, mla_gckv, mla_wuq, mla_wukv, qk_gq, qk_gk, fox_bf, sink, w_o,
                 norm2_g, w_rg, b_rg, w_re, b_re, w1, w3, w2):
    b, S, _ = x.shape
    H, hd = HEADS_PER_MIXER, HEAD_DIM
    slopes_dil, slopes_swa = alibi_slopes()
    u = rmsnorm(x, norm1_g)
    proj = u @ w_in
    offs = [int(o) for o in np.cumsum(IN_SPLITS)[:-1]]
    cq, ckv, kr, pb, pc, fg, pdq, pdkv = jnp.split(proj, offs, axis=-1)

    qa = (rmsnorm(cq, mla_gcq) @ mla_wuq).reshape(b, S, H, MLA_NOPE + MLA_ROPE)
    kva = (rmsnorm(ckv, mla_gckv) @ mla_wukv).reshape(b, S, H, MLA_NOPE + MLA_V)
    ka = jnp.concatenate([kva[..., :MLA_NOPE], jnp.broadcast_to(kr[:, :, None, :], (b, S, H, MLA_ROPE))], axis=-1)
    va = kva[..., MLA_NOPE:]
    qa = rmsnorm(qa, qk_gq[0])
    ka = rmsnorm(ka, qk_gk[0])
    qa = jnp.concatenate([qa[..., :MLA_NOPE], rope(qa[..., MLA_NOPE:])], axis=-1)
    ka = jnp.concatenate([ka[..., :MLA_NOPE], rope(ka[..., MLA_NOPE:])], axis=-1)
    oa = causal_block_attention(qa, ka, va)

    pb = pb.reshape(b, S, 3, H, hd)
    ob = dilated_attention(rmsnorm(pb[:, :, 0], qk_gq[1]), rmsnorm(pb[:, :, 1], qk_gk[1]), pb[:, :, 2], slopes_dil)

    pc = pc.reshape(b, S, 3, H, hd)
    cum = jnp.cumsum(jax.nn.log_sigmoid(fg.astype(jnp.float32) + fox_bf.astype(jnp.float32)), axis=1)
    oc = causal_block_attention(rmsnorm(pc[:, :, 0], qk_gq[2]), rmsnorm(pc[:, :, 1], qk_gk[2]), pc[:, :, 2], cum)

    qd = rmsnorm(pdq.reshape(b, S, SWA_KV_HEADS, SWA_GROUP, hd), qk_gq[3])
    pdkv = pdkv.reshape(b, S, 2, SWA_KV_HEADS, hd)
    od, _ = banded_attention(qd, rmsnorm(pdkv[:, :, 0], qk_gk[3]), pdkv[:, :, 1], SWA_WINDOW - 1, 1,
                             slopes_swa.reshape(SWA_KV_HEADS, SWA_GROUP), sink.reshape(SWA_KV_HEADS, SWA_GROUP))

    mix = jnp.concatenate([oa.reshape(b, S, GROUP_WIDTH), ob.reshape(b, S, GROUP_WIDTH),
                           oc.reshape(b, S, GROUP_WIDTH), od.reshape(b, S, GROUP_WIDTH)], axis=-1)
    h = x + mix @ w_o
    return h + hierarchical_moe(rmsnorm(h, norm2_g), w_rg, b_rg, w_re, b_re, w1, w3, w2)


def setup_inputs(seed: int = 0) -> dict:
    key = jax.random.key(seed)
    ks = jax.random.split(key, 20)

    def nrm(k, shape, scale):
        return jax.random.normal(k, shape, jnp.float32) * scale

    def gain(k, shape):
        return 1.0 + 0.02 * jax.random.normal(k, shape, jnp.float32)

    H = HEADS_PER_MIXER
    return {
        'x': nrm(ks[0], (BATCH, SEQ, D_MODEL), 1.0),
        'norm1_g': gain(ks[1], (DEPTH, D_MODEL)),
        'w_in': nrm(ks[2], (DEPTH, D_MODEL, IN_WIDTH), D_MODEL ** -0.5),
        'mla_gcq': gain(ks[3], (DEPTH, MLA_Q_RANK)),
        'mla_gckv': gain(ks[4], (DEPTH, MLA_KV_RANK)),
        'mla_wuq': nrm(ks[5], (DEPTH, MLA_Q_RANK, H * (MLA_NOPE + MLA_ROPE)), MLA_Q_RANK ** -0.5),
        'mla_wukv': nrm(ks[6], (DEPTH, MLA_KV_RANK, H * (MLA_NOPE + MLA_V)), MLA_KV_RANK ** -0.5),
        'qk_gq': gain(ks[7], (DEPTH, N_MIXERS, HEAD_DIM)),
        'qk_gk': gain(ks[8], (DEPTH, N_MIXERS, HEAD_DIM)),
        'fox_bf': 2.0 + 0.5 * jax.random.normal(ks[9], (DEPTH, H), jnp.float32),
        'sink': nrm(ks[10], (DEPTH, H), 0.5),
        'w_o': nrm(ks[11], (DEPTH, MIX_WIDTH, D_MODEL), 0.5 * MIX_WIDTH ** -0.5),
        'norm2_g': gain(ks[12], (DEPTH, D_MODEL)),
        'w_rg': nrm(ks[13], (DEPTH, D_MODEL, N_GROUPS), D_MODEL ** -0.5),
        'b_rg': nrm(ks[14], (DEPTH, N_GROUPS), 0.01),
        'w_re': nrm(ks[15], (DEPTH, D_MODEL, N_EXPERTS), D_MODEL ** -0.5),
        'b_re': nrm(ks[16], (DEPTH, N_EXPERTS), 0.01),
        'w1': nrm(ks[17], (DEPTH, N_EXPERTS, D_MODEL, D_EXPERT), D_MODEL ** -0.5),
        'w3': nrm(ks[18], (DEPTH, N_EXPERTS, D_MODEL, D_EXPERT), D_MODEL ** -0.5),
        'w2': nrm(ks[19], (DEPTH, N_EXPERTS, D_EXPERT, D_MODEL), D_EXPERT ** -0.5),
    }


def reference(x, norm1_g, w_in, mla_gcq, mla_gckv, mla_wuq, mla_wukv, qk_gq, qk_gk, fox_bf, sink, w_o,
              norm2_g, w_rg, b_rg, w_re, b_re, w1, w3, w2):
    for l in range(DEPTH):
        x = hybrid_layer(x, norm1_g[l], w_in[l], mla_gcq[l], mla_gckv[l], mla_wuq[l], mla_wukv[l], qk_gq[l],
                         qk_gk[l], fox_bf[l], sink[l], w_o[l], norm2_g[l], w_rg[l], b_rg[l], w_re[l], b_re[l],
                         w1[l], w3[l], w2[l])
    return x
```

```cpp
#include <hip/hip_runtime.h>
#include <stdint.h>
#include <math.h>

namespace {
constexpr int NB = 2, S = 8192, D = 1024, T = NB * S, NL = 2, NW = 2404;
constexpr int OFF_CQ = 0, OFF_CKV = 192, OFF_KR = 320, OFF_PB = 352, OFF_PC = 1120, OFF_FG = 1888, OFF_PDQ = 1892, OFF_PDKV = 2148;
constexpr float EPS = 1e-6f;

__device__ __forceinline__ float wave_sum(float v) {
#pragma unroll
  for (int o = 32; o; o >>= 1) v += __shfl_xor(v, o);
  return v;
}
__device__ __forceinline__ float wave_max(float v) {
#pragma unroll
  for (int o = 32; o; o >>= 1) v = fmaxf(v, __shfl_xor(v, o));
  return v;
}

__global__ void k_rmsnorm(const float* __restrict__ x, const float* __restrict__ g, float* __restrict__ y, int rows) {
  const int lane = threadIdx.x & 63, wpb = blockDim.x >> 6;
  for (int r = blockIdx.x * wpb + (threadIdx.x >> 6); r < rows; r += gridDim.x * wpb) {
    const float* xr = x + (size_t)r * D;
    float v[16], ss = 0.f;
#pragma unroll
    for (int j = 0; j < 16; ++j) { v[j] = xr[lane + 64 * j]; ss += v[j] * v[j]; }
    ss = wave_sum(ss);
    const float rstd = rsqrtf(ss * (1.f / D) + EPS);
#pragma unroll
    for (int j = 0; j < 16; ++j) y[(size_t)r * D + lane + 64 * j] = v[j] * rstd * g[lane + 64 * j];
  }
}

__global__ void __launch_bounds__(256) k_gemm(const float* __restrict__ A, const float* __restrict__ Bm, const float* R, float* C, int M, int N, int K) {
  __shared__ float As[16][65];
  __shared__ float Bs[16][64];
  const int tx = threadIdx.x & 15, ty = threadIdx.x >> 4;
  const int m0 = blockIdx.y * 64, n0 = blockIdx.x * 64;
  float acc[4][4];
#pragma unroll
  for (int i = 0; i < 4; ++i)
#pragma unroll
    for (int j = 0; j < 4; ++j) acc[i][j] = 0.f;
  for (int k0 = 0; k0 < K; k0 += 16) {
    for (int i = threadIdx.x; i < 1024; i += 256) { const int m = i >> 4, k = i & 15; As[k][m] = A[(size_t)(m0 + m) * K + k0 + k]; }
    for (int i = threadIdx.x; i < 1024; i += 256) { const int k = i >> 6, n = i & 63; Bs[k][n] = (n0 + n < N) ? Bm[(size_t)(k0 + k) * N + n0 + n] : 0.f; }
    __syncthreads();
#pragma unroll
    for (int k = 0; k < 16; ++k) {
      float a[4], b[4];
#pragma unroll
      for (int i = 0; i < 4; ++i) { a[i] = As[k][ty * 4 + i]; b[i] = Bs[k][tx * 4 + i]; }
#pragma unroll
      for (int i = 0; i < 4; ++i)
#pragma unroll
        for (int j = 0; j < 4; ++j) acc[i][j] += a[i] * b[j];
    }
    __syncthreads();
  }
#pragma unroll
  for (int i = 0; i < 4; ++i)
#pragma unroll
    for (int j = 0; j < 4; ++j) {
      const int m = m0 + ty * 4 + i, n = n0 + tx * 4 + j;
      if (n < N) { float v = acc[i][j]; if (R) v += R[(size_t)m * N + n]; C[(size_t)m * N + n] = v; }
    }
}

struct PostP {
  float* proj; const float* gcq; const float* gckv; const float* wuq; const float* wukv; const float* gq; const float* gk; const float* bf;
  float* QA; float* KA; float* VA; float* LF;
};
__device__ __forceinline__ float log_sigmoid(float x) { return fminf(x, 0.f) - log1pf(expf(-fabsf(x))); }

__global__ void __launch_bounds__(256) k_post(PostP p) {
  __shared__ float cqn[192], ckvn[128], kva[384], tmp[256], red[8];
  const int tid = threadIdx.x, lane = tid & 63, w = tid >> 6;
  for (int t = blockIdx.x; t < T; t += gridDim.x) {
    float* row = p.proj + (size_t)t * NW;
    const int pos = t % S;
    float vq = (tid < 192) ? row[OFF_CQ + tid] : 0.f;
    float vk = (tid < 128) ? row[OFF_CKV + tid] : 0.f;
    float sq = wave_sum(vq * vq), sk = wave_sum(vk * vk);
    if (lane == 0) { red[w] = sq; red[4 + w] = sk; }
    __syncthreads();
    const float rq = rsqrtf((red[0] + red[1] + red[2] + red[3]) * (1.f / 192.f) + EPS);
    const float rk = rsqrtf((red[4] + red[5] + red[6] + red[7]) * (1.f / 128.f) + EPS);
    if (tid < 192) cqn[tid] = vq * rq * p.gcq[tid];
    if (tid < 128) ckvn[tid] = vk * rk * p.gckv[tid];
    __syncthreads();
    float qa = 0.f;
    for (int i = 0; i < 192; ++i) qa += cqn[i] * p.wuq[i * 256 + tid];
    float k0 = 0.f, k1 = 0.f;
    for (int i = 0; i < 128; ++i) { k0 += ckvn[i] * p.wukv[i * 384 + tid]; if (tid < 128) k1 += ckvn[i] * p.wukv[i * 384 + 256 + tid]; }
    kva[tid] = k0; if (tid < 128) kva[256 + tid] = k1;
    {
      const float ss = wave_sum(qa * qa);
      qa = qa * rsqrtf(ss * (1.f / 64.f) + EPS) * p.gq[0 * 64 + lane];
    }
    tmp[tid] = qa;
    __syncthreads();
    {
      float o = qa;
      if (lane >= 32) {
        const int j = (lane - 32) & 15;
        const float inv = powf(10000.f, -(float)(2 * j) / 32.f);
        const float ang = (float)pos * inv, c = cosf(ang), s = sinf(ang);
        if (lane < 48) o = qa * c - tmp[tid + 16] * s; else o = qa * c + tmp[tid - 16] * s;
      }
      p.QA[(size_t)t * 256 + tid] = o;
    }
    float ka = (lane < 32) ? kva[w * 96 + lane] : row[OFF_KR + lane - 32];
    {
      const float ss = wave_sum(ka * ka);
      ka = ka * rsqrtf(ss * (1.f / 64.f) + EPS) * p.gk[0 * 64 + lane];
    }
    __syncthreads();
    tmp[tid] = ka;
    __syncthreads();
    {
      float o = ka;
      if (lane >= 32) {
        const int j = (lane - 32) & 15;
        const float inv = powf(10000.f, -(float)(2 * j) / 32.f);
        const float ang = (float)pos * inv, c = cosf(ang), s = sinf(ang);
        if (lane < 48) o = ka * c - tmp[tid + 16] * s; else o = ka * c + tmp[tid - 16] * s;
      }
      p.KA[(size_t)t * 256 + tid] = o;
    }
    p.VA[(size_t)t * 256 + tid] = kva[w * 96 + 32 + lane];
    for (int hh = w; hh < 22; hh += 4) {
      int col; const float* g;
      if (hh < 4) { col = OFF_PB + hh * 64; g = p.gq + 1 * 64; }
      else if (hh < 8) { col = OFF_PB + 256 + (hh - 4) * 64; g = p.gk + 1 * 64; }
      else if (hh < 12) { col = OFF_PC + (hh - 8) * 64; g = p.gq + 2 * 64; }
      else if (hh < 16) { col = OFF_PC + 256 + (hh - 12) * 64; g = p.gk + 2 * 64; }
      else if (hh < 20) { col = OFF_PDQ + (hh - 16) * 64; g = p.gq + 3 * 64; }
      else { col = OFF_PDKV + (hh - 20) * 64; g = p.gk + 3 * 64; }
      const float v = row[col + lane];
      const float ss = wave_sum(v * v);
      row[col + lane] = v * rsqrtf(ss * (1.f / 64.f) + EPS) * g[lane];
    }
    if (tid < 4) p.LF[(size_t)t * 4 + tid] = log_sigmoid(row[OFF_FG + tid] + p.bf[tid]);
    __syncthreads();
  }
}

__global__ void __launch_bounds__(256) k_cumsum(const float* __restrict__ LF, float* __restrict__ CUM) {
  __shared__ float part[256];
  const int b = blockIdx.x >> 2, h = blockIdx.x & 3, tid = threadIdx.x;
  const int per = S / 256;
  float s = 0.f;
  for (int i = 0; i < per; ++i) s += LF[((size_t)b * S + tid * per + i) * 4 + h];
  part[tid] = s;
  __syncthreads();
  if (tid == 0) { float a = 0.f; for (int i = 0; i < 256; ++i) { const float v = part[i]; part[i] = a; a += v; } }
  __syncthreads();
  float a = part[tid];
  for (int i = 0; i < per; ++i) { a += LF[((size_t)b * S + tid * per + i) * 4 + h]; CUM[((size_t)b * S + tid * per + i) * 4 + h] = a; }
}

struct AttP { const float* proj; const float* QA; const float* KA; const float* VA; const float* CUM; const float* sink; float* MIX; };

struct Soft { float m, l, o; };
__device__ __forceinline__ void soft_add(Soft& st, float logit, float v) {
  const float mn = fmaxf(st.m, logit);
  const float a = __expf(st.m - mn), pp = __expf(logit - mn);
  st.l = st.l * a + pp; st.o = st.o * a + pp * v; st.m = mn;
}

__global__ void __launch_bounds__(256) k_attn(AttP p) {
  const int lane = threadIdx.x & 63, wpb = blockDim.x >> 6;
  const long nitems = (long)T * 16;
  for (long it = (long)blockIdx.x * wpb + (threadIdx.x >> 6); it < nitems; it += (long)gridDim.x * wpb) {
    const int t = T - 1 - (int)(it >> 4), mh = (int)(it & 15), mixer = mh >> 2, h = mh & 3;
    const int b = t / S, pos = t % S; const long base = (long)b * S;
    Soft st; st.m = -INFINITY; st.l = 0.f; st.o = 0.f;
    if (mixer == 0) {
      const float q = p.QA[(size_t)t * 256 + h * 64 + lane] * 0.125f;
      for (int s = 0; s <= pos; ++s) {
        const float d = wave_sum(q * p.KA[(size_t)(base + s) * 256 + h * 64 + lane]);
        soft_add(st, d, p.VA[(size_t)(base + s) * 256 + h * 64 + lane]);
      }
    } else if (mixer == 2) {
      const float q = p.proj[(size_t)t * NW + OFF_PC + h * 64 + lane] * 0.125f;
      const float ct = p.CUM[(size_t)t * 4 + h];
      for (int s = 0; s <= pos; ++s) {
        const float* kr = p.proj + (size_t)(base + s) * NW + OFF_PC;
        const float d = wave_sum(q * kr[256 + h * 64 + lane]) + ct - p.CUM[(size_t)(base + s) * 4 + h];
        soft_add(st, d, kr[512 + h * 64 + lane]);
      }
    } else if (mixer == 3) {
      const int hk = h >> 1;
      const float q = p.proj[(size_t)t * NW + OFF_PDQ + h * 64 + lane] * 0.125f;
      const float slope = exp2f(-(float)(h + 1));
      const int s0 = pos - 127 < 0 ? 0 : pos - 127;
      for (int s = s0; s <= pos; ++s) {
        const float* kr = p.proj + (size_t)(base + s) * NW + OFF_PDKV;
        const float d = wave_sum(q * kr[hk * 64 + lane]) - slope * (float)(pos - s);
        soft_add(st, d, kr[128 + hk * 64 + lane]);
      }
      const float sk = p.sink[h];
      const float mn = fmaxf(st.m, sk), a = __expf(st.m - mn);
      st.l = st.l * a + __expf(sk - mn); st.o *= a; st.m = mn;
    } else {
      const float q = p.proj[(size_t)t * NW + OFF_PB + h * 64 + lane] * 0.125f;
      const float slope = exp2f(-(float)(h + 5));
      for (int br = 0; br < 3; ++br) {
        const int dil = br == 0 ? 1 : (br == 1 ? 4 : 16);
        for (int j = 0; j <= 128; ++j) {
          const int s = pos - dil * j;
          if (s < 0) break;
          const float* kr = p.proj + (size_t)(base + s) * NW + OFF_PB;
          const float d = wave_sum(q * kr[256 + h * 64 + lane]) - slope * (float)(dil * j);
          soft_add(st, d, kr[512 + h * 64 + lane]);
        }
      }
    }
    p.MIX[(size_t)t * D + mixer * 256 + h * 64 + lane] = st.o / st.l;
  }
}

struct RouteP { const float* h; const float* g2; const float* wrg; const float* brg; const float* wre; const float* bre; float* HN; int* EXP; float* GATE; };
__global__ void __launch_bounds__(256) k_route(RouteP p) {
  const int lane = threadIdx.x & 63, wpb = blockDim.x >> 6;
  for (int t = blockIdx.x * wpb + (threadIdx.x >> 6); t < T; t += gridDim.x * wpb) {
    const float* hr = p.h + (size_t)t * D;
    float v[16], ss = 0.f;
#pragma unroll
    for (int j = 0; j < 16; ++j) { v[j] = hr[lane + 64 * j]; ss += v[j] * v[j]; }
    ss = wave_sum(ss);
    const float rstd = rsqrtf(ss * (1.f / D) + EPS);
#pragma unroll
    for (int j = 0; j < 16; ++j) { v[j] = v[j] * rstd * p.g2[lane + 64 * j]; p.HN[(size_t)t * D + lane + 64 * j] = v[j]; }
    float gl[4];
#pragma unroll
    for (int g = 0; g < 4; ++g) {
      float a = 0.f;
#pragma unroll
      for (int j = 0; j < 16; ++j) a += v[j] * p.wrg[(size_t)(lane + 64 * j) * 4 + g];
      gl[g] = wave_sum(a) + p.brg[g];
    }
    int gs = 0; float gm = gl[0];
#pragma unroll
    for (int g = 1; g < 4; ++g) if (gl[g] > gm) { gm = gl[g]; gs = g; }
    float den = 0.f;
#pragma unroll
    for (int g = 0; g < 4; ++g) den += expf(gl[g] - gm);
    const float pg = 1.f / den;
    float el[8];
#pragma unroll
    for (int e = 0; e < 8; ++e) {
      float a = 0.f;
#pragma unroll
      for (int j = 0; j < 16; ++j) a += v[j] * p.wre[(size_t)(lane + 64 * j) * 32 + gs * 8 + e];
      el[e] = wave_sum(a) + p.bre[gs * 8 + e];
    }
    int i1 = 0; float m1 = el[0];
#pragma unroll
    for (int e = 1; e < 8; ++e) if (el[e] > m1) { m1 = el[e]; i1 = e; }
    int i2 = -1; float m2 = -INFINITY;
#pragma unroll
    for (int e = 0; e < 8; ++e) if (e != i1 && el[e] > m2) { m2 = el[e]; i2 = e; }
    const float e2 = expf(m2 - m1);
    const float w1 = 1.f / (1.f + e2), w2 = e2 / (1.f + e2);
    if (lane == 0) {
      p.EXP[t * 2] = gs * 8 + i1; p.EXP[t * 2 + 1] = gs * 8 + i2;
      p.GATE[t * 2] = pg * w1; p.GATE[t * 2 + 1] = pg * w2;
    }
  }
}

struct MoeP { const float* HN; const int* EXP; const float* GATE; const float* w1; const float* w3; const float* w2; float* hio; };
__global__ void __launch_bounds__(256) k_moe(MoeP p) {
  __shared__ float xs[D], hid[256];
  const int tid = threadIdx.x;
  for (int t = blockIdx.x; t < T; t += gridDim.x) {
    for (int i = tid; i < D; i += 256) xs[i] = p.HN[(size_t)t * D + i];
    __syncthreads();
    float y[4] = {0.f, 0.f, 0.f, 0.f};
    for (int k = 0; k < 2; ++k) {
      const int e = p.EXP[t * 2 + k]; const float gt = p.GATE[t * 2 + k];
      const float* W1 = p.w1 + (size_t)e * D * 256; const float* W3 = p.w3 + (size_t)e * D * 256; const float* W2 = p.w2 + (size_t)e * 256 * D;
      float a = 0.f, c = 0.f;
      for (int i = 0; i < D; ++i) { a += xs[i] * W1[(size_t)i * 256 + tid]; c += xs[i] * W3[(size_t)i * 256 + tid]; }
      const float sl = a / (1.f + expf(-a));
      hid[tid] = sl * c * gt;
      __syncthreads();
      for (int j = 0; j < 256; ++j) {
        const float hv = hid[j];
#pragma unroll
        for (int q = 0; q < 4; ++q) y[q] += hv * W2[(size_t)j * D + tid + 256 * q];
      }
      __syncthreads();
    }
#pragma unroll
    for (int q = 0; q < 4; ++q) p.hio[(size_t)t * D + tid + 256 * q] += y[q];
    __syncthreads();
  }
}
}

extern "C" void kernel_launch(void* const* d_in, const int* in_sizes, int n_in, void* d_out, int out_size, void* d_ws, size_t ws_size, hipStream_t stream) {
  const float* x = (const float*)d_in[0];
  const float* norm1_g = (const float*)d_in[1];
  const float* w_in = (const float*)d_in[2];
  const float* gcq = (const float*)d_in[3];
  const float* gckv = (const float*)d_in[4];
  const float* wuq = (const float*)d_in[5];
  const float* wukv = (const float*)d_in[6];
  const float* gq = (const float*)d_in[7];
  const float* gk = (const float*)d_in[8];
  const float* bf = (const float*)d_in[9];
  const float* sink = (const float*)d_in[10];
  const float* w_o = (const float*)d_in[11];
  const float* norm2_g = (const float*)d_in[12];
  const float* wrg = (const float*)d_in[13];
  const float* brg = (const float*)d_in[14];
  const float* wre = (const float*)d_in[15];
  const float* bre = (const float*)d_in[16];
  const float* w1 = (const float*)d_in[17];
  const float* w3 = (const float*)d_in[18];
  const float* w2 = (const float*)d_in[19];
  float* out = (float*)d_out;
  char* ws = (char*)d_ws;
  size_t off = 0;
  auto carve = [&](size_t bytes) { char* p = ws + off; off += (bytes + 255) & ~(size_t)255; return p; };
  float* U = (float*)carve((size_t)T * D * 4);
  float* PROJ = (float*)carve((size_t)T * NW * 4);
  float* QA = (float*)carve((size_t)T * 256 * 4);
  float* KA = (float*)carve((size_t)T * 256 * 4);
  float* VA = (float*)carve((size_t)T * 256 * 4);
  float* LF = (float*)carve((size_t)T * 4 * 4);
  float* CUM = (float*)carve((size_t)T * 4 * 4);
  int* EXPI = (int*)carve((size_t)T * 2 * 4);
  float* GATE = (float*)carve((size_t)T * 2 * 4);
  if (off > ws_size) return;
  for (int l = 0; l < NL; ++l) {
    const float* xin = (l == 0) ? x : out;
    k_rmsnorm<<<2048, 256, 0, stream>>>(xin, norm1_g + l * D, U, T);
    k_gemm<<<dim3((NW + 63) / 64, T / 64), 256, 0, stream>>>(U, w_in + (size_t)l * D * NW, nullptr, PROJ, T, NW, D);
    PostP pp{PROJ, gcq + l * 192, gckv + l * 128, wuq + (size_t)l * 192 * 256, wukv + (size_t)l * 128 * 384, gq + l * 256, gk + l * 256, bf + l * 4, QA, KA, VA, LF};
    k_post<<<4096, 256, 0, stream>>>(pp);
    k_cumsum<<<NB * 4, 256, 0, stream>>>(LF, CUM);
    AttP ap{PROJ, QA, KA, VA, CUM, sink + l * 4, U};
    k_attn<<<8192, 256, 0, stream>>>(ap);
    k_gemm<<<dim3(D / 64, T / 64), 256, 0, stream>>>(U, w_o + (size_t)l * D * D, xin, out, T, D, D);
    RouteP rp{out, norm2_g + l * D, wrg + (size_t)l * D * 4, brg + l * 4, wre + (size_t)l * D * 32, bre + l * 32, PROJ, EXPI, GATE};
    k_route<<<2048, 256, 0, stream>>>(rp);
    MoeP mp{PROJ, EXPI, GATE, w1 + (size_t)l * 32 * D * 256, w3 + (size_t)l * 32 * D * 256, w2 + (size_t)l * 32 * 256 * D, out};
    k_moe<<<4096, 256, 0, stream>>>(mp);
  }
}
```

```cpp
#include <hip/hip_runtime.h>
#include <cstdio>
#include <cstdint>
#include <cmath>
__device__ __forceinline__ int opq_tid() { int t = threadIdx.x; asm volatile("" : "+v"(t)); return t; }
__device__ __forceinline__ int opq_bid() { int t = blockIdx.x; asm volatile("" : "+s"(t)); return t; }
namespace pg8 {
#define PG8_LAS __attribute__((address_space(3)))
typedef unsigned short bf16_t;
typedef short bf16x8 __attribute__((ext_vector_type(8)));
typedef float f32x4 __attribute__((ext_vector_type(4)));
typedef unsigned u32x4 __attribute__((ext_vector_type(4)));
constexpr int BM = 256, BK = 64, HALF = 128, HTB = HALF * BK * 2  , STAGE_BYTES = 8 * HTB, NXCD = 8, WGM = 8;

__host__ __device__ __forceinline__ int lds_byte(int r, int c) { const int st = (r >> 4) * 2 + (c >> 5), rr = r & 15, cc = c & 31, ob = rr * 64 + cc * 2; return st * 1024 + (ob ^ (((ob >> 9) & 1) << 5)); }
__host__ __device__ __forceinline__ void stage_rc(int b, int& R, int& C) { const int st = b / 1024, sb = b % 1024, swz = sb ^ (((sb >> 9) & 1) << 5); R = (st >> 1) * 16 + swz / 64; C = (st & 1) * 32 + (swz % 64) / 2; }
__host__ __device__ __forceinline__ int perm32(int rho) { const int n = rho >> 4, i = rho & 15; return 8 * (i >> 2) + 4 * n + (i & 3); }

struct Unit { int pm, pn; };
struct Gemm { const bf16_t* A; const bf16_t* Bt; int M, N, K; };

struct StaticOrder {
    int nM, nN, nwg, G, c;
    __host__ __device__ void init(int M, int N, int G_, int c_) { nM = M / BM; nN = N / BM; nwg = nM * nN; G = G_; c = c_; }
    __host__ __device__ bool next(int i, Unit& u) const {
        const long L = (long)i * G + c; if (L >= nwg) return false;
        int wgid = (int)L; { const int q = nwg / NXCD, r = nwg % NXCD, xcd = wgid % NXCD, off = wgid / NXCD; wgid = (xcd < r ? xcd * (q + 1) : r * (q + 1) + (xcd - r) * q) + off; }
        const int nig = WGM * nN, gid = wgid / nig, fm = gid * WGM, gsz = (nM - fm) < WGM ? (nM - fm) : WGM;
        u.pm = fm + ((wgid % nig) % gsz); u.pn = (wgid % nig) / gsz; return true;
    }
    __device__ __forceinline__ void a_ready(const Unit&) const {}
    __device__ __forceinline__ void done(const Unit&) const {}
};

__device__ __forceinline__ unsigned cvt_pk_bf16(float lo, float hi) { unsigned r; asm volatile("v_cvt_pk_bf16_f32 %0, %1, %2" : "=v"(r) : "v"(lo), "v"(hi)); return r; }
typedef float f32x2 __attribute__((ext_vector_type(2)));
__device__ __forceinline__ f32x2 gelu_pk(f32x2 v) {
    const f32x2 av = __builtin_elementwise_abs(v), d = av * 0.2316418882f + 1.0f;
    f32x2 t; t.x = __builtin_amdgcn_rcpf(d.x); t.y = __builtin_amdgcn_rcpf(d.y);
    f32x2 q = t * 0.5307027145f + (-0.7265760135f); q = q * t + 0.7107068705f; q = q * t + (-0.142248368f); q = q * t + 0.127414796f; q = q * t;
    const f32x2 s = (v * v) * (-0.72134752044f);
    f32x2 e; e.x = __builtin_amdgcn_exp2f(s.x); e.y = __builtin_amdgcn_exp2f(s.y);
    const f32x2 m = v * (q * e), r = v - m;
    f32x2 o; o.x = v.x < 0.f ? m.x : r.x; o.y = v.y < 0.f ? m.y : r.y; return o;
}

template <int ACT  > struct EpiBf16 {
    static constexpr bool PERM = true, AFTER_DRAIN = false; static_assert(ACT == 0 || ACT == 1, "EpiBf16: ACT is 0 (none) or 1 (gelu_pk)");
    bf16_t* O; int ldc; const float* bias; int split_cols; size_t split_stride; float scale0;
    __device__ __forceinline__ void operator()(const f32x4 (&acc)[2][2][4][2], const Unit& u, int wr, int wc, int fr, int fq) const {
        const int row0 = u.pm * BM + wr * 64 + fr; int colt = u.pn * BM; bf16_t* base = O;
        float sc = 1.f; if (split_cols) { const int t = colt / split_cols; base += (size_t)t * split_stride; colt -= t * split_cols; if (t == 0) sc = scale0; }
        const int col0 = colt + wc * 32 + 8 * fq, bcol0 = u.pn * BM + wc * 32 + 8 * fq;
        f32x4 bv[2][2];
#pragma unroll
        for (int bj = 0; bj < 2; ++bj)
#pragma unroll
            for (int n = 0; n < 2; ++n) bv[bj][n] = bias ? *(const f32x4*)(bias + bcol0 + bj * HALF + 4 * n) : (f32x4){0.f, 0.f, 0.f, 0.f};
#pragma unroll
        for (int ai = 0; ai < 2; ++ai)
#pragma unroll
            for (int m = 0; m < 4; ++m) { bf16_t* rowp = base + (size_t)(row0 + ai * HALF + m * 16) * ldc + col0;
#pragma unroll
                for (int bj = 0; bj < 2; ++bj) { f32x4 v0 = acc[ai][bj][m][0] + bv[bj][0], v1 = acc[ai][bj][m][1] + bv[bj][1];
                    if (ACT == 1) { f32x2 a = gelu_pk((f32x2){v0[0], v0[1]}), b = gelu_pk((f32x2){v0[2], v0[3]}), c = gelu_pk((f32x2){v1[0], v1[1]}), d = gelu_pk((f32x2){v1[2], v1[3]});
                        v0 = (f32x4){a.x, a.y, b.x, b.y}; v1 = (f32x4){c.x, c.y, d.x, d.y}; }
                    v0 = v0 * sc; v1 = v1 * sc; u32x4 w; w.x = cvt_pk_bf16(v0[0], v0[1]); w.y = cvt_pk_bf16(v0[2], v0[3]); w.z = cvt_pk_bf16(v1[0], v1[1]); w.w = cvt_pk_bf16(v1[2], v1[3]);
                    *(u32x4*)(rowp + bj * HALF) = w; } }
    }
};
template <class Epi, class Sched, bool ALIGN_EPI = false, bool SP2 = false>
__device__ __forceinline__ void gemm_phase(PG8_LAS unsigned char* lds, const Gemm g, const Sched& S, const Epi& E) {
    const int tid = opq_tid(), wid = __builtin_amdgcn_readfirstlane(tid >> 6), lane = tid & 63, wr = wid >> 2, wc = wid & 3, fr = lane & 15, fq = lane >> 4;
    const int K = g.K, nt = K / BK;
    unsigned voffA[2], voffB[2];
#pragma unroll
    for (int i = 0; i < 2; ++i) { int R, C; stage_rc(tid * 16 + i * 8192, R, C); const int Rb = Epi::PERM ? ((R & ~31) + perm32(R & 31)) : R;
        voffA[i] = (unsigned)(R * K + C) * 2u; voffB[i] = (unsigned)(Rb * K + C) * 2u; }
    const size_t kstep = (size_t)(BK * 2);
    const size_t hstep = (size_t)HALF * K * 2;
    const size_t tstep = 2 * hstep;
    const unsigned ldsw = (unsigned)wid * 1024u;
    const int aoff = lds_byte(wr * 64 + fr, fq * 8), boff = lds_byte(wc * 32 + fr, fq * 8);
#define PG8_SA(b, h) (((b) * 2 + (h)) * HTB)
#define PG8_SB(b, h) ((4 + (b) * 2 + (h)) * HTB)
#define PG8_STAGE(bufoff, gbase, voff) do { _Pragma("unroll") for (int _i = 0; _i < 2; ++_i) \
        __builtin_amdgcn_global_load_lds((const unsigned*)((const char*)(gbase) + (voff)[_i]), (PG8_LAS unsigned*)(lds + (bufoff) + ldsw + _i * 8192), 16, 0, 0); } while (0)
#define PG8_LDA(dst, b, h) do { _Pragma("unroll") for (int m = 0; m < 4; ++m) _Pragma("unroll") for (int k = 0; k < 2; ++k) dst[m][k] = *(const PG8_LAS bf16x8*)(lds + PG8_SA(b, h) + aoff + m * 2048 + k * 1024); } while (0)
#define PG8_LDB(dst, b, h) do { _Pragma("unroll") for (int n = 0; n < 2; ++n) _Pragma("unroll") for (int k = 0; k < 2; ++k) dst[n][k] = *(const PG8_LAS bf16x8*)(lds + PG8_SB(b, h) + boff + n * 2048 + k * 1024); } while (0)
#define PG8_MMA(ai, bj, At, Bt) do { __builtin_amdgcn_s_setprio(1); _Pragma("unroll") for (int m = 0; m < 4; ++m) _Pragma("unroll") for (int n = 0; n < 2; ++n) _Pragma("unroll") for (int k = 0; k < 2; ++k) \
        acc[ai][bj][m][n] = __builtin_amdgcn_mfma_f32_16x16x32_bf16(Bt[n][k], At[m][k], acc[ai][bj][m][n], 0, 0, 0); __builtin_amdgcn_s_setprio(0); } while (0)
#define PG8_WAIT_V(n) asm volatile("s_waitcnt vmcnt(" #n ")" ::: "memory")
#define PG8_WAIT_L(n) asm volatile("s_waitcnt lgkmcnt(" #n ")" ::: "memory")
#define PG8_BAR __builtin_amdgcn_s_barrier()
#define PG8_SCHED __builtin_amdgcn_sched_barrier(0)
    Unit cur, nxt; int ui = 0;
    if (!S.next(0, cur)) return;
    f32x4 acc[2][2][4][2];
#pragma unroll
    for (int a = 0; a < 2; ++a)
#pragma unroll
        for (int b = 0; b < 2; ++b)
#pragma unroll
            for (int m = 0; m < 4; ++m)
#pragma unroll
                for (int n = 0; n < 2; ++n) acc[a][b][m][n] = (f32x4){0.f, 0.f, 0.f, 0.f};
    bf16x8 At[4][2], B0[2][2], B1[2][2];
    const char* cA = (const char*)g.A + (size_t)cur.pm * tstep; const char* cB = (const char*)g.Bt + (size_t)cur.pn * tstep;
    S.a_ready(cur);
    if constexpr (SP2) {
        PG8_STAGE(PG8_SB(0, 0), cB, voffB); PG8_STAGE(PG8_SB(0, 1), cB + hstep, voffB); PG8_STAGE(PG8_SA(0, 0), cA, voffA); PG8_STAGE(PG8_SA(0, 1), cA + hstep, voffA);
        if (wr == 1) PG8_BAR;
        PG8_WAIT_V(2); PG8_BAR;
        PG8_STAGE(PG8_SB(1, 0), cB + kstep, voffB); PG8_STAGE(PG8_SA(1, 0), cA + kstep, voffA); PG8_STAGE(PG8_SB(1, 1), cB + hstep + kstep, voffB);
        PG8_WAIT_V(6); PG8_BAR;
    } else {
        PG8_STAGE(PG8_SB(0, 0), cB, voffB); PG8_STAGE(PG8_SA(0, 0), cA, voffA); PG8_STAGE(PG8_SB(0, 1), cB + hstep, voffB); PG8_STAGE(PG8_SA(0, 1), cA + hstep, voffA);
        if (wr == 1) PG8_BAR;
        PG8_WAIT_V(4); PG8_BAR;
        PG8_STAGE(PG8_SB(1, 0), cB + kstep, voffB); PG8_STAGE(PG8_SA(1, 0), cA + kstep, voffA); PG8_STAGE(PG8_SB(1, 1), cB + hstep + kstep, voffB);
        PG8_WAIT_V(6); PG8_BAR;
    }
    for (;;) {
        const bool has_next = S.next(ui + 1, nxt);
        const char* nA = has_next ? (const char*)g.A + (size_t)nxt.pm * tstep : cA; const char* nB = has_next ? (const char*)g.Bt + (size_t)nxt.pn * tstep : cB;
        for (int t = 0; t < nt; t += 2) {
            const bool last = (t == nt - 2);
            const char* a1 = cA + (size_t)(t + 1) * kstep;
            const char* a2 = last ? nA : cA + (size_t)(t + 2) * kstep; const char* b2 = last ? nB : cB + (size_t)(t + 2) * kstep;
            const char* a3 = a2 + kstep; const char* b3 = b2 + kstep;
            if (last && has_next) S.a_ready(nxt);
            if constexpr (SP2) {
            PG8_LDB(B0, 0, 0); PG8_LDB(B1, 0, 1); PG8_SCHED; PG8_LDA(At, 0, 0); PG8_STAGE(PG8_SA(1, 1), a1 + hstep, voffA);
            PG8_WAIT_V(8); PG8_WAIT_L(0); PG8_BAR; PG8_MMA(0, 0, At, B0); PG8_MMA(0, 1, At, B1); PG8_BAR; PG8_SCHED;
            PG8_LDA(At, 0, 1); PG8_STAGE(PG8_SB(0, 0), b2, voffB); PG8_STAGE(PG8_SB(0, 1), b2 + hstep, voffB); PG8_STAGE(PG8_SA(0, 0), a2, voffA);
            PG8_WAIT_V(8); PG8_WAIT_L(0); PG8_BAR; PG8_MMA(1, 0, At, B0); PG8_MMA(1, 1, At, B1); PG8_BAR; PG8_SCHED;
            PG8_LDB(B0, 1, 0); PG8_LDB(B1, 1, 1); PG8_SCHED; PG8_LDA(At, 1, 0); PG8_STAGE(PG8_SA(0, 1), a2 + hstep, voffA);
            PG8_WAIT_V(8); PG8_WAIT_L(0); PG8_BAR; PG8_MMA(0, 0, At, B0); PG8_MMA(0, 1, At, B1); PG8_BAR; PG8_SCHED;
            PG8_LDA(At, 1, 1); PG8_STAGE(PG8_SB(1, 0), b3, voffB); PG8_STAGE(PG8_SB(1, 1), b3 + hstep, voffB); PG8_STAGE(PG8_SA(1, 0), a3, voffA);
            PG8_WAIT_V(8); PG8_WAIT_L(0); PG8_BAR; PG8_MMA(1, 0, At, B0); PG8_MMA(1, 1, At, B1); PG8_BAR; PG8_SCHED;
            } else {
            PG8_LDB(B0, 0, 0); PG8_SCHED; PG8_LDA(At, 0, 0); PG8_STAGE(PG8_SA(1, 1), a1 + hstep, voffA);
            PG8_WAIT_L(8); PG8_BAR; PG8_WAIT_L(0); PG8_MMA(0, 0, At, B0); PG8_BAR; PG8_SCHED;
            PG8_LDB(B1, 0, 1); PG8_STAGE(PG8_SB(0, 0), b2, voffB);
            PG8_BAR; PG8_WAIT_L(0); PG8_MMA(0, 1, At, B1); PG8_BAR;
            PG8_LDA(At, 0, 1); PG8_STAGE(PG8_SA(0, 0), a2, voffA);
            PG8_BAR; PG8_WAIT_L(0); PG8_MMA(1, 0, At, B0); PG8_BAR; PG8_SCHED;
            PG8_STAGE(PG8_SB(0, 1), b2 + hstep, voffB);
            PG8_WAIT_V(6); PG8_BAR; PG8_MMA(1, 1, At, B1); PG8_BAR;
            PG8_LDB(B0, 1, 0); PG8_SCHED; PG8_LDA(At, 1, 0); PG8_STAGE(PG8_SA(0, 1), a2 + hstep, voffA);
            PG8_WAIT_L(8); PG8_BAR; PG8_WAIT_L(0); PG8_MMA(0, 0, At, B0); PG8_BAR; PG8_SCHED;
            PG8_LDB(B1, 1, 1); PG8_STAGE(PG8_SB(1, 0), b3, voffB);
            PG8_BAR; PG8_WAIT_L(0); PG8_MMA(0, 1, At, B1); PG8_BAR;
            PG8_LDA(At, 1, 1); PG8_STAGE(PG8_SA(1, 0), a3, voffA);
            PG8_BAR; PG8_WAIT_L(0); PG8_MMA(1, 0, At, B0); PG8_BAR; PG8_SCHED;
            PG8_STAGE(PG8_SB(1, 1), b3 + hstep, voffB);
            PG8_WAIT_V(6); PG8_BAR; PG8_MMA(1, 1, At, B1); PG8_BAR;
            }
        }
        if constexpr (ALIGN_EPI) { if (wr == 0) PG8_BAR; }
        if constexpr (!Epi::AFTER_DRAIN) { E(acc, cur, wr, wc, fr, fq); S.done(cur); }
        if (!has_next) break;
#pragma unroll
        for (int a = 0; a < 2; ++a)
#pragma unroll
            for (int b = 0; b < 2; ++b)
#pragma unroll
                for (int m = 0; m < 4; ++m)
#pragma unroll
                    for (int n = 0; n < 2; ++n) acc[a][b][m][n] = (f32x4){0.f, 0.f, 0.f, 0.f};
        cur = nxt; cA = nA; cB = nB; ++ui;
        if constexpr (ALIGN_EPI) { if (wr == 1) PG8_BAR; }
    }
    PG8_WAIT_V(0);
    if constexpr (!ALIGN_EPI) { if (wr == 0) PG8_BAR; }
    PG8_BAR;
    if constexpr (Epi::AFTER_DRAIN) { E.fused(acc, cur, wr, wc, fr, fq, lds, wid, lane); S.done(cur); }
#undef PG8_SA
#undef PG8_SB
#undef PG8_STAGE
#undef PG8_LDA
#undef PG8_LDB
#undef PG8_MMA
#undef PG8_WAIT_V
#undef PG8_WAIT_L
#undef PG8_BAR
#undef PG8_SCHED
}
}

#ifndef PG8_SP2
#define PG8_SP2 true
#endif
#ifndef PG8_ALIGN
#define PG8_ALIGN true
#endif
#define GAS __attribute__((address_space(1)))
#define LAS __attribute__((address_space(3)))
typedef unsigned short bf16;
typedef unsigned v4u __attribute__((ext_vector_type(4)));
typedef float f32x4 __attribute__((ext_vector_type(4)));
typedef short bf16x8 __attribute__((ext_vector_type(8)));
typedef GAS unsigned gu32;
typedef GAS unsigned long long gu64;
#define RLX_AGENT __ATOMIC_RELAXED, __HIP_MEMORY_SCOPE_AGENT
#define LDS_WAIT() asm volatile("s_waitcnt lgkmcnt(0)" ::: "memory")
#define VM_WAIT() asm volatile("s_waitcnt vmcnt(0)" ::: "memory")
__device__ __forceinline__ unsigned long long rt() { return __builtin_amdgcn_s_memrealtime(); }
__device__ __forceinline__ unsigned f2bf(float f) { unsigned u = __builtin_bit_cast(unsigned, f); return (u + 0x7fffu + ((u >> 16) & 1u)) >> 16; }
__device__ __forceinline__ unsigned pk2(float lo, float hi) { return f2bf(lo) | (f2bf(hi) << 16); }

#define XB_TMO      128
#define XB_XCNT(j)  (256  + 64 * (j))
#define XB_XSUB(j)  (1280 + 64 * (j))
#define XB_XGEN(j)  (2304 + 64 * (j))
#define XB_TOP      3328
#define XB_TOPGEN   3392
#define XCD_BAR_WORDS 3456
#define XB_SPIN_CAP (1u << 18)

__device__ __forceinline__ unsigned xb_ld(unsigned* p)              { return __hip_atomic_load(p, __ATOMIC_RELAXED, __HIP_MEMORY_SCOPE_AGENT); }
__device__ __forceinline__ unsigned xb_add(unsigned* p, unsigned v) { return __hip_atomic_fetch_add(p, v, __ATOMIC_RELAXED, __HIP_MEMORY_SCOPE_AGENT); }
__device__ __forceinline__ unsigned xb_xcc_id() { return (unsigned)__builtin_amdgcn_s_getreg((3 << 11) | 20) & 0xFu; }
#define XB_SPIN(cond, bar) do { unsigned _sp = 0; while (cond) { __builtin_amdgcn_s_sleep(1); \
    if ((++_sp & 255u) == 0u) { if (xb_ld(&(bar)[XB_TMO])) break; if (_sp > XB_SPIN_CAP) { atomicAdd(&(bar)[XB_TMO], 1u); break; } } } } while (0)

struct XcdBarrier {
    unsigned* bar; unsigned x;
    volatile LAS unsigned* st;
};

__device__ __forceinline__ XcdBarrier xcd_barrier_post(unsigned* bar, volatile LAS unsigned* st) {
    XcdBarrier b; b.bar = bar; b.x = xb_xcc_id(); b.st = st;
    if (threadIdx.x == 0) (void)xb_add(&bar[XB_XCNT(b.x)], 1u);
    return b;
}
__device__ __forceinline__ void xcd_barrier_complete(unsigned* bar, unsigned x, unsigned& nloc, unsigned& nx) {
    const unsigned G = gridDim.x * gridDim.y * gridDim.z;
    unsigned sum, cnt, mine, sp = 0u;
    for (;;) {
        sum = 0u; cnt = 0u; mine = 0u;
#pragma unroll
        for (unsigned j = 0; j < 16; ++j) { const unsigned c = xb_ld(&bar[XB_XCNT(j)]); sum += c; cnt += (c > 0u) ? 1u : 0u; mine = (j == x) ? c : mine; }
        if (sum == G) break;
        __builtin_amdgcn_s_sleep(1);
        if ((++sp & 255u) == 0u) { if (xb_ld(&bar[XB_TMO])) break; if (sp > XB_SPIN_CAP) { atomicAdd(&bar[XB_TMO], 1u); break; } }
    }
    nloc = mine > 0u ? mine : 1u; nx = cnt > 0u ? cnt : 1u;
}

__device__ __forceinline__ void xcd_barrier(const XcdBarrier& b) {
    asm volatile("s_waitcnt vmcnt(0)" ::: "memory");
    __syncthreads();
    if (threadIdx.x == 0) {
        unsigned* bar = b.bar;
        __builtin_amdgcn_s_waitcnt(0);
        unsigned nloc = b.st[0], nx = b.st[1];
        if (nloc == 0u) { xcd_barrier_complete(bar, b.x, nloc, nx); b.st[0] = nloc; b.st[1] = nx; }
        const unsigned old = xb_add(&bar[XB_XSUB(b.x)], 1u);
        const unsigned gen = old / nloc;
        if (old + 1u == (gen + 1u) * nloc) {
            __builtin_amdgcn_fence(__ATOMIC_RELEASE, "agent");
            asm volatile("s_waitcnt vmcnt(0)" ::: "memory");
            const unsigned og = xb_add(&bar[XB_TOP], 1u);
            const unsigned tg = og / nx;
            if (og + 1u == (tg + 1u) * nx) xb_add(&bar[XB_TOPGEN], 1u);
            else XB_SPIN(xb_ld(&bar[XB_TOPGEN]) == tg, bar);
            __builtin_amdgcn_fence(__ATOMIC_ACQUIRE, "agent");
            xb_add(&bar[XB_XGEN(b.x)], 1u);
            asm volatile("s_waitcnt vmcnt(0)" ::: "memory");
        } else {
            XB_SPIN(xb_ld(&bar[XB_XGEN(b.x)]) == gen, bar);
            __builtin_amdgcn_fence(__ATOMIC_ACQUIRE, "agent");
            asm volatile("s_waitcnt vmcnt(0)" ::: "memory");
        }
    }
    __syncthreads();
}
namespace mk {
constexpr int NB = 2, S = 8192, D = 1024, T = NB * S, NL = 2, NW = 2404, NP = 2560;
constexpr int OFF_CQ = 0, OFF_CKV = 192, OFF_KR = 320, OFF_PB = 352, OFF_PC = 1120, OFF_FG = 1888, OFF_PDQ = 1892, OFF_PDKV = 2148;
constexpr float EPS = 1e-6f, LOG2E = 1.4426950408889634f, C2 = 0.125f * 1.4426950408889634f;
constexpr int NWAVES = 8, NTHR = 512;
constexpr size_t MiB = 1u << 20;
constexpr size_t WS_CTL = 0, CTL_ZERO_BYTES = 1 * MiB;
constexpr size_t WS_WIN = 1 * MiB;
constexpr size_t WS_WO = 11 * MiB;
constexpr size_t WS_WUQ = 15 * MiB;
constexpr size_t WS_WUKV = 15 * MiB + MiB / 2;
constexpr size_t WS_W13 = 16 * MiB;
constexpr size_t WS_W2 = 80 * MiB;
constexpr size_t WS_ACT = 112 * MiB;
constexpr size_t WS_QKV = 144 * MiB;
constexpr size_t WS_R8 = 232 * MiB, WS_R9 = 240 * MiB;
constexpr size_t WS_LF = 248 * MiB, WS_CUM = WS_LF + MiB / 4, WS_EXP = 249 * MiB, WS_GATE = WS_EXP + MiB / 4;
constexpr size_t WS_END = 250 * MiB;
constexpr size_t QKV_STRIDE = (size_t)T * 256;
enum { IQA = 0, IKA, IVA, IQB, IKB, IVB, IQC, IKC, IVC, IQD };
constexpr int CW_BAR = 4096;
constexpr int RING_BYTES = 131072, LDSCTL_OFF = RING_BYTES, MISC_OFF = LDSCTL_OFF + 320, LDS_BYTES = 147456;
constexpr int NPHASE = 1 + 8 * NL;

__device__ __forceinline__ float bf2f(bf16 v) { return __uint_as_float((unsigned)v << 16); }
__device__ __forceinline__ float wave_sum(float v) {
#pragma unroll
  for (int o = 32; o; o >>= 1) v += __shfl_xor(v, o);
  return v;
}
__device__ __forceinline__ float log_sigmoid(float x) { return fminf(x, 0.f) - log1pf(expf(-fabsf(x))); }

__device__ __forceinline__ void tr_item(const float* W, int ldw, int srccol0, int nvalid, bf16* WT, int K, int dstrow0, int k0, LAS float* scr, int lane) {
  const int n_ = lane & 31;
#pragma unroll 8
  for (int i = 0; i < 32; ++i) { const int kk = 2 * i + (lane >> 5); scr[kk * 33 + n_] = (n_ < nvalid) ? W[(size_t)(k0 + kk) * ldw + srccol0 + n_] : 0.f; }
  LDS_WAIT(); asm volatile("" ::: "memory");
  const int c = lane & 7;
#pragma unroll
  for (int j = 0; j < 4; ++j) { const int n = (lane >> 3) + 8 * j; const LAS float* s = scr + (8 * c) * 33 + n;
    v4u o; o.x = pk2(s[0 * 33], s[1 * 33]); o.y = pk2(s[2 * 33], s[3 * 33]); o.z = pk2(s[4 * 33], s[5 * 33]); o.w = pk2(s[6 * 33], s[7 * 33]);
    *(GAS v4u*)(WT + (size_t)(dstrow0 + n) * K + k0 + 8 * c) = o; }
  LDS_WAIT(); asm volatile("" ::: "memory");
}
__device__ __forceinline__ void win_src(int n0, int& sc, int& nv) {
  const int pn = n0 >> 8, p = n0 & 255, lc = 64 * ((p >> 5) & 3) + 32 * (p >> 7);
  nv = 32; sc = 0;
  if (pn < 3) sc = OFF_PB + pn * 256 + lc;
  else if (pn < 6) sc = OFF_PC + (pn - 3) * 256 + lc;
  else if (pn == 6) sc = OFF_PDQ + lc;
  else if (pn == 7) sc = OFF_PDKV + lc;
  else if (pn == 8) { sc = OFF_CQ + lc; if (lc >= 192) { nv = 0; sc = 0; } }
  else { if (lc < 128) sc = OFF_CKV + lc; else if (lc < 160) sc = OFF_KR + lc - 128; else if (lc < 192) { sc = OFF_FG; nv = 4; } else { sc = 0; nv = 0; } }
}
__device__ __forceinline__ void prep_rows(const float* X, const bf16* y0, const bf16* y1, float* xout, bf16* XN, const float* g1, int gw, int NGW, int lane) {
  for (int m = gw; m < T; m += NGW) {
    const GAS f32x4* xr = (const GAS f32x4*)(X + (size_t)m * D) + lane;
    f32x4 v[4]; float ss = 0.f;
#pragma unroll
    for (int j = 0; j < 4; ++j) {
      v[j] = xr[64 * j];
      if (y0) {
        const unsigned long long a = *((const GAS unsigned long long*)(y0 + (size_t)m * D) + lane + 64 * j), b = *((const GAS unsigned long long*)(y1 + (size_t)m * D) + lane + 64 * j);
        v[j].x += __uint_as_float((unsigned)a << 16) + __uint_as_float((unsigned)b << 16);
        v[j].y += __uint_as_float((unsigned)a & 0xffff0000u) + __uint_as_float((unsigned)b & 0xffff0000u);
        v[j].z += __uint_as_float((unsigned)(a >> 32) << 16) + __uint_as_float((unsigned)(b >> 32) << 16);
        v[j].w += __uint_as_float((unsigned)(a >> 32) & 0xffff0000u) + __uint_as_float((unsigned)(b >> 32) & 0xffff0000u);
      }
      ss += (v[j].x * v[j].x + v[j].y * v[j].y) + (v[j].z * v[j].z + v[j].w * v[j].w);
    }
    if (xout) {
#pragma unroll
      for (int j = 0; j < 4; ++j) ((GAS f32x4*)(xout + (size_t)m * D) + lane)[64 * j] = v[j];
    }
    if (XN) {
      const float rstd = rsqrtf(wave_sum(ss) * (1.f / D) + EPS);
      GAS unsigned long long* o8 = (GAS unsigned long long*)(XN + (size_t)m * D) + lane;
#pragma unroll
      for (int j = 0; j < 4; ++j) { const f32x4 g = *((const GAS f32x4*)g1 + lane + 64 * j);
        o8[64 * j] = (unsigned long long)pk2(v[j].x * rstd * g.x, v[j].y * rstd * g.y) | ((unsigned long long)pk2(v[j].z * rstd * g.z, v[j].w * rstd * g.w) << 32); }
    }
  }
}

struct EpiInProj {
  static constexpr bool PERM = true, AFTER_DRAIN = false;
  bf16* qkv; bf16* R8; bf16* R9; float* LF; const float* gq; const float* gk; const float* bfox;
  __device__ __forceinline__ void operator()(const pg8::f32x4 (&acc)[2][2][4][2], const pg8::Unit& u, int wr, int wc, int fr, int fq) const {
    const int pn = u.pn;
    bf16* dst; int pitch = 256, cb = 64 * wc; const float* g = nullptr; float sc = 1.f;
    if (pn < 6) { dst = qkv + (size_t)(IQB + pn) * QKV_STRIDE; const int r3 = pn % 3, mx = 1 + pn / 3; if (r3 == 0) { g = gq + mx * 64; sc = C2; } else if (r3 == 1) g = gk + mx * 64; }
    else if (pn == 6) { dst = qkv + (size_t)IQD * QKV_STRIDE; g = gq + 3 * 64; sc = C2; }
    else if (pn == 7) { pitch = 128; if (wc < 2) { dst = qkv + 10 * QKV_STRIDE; g = gk + 3 * 64; } else { dst = qkv + 10 * QKV_STRIDE + (size_t)T * 128; cb = 64 * (wc - 2); } }
    else if (pn == 8) dst = R8; else dst = R9;
    const int rowb = u.pm * 256 + wr * 64 + fr;
    if (g) {
      pg8::f32x4 gv[2][2];
#pragma unroll
      for (int bj = 0; bj < 2; ++bj)
#pragma unroll
        for (int n = 0; n < 2; ++n) gv[bj][n] = *(const pg8::f32x4*)(g + 32 * bj + 8 * fq + 4 * n) * sc;
#pragma unroll
      for (int ai = 0; ai < 2; ++ai)
#pragma unroll
        for (int m = 0; m < 4; ++m) {
          float ss = 0.f;
#pragma unroll
          for (int bj = 0; bj < 2; ++bj)
#pragma unroll
            for (int n = 0; n < 2; ++n) { const pg8::f32x4 x = acc[ai][bj][m][n]; ss += (x[0] * x[0] + x[1] * x[1]) + (x[2] * x[2] + x[3] * x[3]); }
          ss += __shfl_xor(ss, 16); ss += __shfl_xor(ss, 32);
          const float rstd = rsqrtf(ss * (1.f / 64.f) + EPS);
          bf16* rp = dst + (size_t)(rowb + ai * 128 + m * 16) * pitch + cb + 8 * fq;
#pragma unroll
          for (int bj = 0; bj < 2; ++bj) { const pg8::f32x4 v0 = acc[ai][bj][m][0] * gv[bj][0] * rstd, v1 = acc[ai][bj][m][1] * gv[bj][1] * rstd;
            pg8::u32x4 w; w.x = pg8::cvt_pk_bf16(v0[0], v0[1]); w.y = pg8::cvt_pk_bf16(v0[2], v0[3]); w.z = pg8::cvt_pk_bf16(v1[0], v1[1]); w.w = pg8::cvt_pk_bf16(v1[2], v1[3]);
            *(pg8::u32x4*)(rp + 32 * bj) = w; }
        }
    } else {
#pragma unroll
      for (int ai = 0; ai < 2; ++ai)
#pragma unroll
        for (int m = 0; m < 4; ++m) {
          bf16* rp = dst + (size_t)(rowb + ai * 128 + m * 16) * pitch + cb + 8 * fq;
#pragma unroll
          for (int bj = 0; bj < 2; ++bj) { const pg8::f32x4 v0 = acc[ai][bj][m][0], v1 = acc[ai][bj][m][1];
            pg8::u32x4 w; w.x = pg8::cvt_pk_bf16(v0[0], v0[1]); w.y = pg8::cvt_pk_bf16(v0[2], v0[3]); w.z = pg8::cvt_pk_bf16(v1[0], v1[1]); w.w = pg8::cvt_pk_bf16(v1[2], v1[3]);
            *(pg8::u32x4*)(rp + 32 * bj) = w; }
        }
      if (pn == 9 && wc == 2 && fq == 0) {
        const pg8::f32x4 bb = *(const pg8::f32x4*)bfox;
#pragma unroll
        for (int ai = 0; ai < 2; ++ai)
#pragma unroll
          for (int m = 0; m < 4; ++m) { const pg8::f32x4 v = acc[ai][1][m][0] + bb; pg8::f32x4 o;
            o[0] = log_sigmoid(v[0]); o[1] = log_sigmoid(v[1]); o[2] = log_sigmoid(v[2]); o[3] = log_sigmoid(v[3]);
            *(pg8::f32x4*)(LF + (size_t)(rowb + ai * 128 + m * 16) * 4) = o; }
      }
    }
  }
};

__device__ __forceinline__ void n_post(LAS unsigned char* lds, const bf16* R8, const bf16* R9, const float* gcq, const float* gckv, const float* wuq, const float* wukv,
                                       const float* gq0, const float* gk0, bf16* QA, bf16* KA, bf16* VA) {
  LAS float* cqn = (LAS float*)lds; LAS float* ckvn = cqn + 192; LAS float* kva = ckvn + 128; LAS float* tmp = kva + 384; LAS float* red = tmp + 256; LAS float* krs = red + 8;
  const int tid = opq_tid(), lane = tid & 63, w = tid >> 6;
  for (int t = blockIdx.x; t < T; t += gridDim.x) {
    const int pos = t % S;
    const float vq = (tid < 192) ? bf2f(R8[(size_t)t * 256 + tid]) : 0.f;
    const float vk = (tid < 128) ? bf2f(R9[(size_t)t * 256 + tid]) : 0.f;
    const float sq = wave_sum(vq * vq), sk = wave_sum(vk * vk);
    if (lane == 0 && w < 4) { red[w] = sq; red[4 + w] = sk; }
    if (tid < 32) krs[tid] = bf2f(R9[(size_t)t * 256 + 128 + tid]);
    __syncthreads();
    const float rq = rsqrtf((red[0] + red[1] + red[2] + red[3]) * (1.f / 192.f) + EPS);
    const float rk = rsqrtf((red[4] + red[5] + red[6] + red[7]) * (1.f / 128.f) + EPS);
    if (tid < 192) cqn[tid] = vq * rq * gcq[tid];
    if (tid < 128) ckvn[tid] = vk * rk * gckv[tid];
    __syncthreads();
    float qa = 0.f, ka = 0.f;
    if (tid < 256) {
      float k0 = 0.f, k1 = 0.f;
      for (int i = 0; i < 192; ++i) qa += cqn[i] * wuq[i * 256 + tid];
      for (int i = 0; i < 128; ++i) { k0 += ckvn[i] * wukv[i * 384 + tid]; if (tid < 128) k1 += ckvn[i] * wukv[i * 384 + 256 + tid]; }
      kva[tid] = k0; if (tid < 128) kva[256 + tid] = k1;
      const float ss = wave_sum(qa * qa);
      qa = qa * rsqrtf(ss * (1.f / 64.f) + EPS) * gq0[lane];
      tmp[tid] = qa;
    }
    __syncthreads();
    float cs = 1.f, sn = 0.f;
    if (tid < 256 && lane >= 32) { const int j = (lane - 32) & 15; const float inv = powf(10000.f, -(float)(2 * j) / 32.f); const float ang = (float)pos * inv; cs = cosf(ang); sn = sinf(ang); }
    if (tid < 256) {
      float o = qa;
      if (lane >= 32) { if (lane < 48) o = qa * cs - tmp[tid + 16] * sn; else o = qa * cs + tmp[tid - 16] * sn; }
      QA[(size_t)t * 256 + tid] = (bf16)f2bf(o * C2);
      ka = (lane < 32) ? kva[w * 96 + lane] : krs[lane - 32];
      const float ss = wave_sum(ka * ka);
      ka = ka * rsqrtf(ss * (1.f / 64.f) + EPS) * gk0[lane];
    }
    __syncthreads();
    if (tid < 256) tmp[tid] = ka;
    __syncthreads();
    if (tid < 256) {
      float o = ka;
      if (lane >= 32) { if (lane < 48) o = ka * cs - tmp[tid + 16] * sn; else o = ka * cs + tmp[tid - 16] * sn; }
      KA[(size_t)t * 256 + tid] = (bf16)f2bf(o);
      VA[(size_t)t * 256 + tid] = (bf16)f2bf(kva[w * 96 + 32 + lane]);
    }
    __syncthreads();
  }
}
__device__ __forceinline__ void n_cumsum(LAS unsigned char* lds, const float* LF, float* CUM) {
  LAS float* part = (LAS float*)lds + 2048;
  const int tid = opq_tid(); constexpr int per = S / NTHR;
  for (int item = blockIdx.x; item < NB * 4; item += gridDim.x) {
    const int b = item >> 2, h = item & 3;
    float s = 0.f;
    for (int i = 0; i < per; ++i) s += LF[((size_t)b * S + tid * per + i) * 4 + h];
    part[tid] = s;
    __syncthreads();
    if (tid == 0) { float a = 0.f; for (int i = 0; i < NTHR; ++i) { const float v = part[i]; part[i] = a; a += v; } }
    __syncthreads();
    float a = part[tid];
    for (int i = 0; i < per; ++i) { a += LF[((size_t)b * S + tid * per + i) * 4 + h]; CUM[((size_t)b * S + tid * per + i) * 4 + h] = a; }
    __syncthreads();
  }
}
struct Soft { float m, l, o; };
__device__ __forceinline__ void soft_add(Soft& st, float logit2, float v) {
  const float mn = fmaxf(st.m, logit2);
  const float a = exp2f(st.m - mn), pp = exp2f(logit2 - mn);
  st.l = st.l * a + pp; st.o = st.o * a + pp * v; st.m = mn;
}
__device__ __forceinline__ void n_attn(const bf16* qkv, const float* CUM, const float* sink, bf16* MIX, int mask) {
  const int tid_ = opq_tid(), lane = tid_ & 63, wpb = NTHR >> 6;
  const long nitems = (long)T * 16;
  for (long it = (long)blockIdx.x * wpb + (tid_ >> 6); it < nitems; it += (long)gridDim.x * wpb) {
    const int t = T - 1 - (int)(it >> 4), mh = (int)(it & 15), mixer = mh >> 2, h = mh & 3;
    if (!((mask >> mixer) & 1)) continue;
    const int b = t / S, pos = t % S; const long base = (long)b * S;
    Soft st; st.m = -INFINITY; st.l = 0.f; st.o = 0.f;
    if (mixer == 0 || mixer == 2) {
      const bf16* Q = qkv + (size_t)(mixer == 0 ? IQA : IQC) * QKV_STRIDE; const bf16* K = Q + QKV_STRIDE; const bf16* V = K + QKV_STRIDE;
      const float q = bf2f(Q[(size_t)t * 256 + h * 64 + lane]);
      const float ct = (mixer == 2) ? CUM[(size_t)t * 4 + h] : 0.f;
      for (int s = 0; s <= pos; ++s) {
        float d = wave_sum(q * bf2f(K[(size_t)(base + s) * 256 + h * 64 + lane]));
        if (mixer == 2) d += (ct - CUM[(size_t)(base + s) * 4 + h]) * LOG2E;
        soft_add(st, d, bf2f(V[(size_t)(base + s) * 256 + h * 64 + lane]));
      }
    } else if (mixer == 3) {
      const bf16* Q = qkv + (size_t)IQD * QKV_STRIDE; const bf16* K = qkv + 10 * QKV_STRIDE; const bf16* V = K + (size_t)T * 128;
      const int hk = h >> 1;
      const float q = bf2f(Q[(size_t)t * 256 + h * 64 + lane]);
      const float slope = exp2f(-(float)(h + 1)) * LOG2E;
      const int s0 = pos - 127 < 0 ? 0 : pos - 127;
      for (int s = s0; s <= pos; ++s) {
        const float d = wave_sum(q * bf2f(K[(size_t)(base + s) * 128 + hk * 64 + lane])) - slope * (float)(pos - s);
        soft_add(st, d, bf2f(V[(size_t)(base + s) * 128 + hk * 64 + lane]));
      }
      const float sk = sink[h] * LOG2E;
      const float mn = fmaxf(st.m, sk), a = exp2f(st.m - mn);
      st.l = st.l * a + exp2f(sk - mn); st.o *= a; st.m = mn;
    } else {
      const bf16* Q = qkv + (size_t)IQB * QKV_STRIDE; const bf16* K = Q + QKV_STRIDE; const bf16* V = K + QKV_STRIDE;
      const float q = bf2f(Q[(size_t)t * 256 + h * 64 + lane]);
      const float slope = exp2f(-(float)(h + 5)) * LOG2E;
      for (int br = 0; br < 3; ++br) {
        const int dil = br == 0 ? 1 : (br == 1 ? 4 : 16);
        for (int j = 0; j <= 128; ++j) {
          const int s = pos - dil * j;
          if (s < 0) break;
          const float d = wave_sum(q * bf2f(K[(size_t)(base + s) * 256 + h * 64 + lane])) - slope * (float)(dil * j);
          soft_add(st, d, bf2f(V[(size_t)(base + s) * 256 + h * 64 + lane]));
        }
      }
    }
    MIX[(size_t)t * D + mixer * 256 + h * 64 + lane] = (bf16)f2bf(st.o / st.l);
  }
}
__device__ __forceinline__ void n_wo(LAS unsigned char* lds, const bf16* A, const float* Bm, const float* R, float* C) {
  LAS float* As = (LAS float*)lds;
  LAS float* Bs = As + 16 * 129;
  const int tid = opq_tid(), tx = tid & 15, ty = tid >> 4;
  for (int tile = blockIdx.x; tile < (T / 128) * (D / 64); tile += gridDim.x) {
    const int m0 = (tile / (D / 64)) * 128, n0 = (tile % (D / 64)) * 64;
    float acc[4][4];
#pragma unroll
    for (int i = 0; i < 4; ++i)
#pragma unroll
      for (int j = 0; j < 4; ++j) acc[i][j] = 0.f;
    for (int k0 = 0; k0 < D; k0 += 16) {
#pragma unroll
      for (int r = 0; r < 4; ++r) { const int i = tid + NTHR * r, m = i >> 4, k = i & 15; As[k * 129 + m] = bf2f(A[(size_t)(m0 + m) * D + k0 + k]); }
#pragma unroll
      for (int r = 0; r < 2; ++r) { const int i = tid + NTHR * r, k = i >> 6, n = i & 63; Bs[k * 64 + n] = Bm[(size_t)(k0 + k) * D + n0 + n]; }
      __syncthreads();
#pragma unroll
      for (int k = 0; k < 16; ++k) {
        float a[4], b[4];
#pragma unroll
        for (int i = 0; i < 4; ++i) { a[i] = As[k * 129 + ty * 4 + i]; b[i] = Bs[k * 64 + tx * 4 + i]; }
#pragma unroll
        for (int i = 0; i < 4; ++i)
#pragma unroll
          for (int j = 0; j < 4; ++j) acc[i][j] += a[i] * b[j];
      }
      __syncthreads();
    }
#pragma unroll
    for (int i = 0; i < 4; ++i)
#pragma unroll
      for (int j = 0; j < 4; ++j) { const size_t o = (size_t)(m0 + ty * 4 + i) * D + n0 + tx * 4 + j; C[o] = R[o] + acc[i][j]; }
  }
}
__device__ __forceinline__ void n_route(const float* H, const float* g2, const float* wrg, const float* brg, const float* wre, const float* bre, bf16* HN, int* EXPI, float* GATE) {
  const int tid_ = opq_tid(), lane = tid_ & 63, wpb = NTHR >> 6;
  for (int t = blockIdx.x * wpb + (tid_ >> 6); t < T; t += gridDim.x * wpb) {
    const float* hr = H + (size_t)t * D;
    float v[16], ss = 0.f;
#pragma unroll
    for (int j = 0; j < 16; ++j) { v[j] = hr[lane + 64 * j]; ss += v[j] * v[j]; }
    ss = wave_sum(ss);
    const float rstd = rsqrtf(ss * (1.f / D) + EPS);
#pragma unroll
    for (int j = 0; j < 16; ++j) { v[j] = v[j] * rstd * g2[lane + 64 * j]; HN[(size_t)t * D + lane + 64 * j] = (bf16)f2bf(v[j]); }
    float gl[4];
#pragma unroll
    for (int g = 0; g < 4; ++g) {
      float a = 0.f;
#pragma unroll
      for (int j = 0; j < 16; ++j) a += v[j] * wrg[(size_t)(lane + 64 * j) * 4 + g];
      gl[g] = wave_sum(a) + brg[g];
    }
    int gs = 0; float gm = gl[0];
#pragma unroll
    for (int g = 1; g < 4; ++g) if (gl[g] > gm) { gm = gl[g]; gs = g; }
    float den = 0.f;
#pragma unroll
    for (int g = 0; g < 4; ++g) den += expf(gl[g] - gm);
    const float pg = 1.f / den;
    float el[8];
#pragma unroll
    for (int e = 0; e < 8; ++e) {
      float a = 0.f;
#pragma unroll
      for (int j = 0; j < 16; ++j) a += v[j] * wre[(size_t)(lane + 64 * j) * 32 + gs * 8 + e];
      el[e] = wave_sum(a) + bre[gs * 8 + e];
    }
    int i1 = 0; float m1 = el[0];
#pragma unroll
    for (int e = 1; e < 8; ++e) if (el[e] > m1) { m1 = el[e]; i1 = e; }
    int i2 = 0; float m2 = -INFINITY;
#pragma unroll
    for (int e = 0; e < 8; ++e) if (e != i1 && el[e] > m2) { m2 = el[e]; i2 = e; }
    const float e2 = expf(m2 - m1);
    if (lane == 0) {
      EXPI[t * 2] = gs * 8 + i1; EXPI[t * 2 + 1] = gs * 8 + i2;
      GATE[t * 2] = pg / (1.f + e2); GATE[t * 2 + 1] = pg * e2 / (1.f + e2);
    }
  }
}
__device__ __forceinline__ void n_moe(LAS unsigned char* lds, const bf16* HN, const int* EXPI, const float* GATE, const float* w1, const float* w3, const float* w2, float* hio) {
  LAS float* xs = (LAS float*)lds; LAS float* sa = xs + D; LAS float* hid = sa + 512;
  const int tid = opq_tid(), j = tid & 255, half = tid >> 8;
  for (int t = blockIdx.x; t < T; t += gridDim.x) {
    for (int i = tid; i < D; i += NTHR) xs[i] = bf2f(HN[(size_t)t * D + i]);
    __syncthreads();
    float y0 = 0.f, y1 = 0.f;
    for (int k = 0; k < 2; ++k) {
      const int e = EXPI[t * 2 + k]; const float gt = GATE[t * 2 + k];
      const float* W13 = (half ? w3 : w1) + (size_t)e * D * 256; const float* W2 = w2 + (size_t)e * 256 * D;
      float a = 0.f;
      for (int i = 0; i < D; ++i) a += xs[i] * W13[(size_t)i * 256 + j];
      sa[tid] = a;
      __syncthreads();
      if (tid < 256) { const float av = sa[tid], cv = sa[256 + tid]; hid[tid] = av / (1.f + expf(-av)) * cv * gt; }
      __syncthreads();
      for (int jj = 0; jj < 256; ++jj) { const float hv = hid[jj]; y0 += hv * W2[(size_t)jj * D + tid]; y1 += hv * W2[(size_t)jj * D + tid + 512]; }
      __syncthreads();
    }
    hio[(size_t)t * D + tid] += y0; hio[(size_t)t * D + tid + 512] += y1;
  }
}

struct Args { const float* in[20]; float* out; unsigned char* ws; int ph_lo, ph_hi, li, pad; };

__global__ void __launch_bounds__(NTHR, 2) mk_fwd(Args args) {
  extern __shared__ __attribute__((aligned(16))) unsigned char lds_raw[];
  LAS unsigned char* lds = (LAS unsigned char*)lds_raw;
  volatile LAS unsigned* MISC = (volatile LAS unsigned*)(lds + MISC_OFF);
  const int tid = opq_tid(), lane = tid & 63, wave = __builtin_amdgcn_readfirstlane(tid >> 6);
  const int G = gridDim.x;
  unsigned char* ws = args.ws;
  gu32* ctl = (gu32*)(ws + WS_CTL);
  for (int u = tid; u < (LDS_BYTES - LDSCTL_OFF) / 4; u += NTHR) ((LAS unsigned*)(lds + LDSCTL_OFF))[u] = 0u;
  __syncthreads();
  XcdBarrier bar = xcd_barrier_post((unsigned*)(ctl + CW_BAR) + args.li * XCD_BAR_WORDS, MISC + 8);
  const int lo = args.ph_lo, hi = args.ph_hi;
#define IN(k) (lo <= (k) && (k) < hi)
#define SEAM(k) do { if (IN(k) && IN((k) + 1)) xcd_barrier(bar); } while (0)
  const float* x = args.in[0]; float* out = args.out;
  bf16* Win_t = (bf16*)(ws + WS_WIN); bf16* Wo_t = (bf16*)(ws + WS_WO);
  bf16* ACT = (bf16*)(ws + WS_ACT); bf16* QKV = (bf16*)(ws + WS_QKV); bf16* R8 = (bf16*)(ws + WS_R8); bf16* R9 = (bf16*)(ws + WS_R9);
  float* LF = (float*)(ws + WS_LF); float* CUM = (float*)(ws + WS_CUM); int* EXPI = (int*)(ws + WS_EXP); float* GATE = (float*)(ws + WS_GATE);
  const int gw = blockIdx.x * NWAVES + wave, NGW = G * NWAVES;

  if (IN(0)) {
    LAS float* scr = (LAS float*)(lds + wave * 16384);
    constexpr int I_WIN = (NP / 32) * (D / 64), I_WO = (D / 32) * (D / 64);
    constexpr int NITEMS = NL * (I_WIN + I_WO);
    for (int it = gw; it < NITEMS; it += NGW) {
      int r = it;
      if (r < NL * I_WIN) { const int l = r / I_WIN; r %= I_WIN; const int ng = r / (D / 64), kb = r % (D / 64); int sc, nv; win_src(ng * 32, sc, nv);
        tr_item(args.in[2] + (size_t)l * D * NW, NW, sc, nv, Win_t + (size_t)l * NP * D, D, ng * 32, kb * 64, scr, lane); continue; }
      r -= NL * I_WIN;
      { const int l = r / I_WO; r %= I_WO; const int ng = r / (D / 64), kb = r % (D / 64);
        tr_item(args.in[11] + (size_t)l * D * D, D, ng * 32, 32, Wo_t + (size_t)l * D * D, D, ng * 32, kb * 64, scr, lane); }
    }
    prep_rows(x, nullptr, nullptr, nullptr, ACT, args.in[1], gw, NGW, lane);
  }
  SEAM(0);
  for (int l = 0; l < NL; ++l) {
    const int pb = 1 + 8 * l;
    if (IN(pb)) {
      pg8::Gemm g{ACT, Win_t + (size_t)l * NP * D, T, NP, D}; pg8::StaticOrder So; So.init(T, NP, G, (int)blockIdx.x);
      EpiInProj E{QKV, R8, R9, LF, args.in[7] + l * 256, args.in[8] + l * 256, args.in[9] + l * 4};
      pg8::gemm_phase<EpiInProj, pg8::StaticOrder, true, true>(lds, g, So, E);
    }
    SEAM(pb);
    if (IN(pb + 1)) {
      n_post(lds, R8, R9, args.in[3] + l * 192, args.in[4] + l * 128, args.in[5] + (size_t)l * 192 * 256, args.in[6] + (size_t)l * 128 * 384, args.in[7] + l * 256, args.in[8] + l * 256,
             QKV + (size_t)IQA * QKV_STRIDE, QKV + (size_t)IKA * QKV_STRIDE, QKV + (size_t)IVA * QKV_STRIDE);
      n_cumsum(lds, LF, CUM);
    }
    SEAM(pb + 1);
    if (IN(pb + 2)) n_attn(QKV, CUM, args.in[10] + l * 4, ACT, 15);
    SEAM(pb + 2);
    if (IN(pb + 3)) n_wo(lds, ACT, args.in[11] + (size_t)l * D * D, l == 0 ? x : out, out);
    SEAM(pb + 3);
    if (IN(pb + 4)) n_route(out, args.in[12] + l * D, args.in[13] + (size_t)l * D * 4, args.in[14] + l * 4, args.in[15] + (size_t)l * D * 32, args.in[16] + l * 32, ACT, EXPI, GATE);
    SEAM(pb + 4);
    if (IN(pb + 5)) n_moe(lds, ACT, EXPI, GATE, args.in[17] + (size_t)l * 32 * D * 256, args.in[18] + (size_t)l * 32 * D * 256, args.in[19] + (size_t)l * 32 * 256 * D, out);
    SEAM(pb + 5);
    SEAM(pb + 6);
    if (IN(pb + 7)) { if (l + 1 < NL) prep_rows(out, nullptr, nullptr, nullptr, ACT, args.in[1] + (l + 1) * D, gw, NGW, lane); }
    SEAM(pb + 7);
  }
#undef IN
#undef SEAM
}
}

#ifndef MK_N_LAUNCHES
#define MK_N_LAUNCHES 17
#endif
extern "C" void kernel_launch(void* const* d_in, const int* in_sizes, int n_in, void* d_out, int out_size, void* d_ws, size_t ws_size, hipStream_t stream) {
  using namespace mk;
  static int grid = 0;
  if (grid == 0) {
    if (n_in != 20 || out_size != T * D || ws_size < WS_END) { fprintf(stderr, "kernel_launch: unexpected shapes (n_in %d out %d ws %zu)\n", n_in, out_size, ws_size); grid = -1; return; }
    int dev = 0, cus = 0;
    if (hipGetDevice(&dev) != hipSuccess || hipDeviceGetAttribute(&cus, hipDeviceAttributeMultiprocessorCount, dev) != hipSuccess) { grid = -1; return; }
    if (hipFuncSetAttribute((const void*)mk_fwd, hipFuncAttributeMaxDynamicSharedMemorySize, LDS_BYTES) != hipSuccess) { grid = -1; return; }
    grid = cus;
  }
  if (grid < 0) return;
  (void)hipMemsetAsync((char*)d_ws + WS_CTL, 0, CTL_ZERO_BYTES, stream);
  Args a{};
  for (int i = 0; i < 20; ++i) a.in[i] = (const float*)d_in[i];
  a.out = (float*)d_out; a.ws = (unsigned char*)d_ws;
  constexpr int NLA = MK_N_LAUNCHES;
  for (int li = 0; li < NLA; ++li) {
    a.ph_lo = (int)((long)NPHASE * li / NLA); a.ph_hi = (int)((long)NPHASE * (li + 1) / NLA); a.li = li;
    hipLaunchKernelGGL(mk_fwd, dim3(grid), dim3(NTHR), LDS_BYTES, stream, a);
  }
}
```

```cpp
#include <hip/hip_runtime.h>
#include <cstdio>
#include <cstdint>
#include <cmath>
__device__ __forceinline__ int opq_tid() { int t = threadIdx.x; asm volatile("" : "+v"(t)); return t; }
__device__ __forceinline__ int opq_bid() { int t = blockIdx.x; asm volatile("" : "+s"(t)); return t; }
namespace pg8 {
#define PG8_LAS __attribute__((address_space(3)))
typedef unsigned short bf16_t;
typedef short bf16x8 __attribute__((ext_vector_type(8)));
typedef float f32x4 __attribute__((ext_vector_type(4)));
typedef unsigned u32x4 __attribute__((ext_vector_type(4)));
constexpr int BM = 256, BK = 64, HALF = 128, HTB = HALF * BK * 2  , STAGE_BYTES = 8 * HTB, NXCD = 8, WGM = 8;

__host__ __device__ __forceinline__ int lds_byte(int r, int c) { const int st = (r >> 4) * 2 + (c >> 5), rr = r & 15, cc = c & 31, ob = rr * 64 + cc * 2; return st * 1024 + (ob ^ (((ob >> 9) & 1) << 5)); }
__host__ __device__ __forceinline__ void stage_rc(int b, int& R, int& C) { const int st = b / 1024, sb = b % 1024, swz = sb ^ (((sb >> 9) & 1) << 5); R = (st >> 1) * 16 + swz / 64; C = (st & 1) * 32 + (swz % 64) / 2; }
__host__ __device__ __forceinline__ int perm32(int rho) { const int n = rho >> 4, i = rho & 15; return 8 * (i >> 2) + 4 * n + (i & 3); }

struct Unit { int pm, pn; };
struct Gemm { const bf16_t* A; const bf16_t* Bt; int M, N, K; };

struct StaticOrder {
    int nM, nN, nwg, G, c;
    __host__ __device__ void init(int M, int N, int G_, int c_) { nM = M / BM; nN = N / BM; nwg = nM * nN; G = G_; c = c_; }
    __host__ __device__ bool next(int i, Unit& u) const {
        const long L = (long)i * G + c; if (L >= nwg) return false;
        int wgid = (int)L; { const int q = nwg / NXCD, r = nwg % NXCD, xcd = wgid % NXCD, off = wgid / NXCD; wgid = (xcd < r ? xcd * (q + 1) : r * (q + 1) + (xcd - r) * q) + off; }
        const int nig = WGM * nN, gid = wgid / nig, fm = gid * WGM, gsz = (nM - fm) < WGM ? (nM - fm) : WGM;
        u.pm = fm + ((wgid % nig) % gsz); u.pn = (wgid % nig) / gsz; return true;
    }
    __device__ __forceinline__ void a_ready(const Unit&) const {}
    __device__ __forceinline__ void done(const Unit&) const {}
};

__device__ __forceinline__ unsigned cvt_pk_bf16(float lo, float hi) { unsigned r; asm volatile("v_cvt_pk_bf16_f32 %0, %1, %2" : "=v"(r) : "v"(lo), "v"(hi)); return r; }
typedef float f32x2 __attribute__((ext_vector_type(2)));
__device__ __forceinline__ f32x2 gelu_pk(f32x2 v) {
    const f32x2 av = __builtin_elementwise_abs(v), d = av * 0.2316418882f + 1.0f;
    f32x2 t; t.x = __builtin_amdgcn_rcpf(d.x); t.y = __builtin_amdgcn_rcpf(d.y);
    f32x2 q = t * 0.5307027145f + (-0.7265760135f); q = q * t + 0.7107068705f; q = q * t + (-0.142248368f); q = q * t + 0.127414796f; q = q * t;
    const f32x2 s = (v * v) * (-0.72134752044f);
    f32x2 e; e.x = __builtin_amdgcn_exp2f(s.x); e.y = __builtin_amdgcn_exp2f(s.y);
    const f32x2 m = v * (q * e), r = v - m;
    f32x2 o; o.x = v.x < 0.f ? m.x : r.x; o.y = v.y < 0.f ? m.y : r.y; return o;
}

template <int ACT  > struct EpiBf16 {
    static constexpr bool PERM = true, AFTER_DRAIN = false; static_assert(ACT == 0 || ACT == 1, "EpiBf16: ACT is 0 (none) or 1 (gelu_pk)");
    bf16_t* O; int ldc; const float* bias; int split_cols; size_t split_stride; float scale0;
    __device__ __forceinline__ void operator()(const f32x4 (&acc)[2][2][4][2], const Unit& u, int wr, int wc, int fr, int fq) const {
        const int row0 = u.pm * BM + wr * 64 + fr; int colt = u.pn * BM; bf16_t* base = O;
        float sc = 1.f; if (split_cols) { const int t = colt / split_cols; base += (size_t)t * split_stride; colt -= t * split_cols; if (t == 0) sc = scale0; }
        const int col0 = colt + wc * 32 + 8 * fq, bcol0 = u.pn * BM + wc * 32 + 8 * fq;
        f32x4 bv[2][2];
#pragma unroll
        for (int bj = 0; bj < 2; ++bj)
#pragma unroll
            for (int n = 0; n < 2; ++n) bv[bj][n] = bias ? *(const f32x4*)(bias + bcol0 + bj * HALF + 4 * n) : (f32x4){0.f, 0.f, 0.f, 0.f};
#pragma unroll
        for (int ai = 0; ai < 2; ++ai)
#pragma unroll
            for (int m = 0; m < 4; ++m) { bf16_t* rowp = base + (size_t)(row0 + ai * HALF + m * 16) * ldc + col0;
#pragma unroll
                for (int bj = 0; bj < 2; ++bj) { f32x4 v0 = acc[ai][bj][m][0] + bv[bj][0], v1 = acc[ai][bj][m][1] + bv[bj][1];
                    if (ACT == 1) { f32x2 a = gelu_pk((f32x2){v0[0], v0[1]}), b = gelu_pk((f32x2){v0[2], v0[3]}), c = gelu_pk((f32x2){v1[0], v1[1]}), d = gelu_pk((f32x2){v1[2], v1[3]});
                        v0 = (f32x4){a.x, a.y, b.x, b.y}; v1 = (f32x4){c.x, c.y, d.x, d.y}; }
                    v0 = v0 * sc; v1 = v1 * sc; u32x4 w; w.x = cvt_pk_bf16(v0[0], v0[1]); w.y = cvt_pk_bf16(v0[2], v0[3]); w.z = cvt_pk_bf16(v1[0], v1[1]); w.w = cvt_pk_bf16(v1[2], v1[3]);
                    *(u32x4*)(rowp + bj * HALF) = w; } }
    }
};
template <class Epi, class Sched, bool ALIGN_EPI = false, bool SP2 = false>
__device__ __forceinline__ void gemm_phase(PG8_LAS unsigned char* lds, const Gemm g, const Sched& S, const Epi& E) {
    const int tid = opq_tid(), wid = __builtin_amdgcn_readfirstlane(tid >> 6), lane = tid & 63, wr = wid >> 2, wc = wid & 3, fr = lane & 15, fq = lane >> 4;
    const int K = g.K, nt = K / BK;
    unsigned voffA[2], voffB[2];
#pragma unroll
    for (int i = 0; i < 2; ++i) { int R, C; stage_rc(tid * 16 + i * 8192, R, C); const int Rb = Epi::PERM ? ((R & ~31) + perm32(R & 31)) : R;
        voffA[i] = (unsigned)(R * K + C) * 2u; voffB[i] = (unsigned)(Rb * K + C) * 2u; }
    const size_t kstep = (size_t)(BK * 2);
    const size_t hstep = (size_t)HALF * K * 2;
    const size_t tstep = 2 * hstep;
    const unsigned ldsw = (unsigned)wid * 1024u;
    const int aoff = lds_byte(wr * 64 + fr, fq * 8), boff = lds_byte(wc * 32 + fr, fq * 8);
#define PG8_SA(b, h) (((b) * 2 + (h)) * HTB)
#define PG8_SB(b, h) ((4 + (b) * 2 + (h)) * HTB)
#define PG8_STAGE(bufoff, gbase, voff) do { _Pragma("unroll") for (int _i = 0; _i < 2; ++_i) \
        __builtin_amdgcn_global_load_lds((const unsigned*)((const char*)(gbase) + (voff)[_i]), (PG8_LAS unsigned*)(lds + (bufoff) + ldsw + _i * 8192), 16, 0, 0); } while (0)
#define PG8_LDA(dst, b, h) do { _Pragma("unroll") for (int m = 0; m < 4; ++m) _Pragma("unroll") for (int k = 0; k < 2; ++k) dst[m][k] = *(const PG8_LAS bf16x8*)(lds + PG8_SA(b, h) + aoff + m * 2048 + k * 1024); } while (0)
#define PG8_LDB(dst, b, h) do { _Pragma("unroll") for (int n = 0; n < 2; ++n) _Pragma("unroll") for (int k = 0; k < 2; ++k) dst[n][k] = *(const PG8_LAS bf16x8*)(lds + PG8_SB(b, h) + boff + n * 2048 + k * 1024); } while (0)
#define PG8_MMA(ai, bj, At, Bt) do { __builtin_amdgcn_s_setprio(1); _Pragma("unroll") for (int m = 0; m < 4; ++m) _Pragma("unroll") for (int n = 0; n < 2; ++n) _Pragma("unroll") for (int k = 0; k < 2; ++k) \
        acc[ai][bj][m][n] = __builtin_amdgcn_mfma_f32_16x16x32_bf16(Bt[n][k], At[m][k], acc[ai][bj][m][n], 0, 0, 0); __builtin_amdgcn_s_setprio(0); } while (0)
#define PG8_WAIT_V(n) asm volatile("s_waitcnt vmcnt(" #n ")" ::: "memory")
#define PG8_WAIT_L(n) asm volatile("s_waitcnt lgkmcnt(" #n ")" ::: "memory")
#define PG8_BAR __builtin_amdgcn_s_barrier()
#define PG8_SCHED __builtin_amdgcn_sched_barrier(0)
    Unit cur, nxt; int ui = 0;
    if (!S.next(0, cur)) return;
    f32x4 acc[2][2][4][2];
#pragma unroll
    for (int a = 0; a < 2; ++a)
#pragma unroll
        for (int b = 0; b < 2; ++b)
#pragma unroll
            for (int m = 0; m < 4; ++m)
#pragma unroll
                for (int n = 0; n < 2; ++n) acc[a][b][m][n] = (f32x4){0.f, 0.f, 0.f, 0.f};
    bf16x8 At[4][2], B0[2][2], B1[2][2];
    const char* cA = (const char*)g.A + (size_t)cur.pm * tstep; const char* cB = (const char*)g.Bt + (size_t)cur.pn * tstep;
    S.a_ready(cur);
    if constexpr (SP2) {
        PG8_STAGE(PG8_SB(0, 0), cB, voffB); PG8_STAGE(PG8_SB(0, 1), cB + hstep, voffB); PG8_STAGE(PG8_SA(0, 0), cA, voffA); PG8_STAGE(PG8_SA(0, 1), cA + hstep, voffA);
        if (wr == 1) PG8_BAR;
        PG8_WAIT_V(2); PG8_BAR;
        PG8_STAGE(PG8_SB(1, 0), cB + kstep, voffB); PG8_STAGE(PG8_SA(1, 0), cA + kstep, voffA); PG8_STAGE(PG8_SB(1, 1), cB + hstep + kstep, voffB);
        PG8_WAIT_V(6); PG8_BAR;
    } else {
        PG8_STAGE(PG8_SB(0, 0), cB, voffB); PG8_STAGE(PG8_SA(0, 0), cA, voffA); PG8_STAGE(PG8_SB(0, 1), cB + hstep, voffB); PG8_STAGE(PG8_SA(0, 1), cA + hstep, voffA);
        if (wr == 1) PG8_BAR;
        PG8_WAIT_V(4); PG8_BAR;
        PG8_STAGE(PG8_SB(1, 0), cB + kstep, voffB); PG8_STAGE(PG8_SA(1, 0), cA + kstep, voffA); PG8_STAGE(PG8_SB(1, 1), cB + hstep + kstep, voffB);
        PG8_WAIT_V(6); PG8_BAR;
    }
    for (;;) {
        const bool has_next = S.next(ui + 1, nxt);
        const char* nA = has_next ? (const char*)g.A + (size_t)nxt.pm * tstep : cA; const char* nB = has_next ? (const char*)g.Bt + (size_t)nxt.pn * tstep : cB;
        for (int t = 0; t < nt; t += 2) {
            const bool last = (t == nt - 2);
            const char* a1 = cA + (size_t)(t + 1) * kstep;
            const char* a2 = last ? nA : cA + (size_t)(t + 2) * kstep; const char* b2 = last ? nB : cB + (size_t)(t + 2) * kstep;
            const char* a3 = a2 + kstep; const char* b3 = b2 + kstep;
            if (last && has_next) S.a_ready(nxt);
            if constexpr (SP2) {
            PG8_LDB(B0, 0, 0); PG8_LDB(B1, 0, 1); PG8_SCHED; PG8_LDA(At, 0, 0); PG8_STAGE(PG8_SA(1, 1), a1 + hstep, voffA);
            PG8_WAIT_V(8); PG8_WAIT_L(0); PG8_BAR; PG8_MMA(0, 0, At, B0); PG8_MMA(0, 1, At, B1); PG8_BAR; PG8_SCHED;
            PG8_LDA(At, 0, 1); PG8_STAGE(PG8_SB(0, 0), b2, voffB); PG8_STAGE(PG8_SB(0, 1), b2 + hstep, voffB); PG8_STAGE(PG8_SA(0, 0), a2, voffA);
            PG8_WAIT_V(8); PG8_WAIT_L(0); PG8_BAR; PG8_MMA(1, 0, At, B0); PG8_MMA(1, 1, At, B1); PG8_BAR; PG8_SCHED;
            PG8_LDB(B0, 1, 0); PG8_LDB(B1, 1, 1); PG8_SCHED; PG8_LDA(At, 1, 0); PG8_STAGE(PG8_SA(0, 1), a2 + hstep, voffA);
            PG8_WAIT_V(8); PG8_WAIT_L(0); PG8_BAR; PG8_MMA(0, 0, At, B0); PG8_MMA(0, 1, At, B1); PG8_BAR; PG8_SCHED;
            PG8_LDA(At, 1, 1); PG8_STAGE(PG8_SB(1, 0), b3, voffB); PG8_STAGE(PG8_SB(1, 1), b3 + hstep, voffB); PG8_STAGE(PG8_SA(1, 0), a3, voffA);
            PG8_WAIT_V(8); PG8_WAIT_L(0); PG8_BAR; PG8_MMA(1, 0, At, B0); PG8_MMA(1, 1, At, B1); PG8_BAR; PG8_SCHED;
            } else {
            PG8_LDB(B0, 0, 0); PG8_SCHED; PG8_LDA(At, 0, 0); PG8_STAGE(PG8_SA(1, 1), a1 + hstep, voffA);
            PG8_WAIT_L(8); PG8_BAR; PG8_WAIT_L(0); PG8_MMA(0, 0, At, B0); PG8_BAR; PG8_SCHED;
            PG8_LDB(B1, 0, 1); PG8_STAGE(PG8_SB(0, 0), b2, voffB);
            PG8_BAR; PG8_WAIT_L(0); PG8_MMA(0, 1, At, B1); PG8_BAR;
            PG8_LDA(At, 0, 1); PG8_STAGE(PG8_SA(0, 0), a2, voffA);
            PG8_BAR; PG8_WAIT_L(0); PG8_MMA(1, 0, At, B0); PG8_BAR; PG8_SCHED;
            PG8_STAGE(PG8_SB(0, 1), b2 + hstep, voffB);
            PG8_WAIT_V(6); PG8_BAR; PG8_MMA(1, 1, At, B1); PG8_BAR;
            PG8_LDB(B0, 1, 0); PG8_SCHED; PG8_LDA(At, 1, 0); PG8_STAGE(PG8_SA(0, 1), a2 + hstep, voffA);
            PG8_WAIT_L(8); PG8_BAR; PG8_WAIT_L(0); PG8_MMA(0, 0, At, B0); PG8_BAR; PG8_SCHED;
            PG8_LDB(B1, 1, 1); PG8_STAGE(PG8_SB(1, 0), b3, voffB);
            PG8_BAR; PG8_WAIT_L(0); PG8_MMA(0, 1, At, B1); PG8_BAR;
            PG8_LDA(At, 1, 1); PG8_STAGE(PG8_SA(1, 0), a3, voffA);
            PG8_BAR; PG8_WAIT_L(0); PG8_MMA(1, 0, At, B0); PG8_BAR; PG8_SCHED;
            PG8_STAGE(PG8_SB(1, 1), b3 + hstep, voffB);
            PG8_WAIT_V(6); PG8_BAR; PG8_MMA(1, 1, At, B1); PG8_BAR;
            }
        }
        if constexpr (ALIGN_EPI) { if (wr == 0) PG8_BAR; }
        if constexpr (!Epi::AFTER_DRAIN) { E(acc, cur, wr, wc, fr, fq); S.done(cur); }
        if (!has_next) break;
#pragma unroll
        for (int a = 0; a < 2; ++a)
#pragma unroll
            for (int b = 0; b < 2; ++b)
#pragma unroll
                for (int m = 0; m < 4; ++m)
#pragma unroll
                    for (int n = 0; n < 2; ++n) acc[a][b][m][n] = (f32x4){0.f, 0.f, 0.f, 0.f};
        cur = nxt; cA = nA; cB = nB; ++ui;
        if constexpr (ALIGN_EPI) { if (wr == 1) PG8_BAR; }
    }
    PG8_WAIT_V(0);
    if constexpr (!ALIGN_EPI) { if (wr == 0) PG8_BAR; }
    PG8_BAR;
    if constexpr (Epi::AFTER_DRAIN) { E.fused(acc, cur, wr, wc, fr, fq, lds, wid, lane); S.done(cur); }
#undef PG8_SA
#undef PG8_SB
#undef PG8_STAGE
#undef PG8_LDA
#undef PG8_LDB
#undef PG8_MMA
#undef PG8_WAIT_V
#undef PG8_WAIT_L
#undef PG8_BAR
#undef PG8_SCHED
}
}

#ifndef PG8_SP2
#define PG8_SP2 true
#endif
#ifndef PG8_ALIGN
#define PG8_ALIGN true
#endif
#define GAS __attribute__((address_space(1)))
#define LAS __attribute__((address_space(3)))
typedef unsigned short bf16;
typedef unsigned v4u __attribute__((ext_vector_type(4)));
typedef float f32x4 __attribute__((ext_vector_type(4)));
typedef short bf16x8 __attribute__((ext_vector_type(8)));
typedef GAS unsigned gu32;
typedef GAS unsigned long long gu64;
#define RLX_AGENT __ATOMIC_RELAXED, __HIP_MEMORY_SCOPE_AGENT
#define LDS_WAIT() asm volatile("s_waitcnt lgkmcnt(0)" ::: "memory")
#define VM_WAIT() asm volatile("s_waitcnt vmcnt(0)" ::: "memory")
__device__ __forceinline__ unsigned long long rt() { return __builtin_amdgcn_s_memrealtime(); }
__device__ __forceinline__ unsigned f2bf(float f) { unsigned u = __builtin_bit_cast(unsigned, f); return (u + 0x7fffu + ((u >> 16) & 1u)) >> 16; }
__device__ __forceinline__ unsigned pk2(float lo, float hi) { return f2bf(lo) | (f2bf(hi) << 16); }

#define XB_TMO      128
#define XB_XCNT(j)  (256  + 64 * (j))
#define XB_XSUB(j)  (1280 + 64 * (j))
#define XB_XGEN(j)  (2304 + 64 * (j))
#define XB_TOP      3328
#define XB_TOPGEN   3392
#define XCD_BAR_WORDS 3456
#define XB_SPIN_CAP (1u << 24)

__device__ __forceinline__ unsigned xb_ld(unsigned* p)              { return __hip_atomic_load(p, __ATOMIC_RELAXED, __HIP_MEMORY_SCOPE_AGENT); }
__device__ __forceinline__ unsigned xb_add(unsigned* p, unsigned v) { return __hip_atomic_fetch_add(p, v, __ATOMIC_RELAXED, __HIP_MEMORY_SCOPE_AGENT); }
__device__ __forceinline__ unsigned xb_xcc_id() { return (unsigned)__builtin_amdgcn_s_getreg((3 << 11) | 20) & 0xFu; }
#define XB_SPIN(cond, bar) do { unsigned _sp = 0; while (cond) { __builtin_amdgcn_s_sleep(1); \
    if ((++_sp & 255u) == 0u) { if (xb_ld(&(bar)[XB_TMO])) break; if (_sp > XB_SPIN_CAP) { atomicAdd(&(bar)[XB_TMO], 1u); break; } } } } while (0)

struct XcdBarrier {
    unsigned* bar; unsigned x;
    volatile LAS unsigned* st;
};

__device__ __forceinline__ XcdBarrier xcd_barrier_post(unsigned* bar, volatile LAS unsigned* st) {
    XcdBarrier b; b.bar = bar; b.x = xb_xcc_id(); b.st = st;
    if (threadIdx.x == 0) (void)xb_add(&bar[XB_XCNT(b.x)], 1u);
    return b;
}
__device__ __forceinline__ void xcd_barrier_complete(unsigned* bar, unsigned x, unsigned& nloc, unsigned& nx) {
    const unsigned G = gridDim.x * gridDim.y * gridDim.z;
    unsigned sum, cnt, mine, sp = 0u;
    for (;;) {
        sum = 0u; cnt = 0u; mine = 0u;
#pragma unroll
        for (unsigned j = 0; j < 16; ++j) { const unsigned c = xb_ld(&bar[XB_XCNT(j)]); sum += c; cnt += (c > 0u) ? 1u : 0u; mine = (j == x) ? c : mine; }
        if (sum == G) break;
        __builtin_amdgcn_s_sleep(1);
        if ((++sp & 255u) == 0u) { if (xb_ld(&bar[XB_TMO])) break; if (sp > XB_SPIN_CAP) { atomicAdd(&bar[XB_TMO], 1u); break; } }
    }
    nloc = mine > 0u ? mine : 1u; nx = cnt > 0u ? cnt : 1u;
}

__device__ __forceinline__ void xcd_barrier(const XcdBarrier& b) {
    asm volatile("s_waitcnt vmcnt(0)" ::: "memory");
    __syncthreads();
    if (threadIdx.x == 0) {
        unsigned* bar = b.bar;
        __builtin_amdgcn_s_waitcnt(0);
        unsigned nloc = b.st[0], nx = b.st[1];
        if (nloc == 0u) { xcd_barrier_complete(bar, b.x, nloc, nx); b.st[0] = nloc; b.st[1] = nx; }
        const unsigned old = xb_add(&bar[XB_XSUB(b.x)], 1u);
        const unsigned gen = old / nloc;
        if (old + 1u == (gen + 1u) * nloc) {
            __builtin_amdgcn_fence(__ATOMIC_RELEASE, "agent");
            asm volatile("s_waitcnt vmcnt(0)" ::: "memory");
            const unsigned og = xb_add(&bar[XB_TOP], 1u);
            const unsigned tg = og / nx;
            if (og + 1u == (tg + 1u) * nx) xb_add(&bar[XB_TOPGEN], 1u);
            else XB_SPIN(xb_ld(&bar[XB_TOPGEN]) == tg, bar);
            __builtin_amdgcn_fence(__ATOMIC_ACQUIRE, "agent");
            xb_add(&bar[XB_XGEN(b.x)], 1u);
            asm volatile("s_waitcnt vmcnt(0)" ::: "memory");
        } else {
            XB_SPIN(xb_ld(&bar[XB_XGEN(b.x)]) == gen, bar);
            __builtin_amdgcn_fence(__ATOMIC_ACQUIRE, "agent");
            asm volatile("s_waitcnt vmcnt(0)" ::: "memory");
        }
    }
    __syncthreads();
}
namespace mk {
constexpr int NB = 2, S = 8192, D = 1024, T = NB * S, NL = 2, NW = 2404, NP = 2560;
constexpr int OFF_CQ = 0, OFF_CKV = 192, OFF_KR = 320, OFF_PB = 352, OFF_PC = 1120, OFF_FG = 1888, OFF_PDQ = 1892, OFF_PDKV = 2148;
constexpr float EPS = 1e-6f, LOG2E = 1.4426950408889634f, C2 = 0.125f * 1.4426950408889634f;
constexpr int NWAVES = 8, NTHR = 512;
constexpr size_t MiB = 1u << 20;
constexpr size_t WS_CTL = 0, CTL_ZERO_BYTES = 1 * MiB;
constexpr size_t WS_WIN = 1 * MiB;
constexpr size_t WS_WO = 11 * MiB;
constexpr size_t WS_WUQ = 15 * MiB;
constexpr size_t WS_WUKV = 15 * MiB + MiB / 2;
constexpr size_t WS_W13 = 16 * MiB;
constexpr size_t WS_W2 = 80 * MiB;
constexpr size_t WS_ACT = 112 * MiB;
constexpr size_t WS_QKV = 144 * MiB;
constexpr size_t WS_R8 = 232 * MiB, WS_R9 = 240 * MiB;
constexpr size_t WS_LF = 248 * MiB, WS_CUM = WS_LF + MiB / 4, WS_EXP = 249 * MiB, WS_GATE = WS_EXP + MiB / 4;
constexpr size_t WS_END = 250 * MiB;
constexpr size_t QKV_STRIDE = (size_t)T * 256;
enum { IQA = 0, IKA, IVA, IQB, IKB, IVB, IQC, IKC, IVC, IQD };
constexpr int CW_BAR = 4096;
constexpr int RING_BYTES = 131072, LDSCTL_OFF = RING_BYTES, MISC_OFF = LDSCTL_OFF + 320, LDS_BYTES = 147456;
constexpr int NPHASE = 1 + 8 * NL;

__device__ __forceinline__ float bf2f(bf16 v) { return __uint_as_float((unsigned)v << 16); }
__device__ __forceinline__ float wave_sum(float v) {
#pragma unroll
  for (int o = 32; o; o >>= 1) v += __shfl_xor(v, o);
  return v;
}
__device__ __forceinline__ float log_sigmoid(float x) { return fminf(x, 0.f) - log1pf(expf(-fabsf(x))); }

__device__ __forceinline__ void tr_item(const float* W, int ldw, int srccol0, int nvalid, bf16* WT, int K, int dstrow0, int k0, LAS float* scr, int lane) {
  const int n_ = lane & 31;
#pragma unroll 8
  for (int i = 0; i < 32; ++i) { const int kk = 2 * i + (lane >> 5); scr[kk * 33 + n_] = (n_ < nvalid) ? W[(size_t)(k0 + kk) * ldw + srccol0 + n_] : 0.f; }
  LDS_WAIT(); asm volatile("" ::: "memory");
  const int c = lane & 7;
#pragma unroll
  for (int j = 0; j < 4; ++j) { const int n = (lane >> 3) + 8 * j; const LAS float* s = scr + (8 * c) * 33 + n;
    v4u o; o.x = pk2(s[0 * 33], s[1 * 33]); o.y = pk2(s[2 * 33], s[3 * 33]); o.z = pk2(s[4 * 33], s[5 * 33]); o.w = pk2(s[6 * 33], s[7 * 33]);
    *(GAS v4u*)(WT + (size_t)(dstrow0 + n) * K + k0 + 8 * c) = o; }
  LDS_WAIT(); asm volatile("" ::: "memory");
}
__device__ __forceinline__ void win_src(int n0, int& sc, int& nv) {
  const int pn = n0 >> 8, p = n0 & 255, lc = 64 * ((p >> 5) & 3) + 32 * (p >> 7);
  nv = 32; sc = 0;
  if (pn < 3) sc = OFF_PB + pn * 256 + lc;
  else if (pn < 6) sc = OFF_PC + (pn - 3) * 256 + lc;
  else if (pn == 6) sc = OFF_PDQ + lc;
  else if (pn == 7) sc = OFF_PDKV + lc;
  else if (pn == 8) { sc = OFF_CQ + lc; if (lc >= 192) { nv = 0; sc = 0; } }
  else { if (lc < 128) sc = OFF_CKV + lc; else if (lc < 160) sc = OFF_KR + lc - 128; else if (lc < 192) { sc = OFF_FG; nv = 4; } else { sc = 0; nv = 0; } }
}
__device__ __forceinline__ void prep_rows(const float* X, const bf16* y0, const bf16* y1, float* xout, bf16* XN, const float* g1, int gw, int NGW, int lane) {
  for (int m = gw; m < T; m += NGW) {
    const GAS f32x4* xr = (const GAS f32x4*)(X + (size_t)m * D) + lane;
    f32x4 v[4]; float ss = 0.f;
#pragma unroll
    for (int j = 0; j < 4; ++j) {
      v[j] = xr[64 * j];
      if (y0) {
        const unsigned long long a = *((const GAS unsigned long long*)(y0 + (size_t)m * D) + lane + 64 * j), b = *((const GAS unsigned long long*)(y1 + (size_t)m * D) + lane + 64 * j);
        v[j].x += __uint_as_float((unsigned)a << 16) + __uint_as_float((unsigned)b << 16);
        v[j].y += __uint_as_float((unsigned)a & 0xffff0000u) + __uint_as_float((unsigned)b & 0xffff0000u);
        v[j].z += __uint_as_float((unsigned)(a >> 32) << 16) + __uint_as_float((unsigned)(b >> 32) << 16);
        v[j].w += __uint_as_float((unsigned)(a >> 32) & 0xffff0000u) + __uint_as_float((unsigned)(b >> 32) & 0xffff0000u);
      }
      ss += (v[j].x * v[j].x + v[j].y * v[j].y) + (v[j].z * v[j].z + v[j].w * v[j].w);
    }
    if (xout) {
#pragma unroll
      for (int j = 0; j < 4; ++j) ((GAS f32x4*)(xout + (size_t)m * D) + lane)[64 * j] = v[j];
    }
    if (XN) {
      const float rstd = rsqrtf(wave_sum(ss) * (1.f / D) + EPS);
      GAS unsigned long long* o8 = (GAS unsigned long long*)(XN + (size_t)m * D) + lane;
#pragma unroll
      for (int j = 0; j < 4; ++j) { const f32x4 g = *((const GAS f32x4*)g1 + lane + 64 * j);
        o8[64 * j] = (unsigned long long)pk2(v[j].x * rstd * g.x, v[j].y * rstd * g.y) | ((unsigned long long)pk2(v[j].z * rstd * g.z, v[j].w * rstd * g.w) << 32); }
    }
  }
}

struct EpiInProj {
  static constexpr bool PERM = true, AFTER_DRAIN = false;
  bf16* qkv; bf16* R8; bf16* R9; float* LF; const float* gq; const float* gk; const float* bfox;
  __device__ __forceinline__ void operator()(const pg8::f32x4 (&acc)[2][2][4][2], const pg8::Unit& u, int wr, int wc, int fr, int fq) const {
    const int pn = u.pn;
    bf16* dst; int pitch = 256, cb = 64 * wc; const float* g = nullptr; float sc = 1.f;
    if (pn < 6) { dst = qkv + (size_t)(IQB + pn) * QKV_STRIDE; const int r3 = pn % 3, mx = 1 + pn / 3; if (r3 == 0) { g = gq + mx * 64; sc = C2; } else if (r3 == 1) g = gk + mx * 64; }
    else if (pn == 6) { dst = qkv + (size_t)IQD * QKV_STRIDE; g = gq + 3 * 64; sc = C2; }
    else if (pn == 7) { pitch = 128; if (wc < 2) { dst = qkv + 10 * QKV_STRIDE; g = gk + 3 * 64; } else { dst = qkv + 10 * QKV_STRIDE + (size_t)T * 128; cb = 64 * (wc - 2); } }
    else if (pn == 8) dst = R8; else dst = R9;
    const int rowb = u.pm * 256 + wr * 64 + fr;
    if (g) {
      pg8::f32x4 gv[2][2];
#pragma unroll
      for (int bj = 0; bj < 2; ++bj)
#pragma unroll
        for (int n = 0; n < 2; ++n) gv[bj][n] = *(const pg8::f32x4*)(g + 32 * bj + 8 * fq + 4 * n) * sc;
#pragma unroll
      for (int ai = 0; ai < 2; ++ai)
#pragma unroll
        for (int m = 0; m < 4; ++m) {
          float ss = 0.f;
#pragma unroll
          for (int bj = 0; bj < 2; ++bj)
#pragma unroll
            for (int n = 0; n < 2; ++n) { const pg8::f32x4 x = acc[ai][bj][m][n]; ss += (x[0] * x[0] + x[1] * x[1]) + (x[2] * x[2] + x[3] * x[3]); }
          ss += __shfl_xor(ss, 16); ss += __shfl_xor(ss, 32);
          const float rstd = rsqrtf(ss * (1.f / 64.f) + EPS);
          bf16* rp = dst + (size_t)(rowb + ai * 128 + m * 16) * pitch + cb + 8 * fq;
#pragma unroll
          for (int bj = 0; bj < 2; ++bj) { const pg8::f32x4 v0 = acc[ai][bj][m][0] * gv[bj][0] * rstd, v1 = acc[ai][bj][m][1] * gv[bj][1] * rstd;
            pg8::u32x4 w; w.x = pg8::cvt_pk_bf16(v0[0], v0[1]); w.y = pg8::cvt_pk_bf16(v0[2], v0[3]); w.z = pg8::cvt_pk_bf16(v1[0], v1[1]); w.w = pg8::cvt_pk_bf16(v1[2], v1[3]);
            *(pg8::u32x4*)(rp + 32 * bj) = w; }
        }
    } else {
#pragma unroll
      for (int ai = 0; ai < 2; ++ai)
#pragma unroll
        for (int m = 0; m < 4; ++m) {
          bf16* rp = dst + (size_t)(rowb + ai * 128 + m * 16) * pitch + cb + 8 * fq;
#pragma unroll
          for (int bj = 0; bj < 2; ++bj) { const pg8::f32x4 v0 = acc[ai][bj][m][0], v1 = acc[ai][bj][m][1];
            pg8::u32x4 w; w.x = pg8::cvt_pk_bf16(v0[0], v0[1]); w.y = pg8::cvt_pk_bf16(v0[2], v0[3]); w.z = pg8::cvt_pk_bf16(v1[0], v1[1]); w.w = pg8::cvt_pk_bf16(v1[2], v1[3]);
            *(pg8::u32x4*)(rp + 32 * bj) = w; }
        }
      if (pn == 9 && wc == 2 && fq == 0) {
        const pg8::f32x4 bb = *(const pg8::f32x4*)bfox;
#pragma unroll
        for (int ai = 0; ai < 2; ++ai)
#pragma unroll
          for (int m = 0; m < 4; ++m) { const pg8::f32x4 v = acc[ai][1][m][0] + bb; pg8::f32x4 o;
            o[0] = log_sigmoid(v[0]); o[1] = log_sigmoid(v[1]); o[2] = log_sigmoid(v[2]); o[3] = log_sigmoid(v[3]);
            *(pg8::f32x4*)(LF + (size_t)(rowb + ai * 128 + m * 16) * 4) = o; }
      }
    }
  }
};

__device__ __forceinline__ void n_post(LAS unsigned char* lds, const bf16* R8, const bf16* R9, const float* gcq, const float* gckv, const float* wuq, const float* wukv,
                                       const float* gq0, const float* gk0, bf16* QA, bf16* KA, bf16* VA) {
  LAS float* cqn = (LAS float*)lds; LAS float* ckvn = cqn + 192; LAS float* kva = ckvn + 128; LAS float* tmp = kva + 384; LAS float* red = tmp + 256; LAS float* krs = red + 8;
  const int tid = opq_tid(), lane = tid & 63, w = tid >> 6;
  for (int t = blockIdx.x; t < T; t += gridDim.x) {
    const int pos = t % S;
    const float vq = (tid < 192) ? bf2f(R8[(size_t)t * 256 + tid]) : 0.f;
    const float vk = (tid < 128) ? bf2f(R9[(size_t)t * 256 + tid]) : 0.f;
    const float sq = wave_sum(vq * vq), sk = wave_sum(vk * vk);
    if (lane == 0 && w < 4) { red[w] = sq; red[4 + w] = sk; }
    if (tid < 32) krs[tid] = bf2f(R9[(size_t)t * 256 + 128 + tid]);
    __syncthreads();
    const float rq = rsqrtf((red[0] + red[1] + red[2] + red[3]) * (1.f / 192.f) + EPS);
    const float rk = rsqrtf((red[4] + red[5] + red[6] + red[7]) * (1.f / 128.f) + EPS);
    if (tid < 192) cqn[tid] = vq * rq * gcq[tid];
    if (tid < 128) ckvn[tid] = vk * rk * gckv[tid];
    __syncthreads();
    float qa = 0.f, ka = 0.f;
    if (tid < 256) {
      float k0 = 0.f, k1 = 0.f;
      for (int i = 0; i < 192; ++i) qa += cqn[i] * wuq[i * 256 + tid];
      for (int i = 0; i < 128; ++i) { k0 += ckvn[i] * wukv[i * 384 + tid]; if (tid < 128) k1 += ckvn[i] * wukv[i * 384 + 256 + tid]; }
      kva[tid] = k0; if (tid < 128) kva[256 + tid] = k1;
      const float ss = wave_sum(qa * qa);
      qa = qa * rsqrtf(ss * (1.f / 64.f) + EPS) * gq0[lane];
      tmp[tid] = qa;
    }
    __syncthreads();
    float cs = 1.f, sn = 0.f;
    if (tid < 256 && lane >= 32) { const int j = (lane - 32) & 15; const float inv = powf(10000.f, -(float)(2 * j) / 32.f); const float ang = (float)pos * inv; cs = cosf(ang); sn = sinf(ang); }
    if (tid < 256) {
      float o = qa;
      if (lane >= 32) { if (lane < 48) o = qa * cs - tmp[tid + 16] * sn; else o = qa * cs + tmp[tid - 16] * sn; }
      QA[(size_t)t * 256 + tid] = (bf16)f2bf(o * C2);
      ka = (lane < 32) ? kva[w * 96 + lane] : krs[lane - 32];
      const float ss = wave_sum(ka * ka);
      ka = ka * rsqrtf(ss * (1.f / 64.f) + EPS) * gk0[lane];
    }
    __syncthreads();
    if (tid < 256) tmp[tid] = ka;
    __syncthreads();
    if (tid < 256) {
      float o = ka;
      if (lane >= 32) { if (lane < 48) o = ka * cs - tmp[tid + 16] * sn; else o = ka * cs + tmp[tid - 16] * sn; }
      KA[(size_t)t * 256 + tid] = (bf16)f2bf(o);
      VA[(size_t)t * 256 + tid] = (bf16)f2bf(kva[w * 96 + 32 + lane]);
    }
    __syncthreads();
  }
}
__device__ __forceinline__ void n_cumsum(LAS unsigned char* lds, const float* LF, float* CUM) {
  LAS float* part = (LAS float*)lds + 2048;
  const int tid = opq_tid(); constexpr int per = S / NTHR;
  for (int item = blockIdx.x; item < NB * 4; item += gridDim.x) {
    const int b = item >> 2, h = item & 3;
    float s = 0.f;
    for (int i = 0; i < per; ++i) s += LF[((size_t)b * S + tid * per + i) * 4 + h];
    part[tid] = s;
    __syncthreads();
    if (tid == 0) { float a = 0.f; for (int i = 0; i < NTHR; ++i) { const float v = part[i]; part[i] = a; a += v; } }
    __syncthreads();
    float a = part[tid];
    for (int i = 0; i < per; ++i) { a += LF[((size_t)b * S + tid * per + i) * 4 + h]; CUM[((size_t)b * S + tid * per + i) * 4 + h] = a; }
    __syncthreads();
  }
}
struct Soft { float m, l, o; };
__device__ __forceinline__ void soft_add(Soft& st, float logit2, float v) {
  const float mn = fmaxf(st.m, logit2);
  const float a = exp2f(st.m - mn), pp = exp2f(logit2 - mn);
  st.l = st.l * a + pp; st.o = st.o * a + pp * v; st.m = mn;
}
__device__ __forceinline__ void n_attn(const bf16* qkv, const float* CUM, const float* sink, bf16* MIX, int mask) {
  const int tid_ = opq_tid(), lane = tid_ & 63, wpb = NTHR >> 6;
  const long nitems = (long)T * 16;
  for (long it = (long)blockIdx.x * wpb + (tid_ >> 6); it < nitems; it += (long)gridDim.x * wpb) {
    const int t = T - 1 - (int)(it >> 4), mh = (int)(it & 15), mixer = mh >> 2, h = mh & 3;
    if (!((mask >> mixer) & 1)) continue;
    const int b = t / S, pos = t % S; const long base = (long)b * S;
    Soft st; st.m = -INFINITY; st.l = 0.f; st.o = 0.f;
    if (mixer == 0 || mixer == 2) {
      const bf16* Q = qkv + (size_t)(mixer == 0 ? IQA : IQC) * QKV_STRIDE; const bf16* K = Q + QKV_STRIDE; const bf16* V = K + QKV_STRIDE;
      const float q = bf2f(Q[(size_t)t * 256 + h * 64 + lane]);
      const float ct = (mixer == 2) ? CUM[(size_t)t * 4 + h] : 0.f;
      for (int s = 0; s <= pos; ++s) {
        float d = wave_sum(q * bf2f(K[(size_t)(base + s) * 256 + h * 64 + lane]));
        if (mixer == 2) d += (ct - CUM[(size_t)(base + s) * 4 + h]) * LOG2E;
        soft_add(st, d, bf2f(V[(size_t)(base + s) * 256 + h * 64 + lane]));
      }
    } else if (mixer == 3) {
      const bf16* Q = qkv + (size_t)IQD * QKV_STRIDE; const bf16* K = qkv + 10 * QKV_STRIDE; const bf16* V = K + (size_t)T * 128;
      const int hk = h >> 1;
      const float q = bf2f(Q[(size_t)t * 256 + h * 64 + lane]);
      const float slope = exp2f(-(float)(h + 1)) * LOG2E;
      const int s0 = pos - 127 < 0 ? 0 : pos - 127;
      for (int s = s0; s <= pos; ++s) {
        const float d = wave_sum(q * bf2f(K[(size_t)(base + s) * 128 + hk * 64 + lane])) - slope * (float)(pos - s);
        soft_add(st, d, bf2f(V[(size_t)(base + s) * 128 + hk * 64 + lane]));
      }
      const float sk = sink[h] * LOG2E;
      const float mn = fmaxf(st.m, sk), a = exp2f(st.m - mn);
      st.l = st.l * a + exp2f(sk - mn); st.o *= a; st.m = mn;
    } else {
      const bf16* Q = qkv + (size_t)IQB * QKV_STRIDE; const bf16* K = Q + QKV_STRIDE; const bf16* V = K + QKV_STRIDE;
      const float q = bf2f(Q[(size_t)t * 256 + h * 64 + lane]);
      const float slope = exp2f(-(float)(h + 5)) * LOG2E;
      for (int br = 0; br < 3; ++br) {
        const int dil = br == 0 ? 1 : (br == 1 ? 4 : 16);
        for (int j = 0; j <= 128; ++j) {
          const int s = pos - dil * j;
          if (s < 0) break;
          const float d = wave_sum(q * bf2f(K[(size_t)(base + s) * 256 + h * 64 + lane])) - slope * (float)(dil * j);
          soft_add(st, d, bf2f(V[(size_t)(base + s) * 256 + h * 64 + lane]));
        }
      }
    }
    MIX[(size_t)t * D + mixer * 256 + h * 64 + lane] = (bf16)f2bf(st.o / st.l);
  }
}
__device__ __forceinline__ void n_wo(LAS unsigned char* lds, const bf16* A, const float* Bm, const float* R, float* C) {
  LAS float* As = (LAS float*)lds;
  LAS float* Bs = As + 16 * 129;
  const int tid = opq_tid(), tx = tid & 15, ty = tid >> 4;
  for (int tile = blockIdx.x; tile < (T / 128) * (D / 64); tile += gridDim.x) {
    const int m0 = (tile / (D / 64)) * 128, n0 = (tile % (D / 64)) * 64;
    float acc[4][4];
#pragma unroll
    for (int i = 0; i < 4; ++i)
#pragma unroll
      for (int j = 0; j < 4; ++j) acc[i][j] = 0.f;
    for (int k0 = 0; k0 < D; k0 += 16) {
#pragma unroll
      for (int r = 0; r < 4; ++r) { const int i = tid + NTHR * r, m = i >> 4, k = i & 15; As[k * 129 + m] = bf2f(A[(size_t)(m0 + m) * D + k0 + k]); }
#pragma unroll
      for (int r = 0; r < 2; ++r) { const int i = tid + NTHR * r, k = i >> 6, n = i & 63; Bs[k * 64 + n] = Bm[(size_t)(k0 + k) * D + n0 + n]; }
      __syncthreads();
#pragma unroll
      for (int k = 0; k < 16; ++k) {
        float a[4], b[4];
#pragma unroll
        for (int i = 0; i < 4; ++i) { a[i] = As[k * 129 + ty * 4 + i]; b[i] = Bs[k * 64 + tx * 4 + i]; }
#pragma unroll
        for (int i = 0; i < 4; ++i)
#pragma unroll
          for (int j = 0; j < 4; ++j) acc[i][j] += a[i] * b[j];
      }
      __syncthreads();
    }
#pragma unroll
    for (int i = 0; i < 4; ++i)
#pragma unroll
      for (int j = 0; j < 4; ++j) { const size_t o = (size_t)(m0 + ty * 4 + i) * D + n0 + tx * 4 + j; C[o] = R[o] + acc[i][j]; }
  }
}
__device__ __forceinline__ void n_route(const float* H, const float* g2, const float* wrg, const float* brg, const float* wre, const float* bre, bf16* HN, int* EXPI, float* GATE) {
  const int tid_ = opq_tid(), lane = tid_ & 63, wpb = NTHR >> 6;
  for (int t = blockIdx.x * wpb + (tid_ >> 6); t < T; t += gridDim.x * wpb) {
    const float* hr = H + (size_t)t * D;
    float v[16], ss = 0.f;
#pragma unroll
    for (int j = 0; j < 16; ++j) { v[j] = hr[lane + 64 * j]; ss += v[j] * v[j]; }
    ss = wave_sum(ss);
    const float rstd = rsqrtf(ss * (1.f / D) + EPS);
#pragma unroll
    for (int j = 0; j < 16; ++j) { v[j] = v[j] * rstd * g2[lane + 64 * j]; HN[(size_t)t * D + lane + 64 * j] = (bf16)f2bf(v[j]); }
    float gl[4];
#pragma unroll
    for (int g = 0; g < 4; ++g) {
      float a = 0.f;
#pragma unroll
      for (int j = 0; j < 16; ++j) a += v[j] * wrg[(size_t)(lane + 64 * j) * 4 + g];
      gl[g] = wave_sum(a) + brg[g];
    }
    int gs = 0; float gm = gl[0];
#pragma unroll
    for (int g = 1; g < 4; ++g) if (gl[g] > gm) { gm = gl[g]; gs = g; }
    float den = 0.f;
#pragma unroll
    for (int g = 0; g < 4; ++g) den += expf(gl[g] - gm);
    const float pg = 1.f / den;
    float el[8];
#pragma unroll
    for (int e = 0; e < 8; ++e) {
      float a = 0.f;
#pragma unroll
      for (int j = 0; j < 16; ++j) a += v[j] * wre[(size_t)(lane + 64 * j) * 32 + gs * 8 + e];
      el[e] = wave_sum(a) + bre[gs * 8 + e];
    }
    int i1 = 0; float m1 = el[0];
#pragma unroll
    for (int e = 1; e < 8; ++e) if (el[e] > m1) { m1 = el[e]; i1 = e; }
    int i2 = 0; float m2 = -INFINITY;
#pragma unroll
    for (int e = 0; e < 8; ++e) if (e != i1 && el[e] > m2) { m2 = el[e]; i2 = e; }
    const float e2 = expf(m2 - m1);
    if (lane == 0) {
      EXPI[t * 2] = gs * 8 + i1; EXPI[t * 2 + 1] = gs * 8 + i2;
      GATE[t * 2] = pg / (1.f + e2); GATE[t * 2 + 1] = pg * e2 / (1.f + e2);
    }
  }
}
__device__ __forceinline__ void n_moe(LAS unsigned char* lds, const bf16* HN, const int* EXPI, const float* GATE, const float* w1, const float* w3, const float* w2, float* hio) {
  LAS float* xs = (LAS float*)lds; LAS float* sa = xs + D; LAS float* hid = sa + 512;
  const int tid = opq_tid(), j = tid & 255, half = tid >> 8;
  for (int t = blockIdx.x; t < T; t += gridDim.x) {
    for (int i = tid; i < D; i += NTHR) xs[i] = bf2f(HN[(size_t)t * D + i]);
    __syncthreads();
    float y0 = 0.f, y1 = 0.f;
    for (int k = 0; k < 2; ++k) {
      const int e = EXPI[t * 2 + k]; const float gt = GATE[t * 2 + k];
      const float* W13 = (half ? w3 : w1) + (size_t)e * D * 256; const float* W2 = w2 + (size_t)e * 256 * D;
      float a = 0.f;
      for (int i = 0; i < D; ++i) a += xs[i] * W13[(size_t)i * 256 + j];
      sa[tid] = a;
      __syncthreads();
      if (tid < 256) { const float av = sa[tid], cv = sa[256 + tid]; hid[tid] = av / (1.f + expf(-av)) * cv * gt; }
      __syncthreads();
      for (int jj = 0; jj < 256; ++jj) { const float hv = hid[jj]; y0 += hv * W2[(size_t)jj * D + tid]; y1 += hv * W2[(size_t)jj * D + tid + 512]; }
      __syncthreads();
    }
    hio[(size_t)t * D + tid] += y0; hio[(size_t)t * D + tid + 512] += y1;
  }
}

struct Args { const float* in[20]; float* out; unsigned char* ws; int ph_lo, ph_hi, li, pad; };

__global__ void __launch_bounds__(NTHR, 2) mk_fwd(Args args) {
  extern __shared__ __attribute__((aligned(16))) unsigned char lds_raw[];
  LAS unsigned char* lds = (LAS unsigned char*)lds_raw;
  volatile LAS unsigned* MISC = (volatile LAS unsigned*)(lds + MISC_OFF);
  const int tid = opq_tid(), lane = tid & 63, wave = __builtin_amdgcn_readfirstlane(tid >> 6);
  const int G = gridDim.x;
  unsigned char* ws = args.ws;
  gu32* ctl = (gu32*)(ws + WS_CTL);
  for (int u = tid; u < (LDS_BYTES - LDSCTL_OFF) / 4; u += NTHR) ((LAS unsigned*)(lds + LDSCTL_OFF))[u] = 0u;
  __syncthreads();
  XcdBarrier bar = xcd_barrier_post((unsigned*)(ctl + CW_BAR) + args.li * XCD_BAR_WORDS, MISC + 8);
  const int lo = args.ph_lo, hi = args.ph_hi;
#define IN(k) (lo <= (k) && (k) < hi)
#define SEAM(k) do { if (IN(k) && IN((k) + 1)) xcd_barrier(bar); } while (0)
  const float* x = args.in[0]; float* out = args.out;
  bf16* Win_t = (bf16*)(ws + WS_WIN); bf16* Wo_t = (bf16*)(ws + WS_WO);
  bf16* ACT = (bf16*)(ws + WS_ACT); bf16* QKV = (bf16*)(ws + WS_QKV); bf16* R8 = (bf16*)(ws + WS_R8); bf16* R9 = (bf16*)(ws + WS_R9);
  float* LF = (float*)(ws + WS_LF); float* CUM = (float*)(ws + WS_CUM); int* EXPI = (int*)(ws + WS_EXP); float* GATE = (float*)(ws + WS_GATE);
  const int gw = blockIdx.x * NWAVES + wave, NGW = G * NWAVES;

  if (IN(0)) {
    LAS float* scr = (LAS float*)(lds + wave * 16384);
    constexpr int I_WIN = (NP / 32) * (D / 64), I_WO = (D / 32) * (D / 64);
    constexpr int NITEMS = NL * (I_WIN + I_WO);
    for (int it = gw; it < NITEMS; it += NGW) {
      int r = it;
      if (r < NL * I_WIN) { const int l = r / I_WIN; r %= I_WIN; const int ng = r / (D / 64), kb = r % (D / 64); int sc, nv; win_src(ng * 32, sc, nv);
        tr_item(args.in[2] + (size_t)l * D * NW, NW, sc, nv, Win_t + (size_t)l * NP * D, D, ng * 32, kb * 64, scr, lane); continue; }
      r -= NL * I_WIN;
      { const int l = r / I_WO; r %= I_WO; const int ng = r / (D / 64), kb = r % (D / 64);
        tr_item(args.in[11] + (size_t)l * D * D, D, ng * 32, 32, Wo_t + (size_t)l * D * D, D, ng * 32, kb * 64, scr, lane); }
    }
    prep_rows(x, nullptr, nullptr, nullptr, ACT, args.in[1], gw, NGW, lane);
  }
  SEAM(0);
  for (int l = 0; l < NL; ++l) {
    const int pb = 1 + 8 * l;
    if (IN(pb)) {
      pg8::Gemm g{ACT, Win_t + (size_t)l * NP * D, T, NP, D}; pg8::StaticOrder So; So.init(T, NP, G, (int)blockIdx.x);
      EpiInProj E{QKV, R8, R9, LF, args.in[7] + l * 256, args.in[8] + l * 256, args.in[9] + l * 4};
      pg8::gemm_phase<EpiInProj, pg8::StaticOrder, true, true>(lds, g, So, E);
    }
    SEAM(pb);
    if (IN(pb + 1)) {
      n_post(lds, R8, R9, args.in[3] + l * 192, args.in[4] + l * 128, args.in[5] + (size_t)l * 192 * 256, args.in[6] + (size_t)l * 128 * 384, args.in[7] + l * 256, args.in[8] + l * 256,
             QKV + (size_t)IQA * QKV_STRIDE, QKV + (size_t)IKA * QKV_STRIDE, QKV + (size_t)IVA * QKV_STRIDE);
      n_cumsum(lds, LF, CUM);
    }
    SEAM(pb + 1);
    if (IN(pb + 2)) n_attn(QKV, CUM, args.in[10] + l * 4, ACT, 15);
    SEAM(pb + 2);
    if (IN(pb + 3)) n_wo(lds, ACT, args.in[11] + (size_t)l * D * D, l == 0 ? x : out, out);
    SEAM(pb + 3);
    if (IN(pb + 4)) n_route(out, args.in[12] + l * D, args.in[13] + (size_t)l * D * 4, args.in[14] + l * 4, args.in[15] + (size_t)l * D * 32, args.in[16] + l * 32, ACT, EXPI, GATE);
    SEAM(pb + 4);
    if (IN(pb + 5)) n_moe(lds, ACT, EXPI, GATE, args.in[17] + (size_t)l * 32 * D * 256, args.in[18] + (size_t)l * 32 * D * 256, args.in[19] + (size_t)l * 32 * 256 * D, out);
    SEAM(pb + 5);
    SEAM(pb + 6);
    if (IN(pb + 7)) { if (l + 1 < NL) prep_rows(out, nullptr, nullptr, nullptr, ACT, args.in[1] + (l + 1) * D, gw, NGW, lane); }
    SEAM(pb + 7);
  }
#undef IN
#undef SEAM
}
}

#ifndef MK_N_LAUNCHES
#define MK_N_LAUNCHES 1
#endif
extern "C" void kernel_launch(void* const* d_in, const int* in_sizes, int n_in, void* d_out, int out_size, void* d_ws, size_t ws_size, hipStream_t stream) {
  using namespace mk;
  static int grid = 0;
  if (grid == 0) {
    if (n_in != 20 || out_size != T * D || ws_size < WS_END) { fprintf(stderr, "kernel_launch: unexpected shapes (n_in %d out %d ws %zu)\n", n_in, out_size, ws_size); grid = -1; return; }
    int dev = 0, cus = 0;
    if (hipGetDevice(&dev) != hipSuccess || hipDeviceGetAttribute(&cus, hipDeviceAttributeMultiprocessorCount, dev) != hipSuccess) { grid = -1; return; }
    if (hipFuncSetAttribute((const void*)mk_fwd, hipFuncAttributeMaxDynamicSharedMemorySize, LDS_BYTES) != hipSuccess) { grid = -1; return; }
    grid = cus;
  }
  if (grid < 0) return;
  (void)hipMemsetAsync((char*)d_ws + WS_CTL, 0, CTL_ZERO_BYTES, stream);
  Args a{};
  for (int i = 0; i < 20; ++i) a.in[i] = (const float*)d_in[i];
  a.out = (float*)d_out; a.ws = (unsigned char*)d_ws;
  constexpr int NLA = MK_N_LAUNCHES;
  for (int li = 0; li < NLA; ++li) {
    a.ph_lo = (int)((long)NPHASE * li / NLA); a.ph_hi = (int)((long)NPHASE * (li + 1) / NLA); a.li = li;
    hipLaunchKernelGGL(mk_fwd, dim3(grid), dim3(NTHR), LDS_BYTES, stream, a);
  }
}
```

```cpp
#include <hip/hip_runtime.h>
#include <cstdio>
#include <cstdint>
#include <cmath>
__device__ __forceinline__ int opq_tid() { int t = threadIdx.x; asm volatile("" : "+v"(t)); return t; }
__device__ __forceinline__ int opq_bid() { int t = blockIdx.x; asm volatile("" : "+s"(t)); return t; }
#define FASTMASK 15

namespace pg8 {
#define PG8_LAS __attribute__((address_space(3)))
typedef unsigned short bf16_t;
typedef short bf16x8 __attribute__((ext_vector_type(8)));
typedef float f32x4 __attribute__((ext_vector_type(4)));
typedef unsigned u32x4 __attribute__((ext_vector_type(4)));
constexpr int BM = 256, BK = 64, HALF = 128, HTB = HALF * BK * 2  , STAGE_BYTES = 8 * HTB, NXCD = 8, WGM = 8;

__host__ __device__ __forceinline__ int lds_byte(int r, int c) { const int st = (r >> 4) * 2 + (c >> 5), rr = r & 15, cc = c & 31, ob = rr * 64 + cc * 2; return st * 1024 + (ob ^ (((ob >> 9) & 1) << 5)); }
__host__ __device__ __forceinline__ void stage_rc(int b, int& R, int& C) { const int st = b / 1024, sb = b % 1024, swz = sb ^ (((sb >> 9) & 1) << 5); R = (st >> 1) * 16 + swz / 64; C = (st & 1) * 32 + (swz % 64) / 2; }
__host__ __device__ __forceinline__ int perm32(int rho) { const int n = rho >> 4, i = rho & 15; return 8 * (i >> 2) + 4 * n + (i & 3); }

struct Unit { int pm, pn; };
struct Gemm { const bf16_t* A; const bf16_t* Bt; int M, N, K; };

struct StaticOrder {
    int nM, nN, nwg, G, c;
    __host__ __device__ void init(int M, int N, int G_, int c_) { nM = M / BM; nN = N / BM; nwg = nM * nN; G = G_; c = c_; }
    __host__ __device__ bool next(int i, Unit& u) const {
        const long L = (long)i * G + c; if (L >= nwg) return false;
        int wgid = (int)L; { const int q = nwg / NXCD, r = nwg % NXCD, xcd = wgid % NXCD, off = wgid / NXCD; wgid = (xcd < r ? xcd * (q + 1) : r * (q + 1) + (xcd - r) * q) + off; }
        const int nig = WGM * nN, gid = wgid / nig, fm = gid * WGM, gsz = (nM - fm) < WGM ? (nM - fm) : WGM;
        u.pm = fm + ((wgid % nig) % gsz); u.pn = (wgid % nig) / gsz; return true;
    }
    __device__ __forceinline__ void a_ready(const Unit&) const {}
    __device__ __forceinline__ void done(const Unit&) const {}
};

__device__ __forceinline__ unsigned cvt_pk_bf16(float lo, float hi) { unsigned r; asm volatile("v_cvt_pk_bf16_f32 %0, %1, %2" : "=v"(r) : "v"(lo), "v"(hi)); return r; }
typedef float f32x2 __attribute__((ext_vector_type(2)));
__device__ __forceinline__ f32x2 gelu_pk(f32x2 v) {
    const f32x2 av = __builtin_elementwise_abs(v), d = av * 0.2316418882f + 1.0f;
    f32x2 t; t.x = __builtin_amdgcn_rcpf(d.x); t.y = __builtin_amdgcn_rcpf(d.y);
    f32x2 q = t * 0.5307027145f + (-0.7265760135f); q = q * t + 0.7107068705f; q = q * t + (-0.142248368f); q = q * t + 0.127414796f; q = q * t;
    const f32x2 s = (v * v) * (-0.72134752044f);
    f32x2 e; e.x = __builtin_amdgcn_exp2f(s.x); e.y = __builtin_amdgcn_exp2f(s.y);
    const f32x2 m = v * (q * e), r = v - m;
    f32x2 o; o.x = v.x < 0.f ? m.x : r.x; o.y = v.y < 0.f ? m.y : r.y; return o;
}

template <int ACT  > struct EpiBf16 {
    static constexpr bool PERM = true, AFTER_DRAIN = false; static_assert(ACT == 0 || ACT == 1, "EpiBf16: ACT is 0 (none) or 1 (gelu_pk)");
    bf16_t* O; int ldc; const float* bias; int split_cols; size_t split_stride; float scale0;
    __device__ __forceinline__ void operator()(const f32x4 (&acc)[2][2][4][2], const Unit& u, int wr, int wc, int fr, int fq) const {
        const int row0 = u.pm * BM + wr * 64 + fr; int colt = u.pn * BM; bf16_t* base = O;
        float sc = 1.f; if (split_cols) { const int t = colt / split_cols; base += (size_t)t * split_stride; colt -= t * split_cols; if (t == 0) sc = scale0; }
        const int col0 = colt + wc * 32 + 8 * fq, bcol0 = u.pn * BM + wc * 32 + 8 * fq;
        f32x4 bv[2][2];
#pragma unroll
        for (int bj = 0; bj < 2; ++bj)
#pragma unroll
            for (int n = 0; n < 2; ++n) bv[bj][n] = bias ? *(const f32x4*)(bias + bcol0 + bj * HALF + 4 * n) : (f32x4){0.f, 0.f, 0.f, 0.f};
#pragma unroll
        for (int ai = 0; ai < 2; ++ai)
#pragma unroll
            for (int m = 0; m < 4; ++m) { bf16_t* rowp = base + (size_t)(row0 + ai * HALF + m * 16) * ldc + col0;
#pragma unroll
                for (int bj = 0; bj < 2; ++bj) { f32x4 v0 = acc[ai][bj][m][0] + bv[bj][0], v1 = acc[ai][bj][m][1] + bv[bj][1];
                    if (ACT == 1) { f32x2 a = gelu_pk((f32x2){v0[0], v0[1]}), b = gelu_pk((f32x2){v0[2], v0[3]}), c = gelu_pk((f32x2){v1[0], v1[1]}), d = gelu_pk((f32x2){v1[2], v1[3]});
                        v0 = (f32x4){a.x, a.y, b.x, b.y}; v1 = (f32x4){c.x, c.y, d.x, d.y}; }
                    v0 = v0 * sc; v1 = v1 * sc; u32x4 w; w.x = cvt_pk_bf16(v0[0], v0[1]); w.y = cvt_pk_bf16(v0[2], v0[3]); w.z = cvt_pk_bf16(v1[0], v1[1]); w.w = cvt_pk_bf16(v1[2], v1[3]);
                    *(u32x4*)(rowp + bj * HALF) = w; } }
    }
};
template <class Epi, class Sched, bool ALIGN_EPI = false, bool SP2 = false>
__device__ __forceinline__ void gemm_phase(PG8_LAS unsigned char* lds, const Gemm g, const Sched& S, const Epi& E) {
    const int tid = opq_tid(), wid = __builtin_amdgcn_readfirstlane(tid >> 6), lane = tid & 63, wr = wid >> 2, wc = wid & 3, fr = lane & 15, fq = lane >> 4;
    const int K = g.K, nt = K / BK;
    unsigned voffA[2], voffB[2];
#pragma unroll
    for (int i = 0; i < 2; ++i) { int R, C; stage_rc(tid * 16 + i * 8192, R, C); const int Rb = Epi::PERM ? ((R & ~31) + perm32(R & 31)) : R;
        voffA[i] = (unsigned)(R * K + C) * 2u; voffB[i] = (unsigned)(Rb * K + C) * 2u; }
    const size_t kstep = (size_t)(BK * 2);
    const size_t hstep = (size_t)HALF * K * 2;
    const size_t tstep = 2 * hstep;
    const unsigned ldsw = (unsigned)wid * 1024u;
    const int aoff = lds_byte(wr * 64 + fr, fq * 8), boff = lds_byte(wc * 32 + fr, fq * 8);
#define PG8_SA(b, h) (((b) * 2 + (h)) * HTB)
#define PG8_SB(b, h) ((4 + (b) * 2 + (h)) * HTB)
#define PG8_STAGE(bufoff, gbase, voff) do { _Pragma("unroll") for (int _i = 0; _i < 2; ++_i) \
        __builtin_amdgcn_global_load_lds((const unsigned*)((const char*)(gbase) + (voff)[_i]), (PG8_LAS unsigned*)(lds + (bufoff) + ldsw + _i * 8192), 16, 0, 0); } while (0)
#define PG8_LDA(dst, b, h) do { _Pragma("unroll") for (int m = 0; m < 4; ++m) _Pragma("unroll") for (int k = 0; k < 2; ++k) dst[m][k] = *(const PG8_LAS bf16x8*)(lds + PG8_SA(b, h) + aoff + m * 2048 + k * 1024); } while (0)
#define PG8_LDB(dst, b, h) do { _Pragma("unroll") for (int n = 0; n < 2; ++n) _Pragma("unroll") for (int k = 0; k < 2; ++k) dst[n][k] = *(const PG8_LAS bf16x8*)(lds + PG8_SB(b, h) + boff + n * 2048 + k * 1024); } while (0)
#define PG8_MMA(ai, bj, At, Bt) do { __builtin_amdgcn_s_setprio(1); _Pragma("unroll") for (int m = 0; m < 4; ++m) _Pragma("unroll") for (int n = 0; n < 2; ++n) _Pragma("unroll") for (int k = 0; k < 2; ++k) \
        acc[ai][bj][m][n] = __builtin_amdgcn_mfma_f32_16x16x32_bf16(Bt[n][k], At[m][k], acc[ai][bj][m][n], 0, 0, 0); __builtin_amdgcn_s_setprio(0); } while (0)
#define PG8_WAIT_V(n) asm volatile("s_waitcnt vmcnt(" #n ")" ::: "memory")
#define PG8_WAIT_L(n) asm volatile("s_waitcnt lgkmcnt(" #n ")" ::: "memory")
#define PG8_BAR __builtin_amdgcn_s_barrier()
#define PG8_SCHED __builtin_amdgcn_sched_barrier(0)
    Unit cur, nxt; int ui = 0;
    if (!S.next(0, cur)) return;
    f32x4 acc[2][2][4][2];
#pragma unroll
    for (int a = 0; a < 2; ++a)
#pragma unroll
        for (int b = 0; b < 2; ++b)
#pragma unroll
            for (int m = 0; m < 4; ++m)
#pragma unroll
                for (int n = 0; n < 2; ++n) acc[a][b][m][n] = (f32x4){0.f, 0.f, 0.f, 0.f};
    bf16x8 At[4][2], B0[2][2], B1[2][2];
    const char* cA = (const char*)g.A + (size_t)cur.pm * tstep; const char* cB = (const char*)g.Bt + (size_t)cur.pn * tstep;
    S.a_ready(cur);
    if constexpr (SP2) {
        PG8_STAGE(PG8_SB(0, 0), cB, voffB); PG8_STAGE(PG8_SB(0, 1), cB + hstep, voffB); PG8_STAGE(PG8_SA(0, 0), cA, voffA); PG8_STAGE(PG8_SA(0, 1), cA + hstep, voffA);
        if (wr == 1) PG8_BAR;
        PG8_WAIT_V(2); PG8_BAR;
        PG8_STAGE(PG8_SB(1, 0), cB + kstep, voffB); PG8_STAGE(PG8_SA(1, 0), cA + kstep, voffA); PG8_STAGE(PG8_SB(1, 1), cB + hstep + kstep, voffB);
        PG8_WAIT_V(6); PG8_BAR;
    } else {
        PG8_STAGE(PG8_SB(0, 0), cB, voffB); PG8_STAGE(PG8_SA(0, 0), cA, voffA); PG8_STAGE(PG8_SB(0, 1), cB + hstep, voffB); PG8_STAGE(PG8_SA(0, 1), cA + hstep, voffA);
        if (wr == 1) PG8_BAR;
        PG8_WAIT_V(4); PG8_BAR;
        PG8_STAGE(PG8_SB(1, 0), cB + kstep, voffB); PG8_STAGE(PG8_SA(1, 0), cA + kstep, voffA); PG8_STAGE(PG8_SB(1, 1), cB + hstep + kstep, voffB);
        PG8_WAIT_V(6); PG8_BAR;
    }
    for (;;) {
        const bool has_next = S.next(ui + 1, nxt);
        const char* nA = has_next ? (const char*)g.A + (size_t)nxt.pm * tstep : cA; const char* nB = has_next ? (const char*)g.Bt + (size_t)nxt.pn * tstep : cB;
        for (int t = 0; t < nt; t += 2) {
            const bool last = (t == nt - 2);
            const char* a1 = cA + (size_t)(t + 1) * kstep;
            const char* a2 = last ? nA : cA + (size_t)(t + 2) * kstep; const char* b2 = last ? nB : cB + (size_t)(t + 2) * kstep;
            const char* a3 = a2 + kstep; const char* b3 = b2 + kstep;
            if (last && has_next) S.a_ready(nxt);
            if constexpr (SP2) {
            PG8_LDB(B0, 0, 0); PG8_LDB(B1, 0, 1); PG8_SCHED; PG8_LDA(At, 0, 0); PG8_STAGE(PG8_SA(1, 1), a1 + hstep, voffA);
            PG8_WAIT_V(8); PG8_WAIT_L(0); PG8_BAR; PG8_MMA(0, 0, At, B0); PG8_MMA(0, 1, At, B1); PG8_BAR; PG8_SCHED;
            PG8_LDA(At, 0, 1); PG8_STAGE(PG8_SB(0, 0), b2, voffB); PG8_STAGE(PG8_SB(0, 1), b2 + hstep, voffB); PG8_STAGE(PG8_SA(0, 0), a2, voffA);
            PG8_WAIT_V(8); PG8_WAIT_L(0); PG8_BAR; PG8_MMA(1, 0, At, B0); PG8_MMA(1, 1, At, B1); PG8_BAR; PG8_SCHED;
            PG8_LDB(B0, 1, 0); PG8_LDB(B1, 1, 1); PG8_SCHED; PG8_LDA(At, 1, 0); PG8_STAGE(PG8_SA(0, 1), a2 + hstep, voffA);
            PG8_WAIT_V(8); PG8_WAIT_L(0); PG8_BAR; PG8_MMA(0, 0, At, B0); PG8_MMA(0, 1, At, B1); PG8_BAR; PG8_SCHED;
            PG8_LDA(At, 1, 1); PG8_STAGE(PG8_SB(1, 0), b3, voffB); PG8_STAGE(PG8_SB(1, 1), b3 + hstep, voffB); PG8_STAGE(PG8_SA(1, 0), a3, voffA);
            PG8_WAIT_V(8); PG8_WAIT_L(0); PG8_BAR; PG8_MMA(1, 0, At, B0); PG8_MMA(1, 1, At, B1); PG8_BAR; PG8_SCHED;
            } else {
            PG8_LDB(B0, 0, 0); PG8_SCHED; PG8_LDA(At, 0, 0); PG8_STAGE(PG8_SA(1, 1), a1 + hstep, voffA);
            PG8_WAIT_L(8); PG8_BAR; PG8_WAIT_L(0); PG8_MMA(0, 0, At, B0); PG8_BAR; PG8_SCHED;
            PG8_LDB(B1, 0, 1); PG8_STAGE(PG8_SB(0, 0), b2, voffB);
            PG8_BAR; PG8_WAIT_L(0); PG8_MMA(0, 1, At, B1); PG8_BAR;
            PG8_LDA(At, 0, 1); PG8_STAGE(PG8_SA(0, 0), a2, voffA);
            PG8_BAR; PG8_WAIT_L(0); PG8_MMA(1, 0, At, B0); PG8_BAR; PG8_SCHED;
            PG8_STAGE(PG8_SB(0, 1), b2 + hstep, voffB);
            PG8_WAIT_V(6); PG8_BAR; PG8_MMA(1, 1, At, B1); PG8_BAR;
            PG8_LDB(B0, 1, 0); PG8_SCHED; PG8_LDA(At, 1, 0); PG8_STAGE(PG8_SA(0, 1), a2 + hstep, voffA);
            PG8_WAIT_L(8); PG8_BAR; PG8_WAIT_L(0); PG8_MMA(0, 0, At, B0); PG8_BAR; PG8_SCHED;
            PG8_LDB(B1, 1, 1); PG8_STAGE(PG8_SB(1, 0), b3, voffB);
            PG8_BAR; PG8_WAIT_L(0); PG8_MMA(0, 1, At, B1); PG8_BAR;
            PG8_LDA(At, 1, 1); PG8_STAGE(PG8_SA(1, 0), a3, voffA);
            PG8_BAR; PG8_WAIT_L(0); PG8_MMA(1, 0, At, B0); PG8_BAR; PG8_SCHED;
            PG8_STAGE(PG8_SB(1, 1), b3 + hstep, voffB);
            PG8_WAIT_V(6); PG8_BAR; PG8_MMA(1, 1, At, B1); PG8_BAR;
            }
        }
        if constexpr (ALIGN_EPI) { if (wr == 0) PG8_BAR; }
        if constexpr (!Epi::AFTER_DRAIN) { E(acc, cur, wr, wc, fr, fq); S.done(cur); }
        if (!has_next) break;
#pragma unroll
        for (int a = 0; a < 2; ++a)
#pragma unroll
            for (int b = 0; b < 2; ++b)
#pragma unroll
                for (int m = 0; m < 4; ++m)
#pragma unroll
                    for (int n = 0; n < 2; ++n) acc[a][b][m][n] = (f32x4){0.f, 0.f, 0.f, 0.f};
        cur = nxt; cA = nA; cB = nB; ++ui;
        if constexpr (ALIGN_EPI) { if (wr == 1) PG8_BAR; }
    }
    PG8_WAIT_V(0);
    if constexpr (!ALIGN_EPI) { if (wr == 0) PG8_BAR; }
    PG8_BAR;
    if constexpr (Epi::AFTER_DRAIN) { E.fused(acc, cur, wr, wc, fr, fq, lds, wid, lane); S.done(cur); }
#undef PG8_SA
#undef PG8_SB
#undef PG8_STAGE
#undef PG8_LDA
#undef PG8_LDB
#undef PG8_MMA
#undef PG8_WAIT_V
#undef PG8_WAIT_L
#undef PG8_BAR
#undef PG8_SCHED
}
}

#ifndef PG8_SP2
#define PG8_SP2 true
#endif
#ifndef PG8_ALIGN
#define PG8_ALIGN true
#endif
#include <hip/hip_bf16.h>
#include <cmath>
namespace attn_body {
using bf16=__hip_bfloat16;
using bf16x8=__attribute__((ext_vector_type(8)))short;
using s16x4=__attribute__((ext_vector_type(4)))short;
using f32x16=__attribute__((ext_vector_type(16)))float;
using u32x4=__attribute__((ext_vector_type(4)))unsigned;
constexpr int BATCH=2,NHEAD=4,SEQ=8192,D=64,DM=NHEAD*D;
constexpr int NW=8,QBLK=32,QB=QBLK*NW,KVBLK=64,NQB=SEQ/QB;
constexpr int ATTN_PITCH=DM, ATTN_UNIT_ROWS=QB;
__device__ __forceinline__ int crow(int r,int hi){return (r&3)+8*(r>>2)+4*hi;}
#define SBAR() __builtin_amdgcn_sched_barrier(0)
__device__ __forceinline__ void cmask(f32x16&p0,f32x16&p1,int jb,int qrel,int hi){
  const float NEG=-INFINITY; int kb=64*jb+4*hi;
  #pragma unroll
  for(int r=0;r<16;++r){int kv=kb+(r&3)+8*(r>>2); if(kv>qrel)p0[r]=NEG; if(kv+32>qrel)p1[r]=NEG;}
}

constexpr int NSLOT=3, SLOTB=8192;
constexpr int LDS_K=0, LDS_V=NSLOT*SLOTB, LDS_WS=2*NSLOT*SLOTB, LDS_OST=LDS_WS+NW*64*4, LDS_BIAS=LDS_OST+NW*4096, LDS_BYTES=LDS_BIAS+(SEQ+64)*4;
constexpr float C2=0.125f*1.4426950408889634f;
__device__ __forceinline__ void glds16(const void*gsrc,unsigned lds_dst){unsigned keep;
  asm volatile("s_mov_b32 %0, m0\n\ts_mov_b32 m0, %2\n\ts_nop 0\n\tglobal_load_lds_dwordx4 %1, off\n\ts_mov_b32 m0, %0":"=&s"(keep):"v"(gsrc),"s"(lds_dst):"memory");}
__device__ __forceinline__ float max3f(float a,float b,float c){float r;asm("v_max3_f32 %0, %1, %2, %3":"=v"(r):"v"(a),"v"(b),"v"(c));return r;}
__device__ __forceinline__ float max2f(float a,float b){float r;asm("v_max_f32_e32 %0, %1, %2":"=v"(r):"v"(a),"v"(b));return r;}
__device__ __forceinline__ float fadd_s(float a,float b){float r;asm("v_add_f32_e32 %0, %1, %2":"=v"(r):"v"(a),"v"(b));return r;}
__device__ __forceinline__ float fsub_s(float a,float b){float r;asm("v_sub_f32_e32 %0, %1, %2":"=v"(r):"v"(a),"v"(b));return r;}
typedef float f32x2_t __attribute__((ext_vector_type(2))); typedef float f32x4_t __attribute__((ext_vector_type(4))); typedef __bf16 bf16x2_t __attribute__((ext_vector_type(2)));
__device__ __forceinline__ unsigned cvtpk_s(float lo,float hi){f32x2_t v={lo,hi};bf16x2_t b=__builtin_convertvector(v,bf16x2_t);return __builtin_bit_cast(unsigned,b);}
#define WAIT_BAR(N) asm volatile("s_waitcnt vmcnt(" #N ") lgkmcnt(0)\n\ts_barrier":::"memory")

__device__ __forceinline__ void qkt(f32x16&p0,f32x16&p1,const char*Kslot,const bf16x8*qr,const f32x16&negm,int r32,int hi){
  const char*kb=Kslot+hi*1024+r32*16;
  #pragma unroll
  for(int d0=0;d0<4;++d0){
    const bf16x8 b0=*reinterpret_cast<const bf16x8*>(kb+d0*2048);
    const bf16x8 b1=*reinterpret_cast<const bf16x8*>(kb+d0*2048+512);
    if(d0==0){p0=__builtin_amdgcn_mfma_f32_32x32x16_bf16(b0,qr[0],negm,0,0,0);p1=__builtin_amdgcn_mfma_f32_32x32x16_bf16(b1,qr[0],negm,0,0,0);}
    else{p0=__builtin_amdgcn_mfma_f32_32x32x16_bf16(b0,qr[d0],p0,0,0,0);p1=__builtin_amdgcn_mfma_f32_32x32x16_bf16(b1,qr[d0],p1,0,0,0);}}
}
typedef __attribute__((address_space(3))) const char* lds_cptr;
typedef short v4i16_t __attribute__((ext_vector_type(4)));
__device__ __forceinline__ void kload8(bf16x8*kf,lds_cptr kp){
  kf[0]=*(const __attribute__((address_space(3))) bf16x8*)(kp);      kf[1]=*(const __attribute__((address_space(3))) bf16x8*)(kp+512);
  kf[2]=*(const __attribute__((address_space(3))) bf16x8*)(kp+2048); kf[3]=*(const __attribute__((address_space(3))) bf16x8*)(kp+2560);
  kf[4]=*(const __attribute__((address_space(3))) bf16x8*)(kp+4096); kf[5]=*(const __attribute__((address_space(3))) bf16x8*)(kp+4608);
  kf[6]=*(const __attribute__((address_space(3))) bf16x8*)(kp+6144); kf[7]=*(const __attribute__((address_space(3))) bf16x8*)(kp+6656);
}
__device__ __forceinline__ void kload2(bf16x8*kf,lds_cptr kp,int j){ kf[2*j]=*(const __attribute__((address_space(3))) bf16x8*)(kp+j*2048); kf[2*j+1]=*(const __attribute__((address_space(3))) bf16x8*)(kp+j*2048+512); }
__device__ __forceinline__ s16x4 vtr(lds_cptr p){ return __builtin_bit_cast(s16x4,__builtin_amdgcn_ds_read_tr16_b64_v4i16((__attribute__((address_space(3))) v4i16_t*)p)); }
__device__ __forceinline__ float rowmax(const f32x16&p0,const f32x16&p1){
  float a=max3f(p0[0],p0[1],p1[0]),b=max3f(p0[2],p0[3],p1[1]);a=max3f(a,p1[2],p1[3]);
  #pragma unroll
  for(int r=4;r<16;r+=4){a=max3f(a,p0[r],p0[r+1]);b=max3f(b,p0[r+2],p0[r+3]);a=max3f(a,p1[r],p1[r+1]);b=max3f(b,p1[r+2],p1[r+3]);}
  const float m=max2f(a,b);
  auto rr=__builtin_amdgcn_permlane32_swap(__float_as_uint(m),__float_as_uint(m),false,false);
  return max2f(__uint_as_float(rr[0]),__uint_as_float(rr[1]));
}
__device__ __forceinline__ void pv(f32x16*o,int vb,bf16x8 pa0,bf16x8 pa1,bf16x8 pa2,bf16x8 pa3){
  #pragma unroll
  for(int d0=0;d0<2;++d0){s16x4 lo[4],hi[4];
    #pragma unroll
    for(int ks=0;ks<4;++ks){
      asm volatile("ds_read_b64_tr_b16 %0,%1 offset:%c2":"=&v"(lo[ks]):"v"(vb),"i"(d0*4096+ks*1024):"memory");
      asm volatile("ds_read_b64_tr_b16 %0,%1 offset:%c2":"=&v"(hi[ks]):"v"(vb),"i"(d0*4096+ks*1024+512):"memory");}
    asm volatile("s_waitcnt lgkmcnt(0)":::"memory");SBAR();
    #define PK(k) (bf16x8){lo[k][0],lo[k][1],lo[k][2],lo[k][3],hi[k][0],hi[k][1],hi[k][2],hi[k][3]}
    o[d0]=__builtin_amdgcn_mfma_f32_32x32x16_bf16(pa0,PK(0),o[d0],0,0,0);
    o[d0]=__builtin_amdgcn_mfma_f32_32x32x16_bf16(pa1,PK(1),o[d0],0,0,0);
    o[d0]=__builtin_amdgcn_mfma_f32_32x32x16_bf16(pa2,PK(2),o[d0],0,0,0);
    o[d0]=__builtin_amdgcn_mfma_f32_32x32x16_bf16(pa3,PK(3),o[d0],0,0,0);
    #undef PK
  }
}

#ifndef ATTN_STORE16
#define ATTN_STORE16(p,v) (*(u32x4*)(p)=(v))
#endif
struct AU { const bf16*Q; const bf16*K; const bf16*V; bf16*O; float*LSE; long qs,ks,os; int NT,win,lses,pad; float slope2,sink2; };
template<int THRL,int MODE> __device__ __forceinline__ void attn_unit(const AU&u,char*shm){
  const int tid=opq_tid(),lane=tid&63,r32=lane&31,hi=lane>>5; const int wid=__builtin_amdgcn_readfirstlane(tid>>6);
  const long ks=u.ks;
  const bf16*Qw=u.Q+(long)(wid*QBLK)*u.qs;
  const bf16*Kh=u.K,*Vh=u.V;
  const unsigned lds0=(unsigned)(uintptr_t)shm;
  float*wsf=(float*)(shm+LDS_WS)+wid*64;
  const bf16*ksrc=Kh+(long)lane*ks+wid*8;
  const bf16*vsrc=Vh+(long)(16*(wid&3)+(lane>>2))*ks+(wid>>2)*32+(lane&3)*8;
  const unsigned kdst=lds0+LDS_K+wid*1024, vdst=lds0+LDS_V+wid*1024;
  #define DMA_K(t,slot) glds16(ksrc+(long)(t)*KVBLK*ks,(unsigned)__builtin_amdgcn_readfirstlane(kdst+(slot)))
  #define DMA_V(t,slot) glds16(vsrc+(long)(t)*KVBLK*ks,(unsigned)__builtin_amdgcn_readfirstlane(vdst+(slot)))
  const int vb0=(int)(lds0+LDS_V)+((lane>>4)&1)*32+(lane&3)*8+(4*hi+((lane&15)>>2))*64;
  const char*Kbase=shm+LDS_K; bf16x8 kf[8];
  const lds_cptr shm3=(lds_cptr)shm; const lds_cptr kp0=shm3+LDS_K+hi*1024+r32*16; const lds_cptr vp0=shm3+LDS_V+((lane>>4)&1)*32+(lane&3)*8+(4*hi+((lane&15)>>2))*64;
  const int NT=u.NT;
  const lds_cptr biasp=shm3+LDS_BIAS;
  DMA_K(0,0);DMA_V(0,0);DMA_K(1,SLOTB);
  bf16x8 qr[4];
  #pragma unroll
  for(int d0=0;d0<4;++d0)qr[d0]=*reinterpret_cast<const bf16x8*>(&Qw[(long)r32*u.qs+d0*16+hi*8]);
  float mhat=0.f,l_reg=0.f;f32x16 o[2];o[0]=f32x16{};o[1]=f32x16{};f32x16 negm=f32x16{};if(!(MODE&1)){asm volatile("":"+v"(negm));}
  const int qrel=wid*QBLK+r32;
  #define CMASK(P0,P1,t) do{int jb_=(t)-(NT-4); if(jb_>=0)cmask(P0,P1,jb_,qrel,hi);}while(0)
  #define BIASW(P0,P1,t) do{ if(MODE&1){ const lds_cptr bt_=biasp+((t)*64+4*hi)*4; const float nm_=-mhat; SBAR(); \
      { f32x4_t b_[2]; _Pragma("unroll") for(int g_=0;g_<2;++g_) b_[g_]=*(const __attribute__((address_space(3))) f32x4_t*)(bt_+0+32*(g_+0)); \
        _Pragma("unroll") for(int g_=0;g_<2;++g_){ P0[4*(g_+0)]+=b_[g_][0]+nm_;P0[4*(g_+0)+1]+=b_[g_][1]+nm_;P0[4*(g_+0)+2]+=b_[g_][2]+nm_;P0[4*(g_+0)+3]+=b_[g_][3]+nm_; } } \
      asm volatile("":"+v"(P0)); SBAR(); \
      { f32x4_t b_[2]; _Pragma("unroll") for(int g_=0;g_<2;++g_) b_[g_]=*(const __attribute__((address_space(3))) f32x4_t*)(bt_+0+32*(g_+2)); \
        _Pragma("unroll") for(int g_=0;g_<2;++g_){ P0[4*(g_+2)]+=b_[g_][0]+nm_;P0[4*(g_+2)+1]+=b_[g_][1]+nm_;P0[4*(g_+2)+2]+=b_[g_][2]+nm_;P0[4*(g_+2)+3]+=b_[g_][3]+nm_; } } \
      asm volatile("":"+v"(P0)); SBAR(); \
      { f32x4_t b_[2]; _Pragma("unroll") for(int g_=0;g_<2;++g_) b_[g_]=*(const __attribute__((address_space(3))) f32x4_t*)(bt_+128+32*(g_+0)); \
        _Pragma("unroll") for(int g_=0;g_<2;++g_){ P1[4*(g_+0)]+=b_[g_][0]+nm_;P1[4*(g_+0)+1]+=b_[g_][1]+nm_;P1[4*(g_+0)+2]+=b_[g_][2]+nm_;P1[4*(g_+0)+3]+=b_[g_][3]+nm_; } } \
      asm volatile("":"+v"(P1)); SBAR(); \
      { f32x4_t b_[2]; _Pragma("unroll") for(int g_=0;g_<2;++g_) b_[g_]=*(const __attribute__((address_space(3))) f32x4_t*)(bt_+128+32*(g_+2)); \
        _Pragma("unroll") for(int g_=0;g_<2;++g_){ P1[4*(g_+2)]+=b_[g_][0]+nm_;P1[4*(g_+2)+1]+=b_[g_][1]+nm_;P1[4*(g_+2)+2]+=b_[g_][2]+nm_;P1[4*(g_+2)+3]+=b_[g_][3]+nm_; } } \
      asm volatile("":"+v"(P1)); SBAR(); \
      } \
    if(MODE&2){ const int kw_=64*((t)-(NT-4))+4*hi-qrel+u.win; \
      _Pragma("unroll") for(int r=0;r<16;++r){ const int kv_=kw_+(r&3)+8*(r>>2); if(kv_<0)P0[r]=-INFINITY; if(kv_+32<0)P1[r]=-INFINITY; } } }while(0)
  bool resc=false;
  #define START(P0,P1) do{ const float rm=rowmax(P0,P1); resc=false; \
    { const float dl=(MODE&2)?max2f(rm,-1000.f):rm; mhat=fadd_s(mhat,dl); \
      _Pragma("unroll") for(int r=0;r<16;++r){P0[r]=fsub_s(P0[r],dl);P1[r]=fsub_s(P1[r],dl);} \
      if(!(MODE&1)){ _Pragma("unroll") for(int r=0;r<16;++r)negm[r]=-mhat; asm volatile("":"+v"(negm)); } } \
    _Pragma("unroll") for(int r=0;r<16;++r)P0[r]=__builtin_amdgcn_exp2f(P0[r]); }while(0)
  #define RESC() do{ if(resc){ asm volatile("s_waitcnt lgkmcnt(0)":::"memory"); \
      _Pragma("unroll") for(int d_=0;d_<2;++d_) _Pragma("unroll") for(int r=0;r<16;++r)o[d_][r]*=wsf[crow(r,hi)]; } }while(0)
  f32x16 pA0,pA1,pB0,pB1;
  int sl_prev=0,sl_cur=0,sl_next=SLOTB;
  #define ROT() do{sl_prev=sl_cur;sl_cur=sl_next;sl_next=(sl_next==(NSLOT-1)*SLOTB)?0:sl_next+SLOTB;}while(0)
  DMA_K(2,2*SLOTB);
  WAIT_BAR(3);
  qkt(pA0,pA1,Kbase,qr,negm,r32,hi);asm volatile("s_nop 15\n\ts_nop 7":"+v"(pA0),"+v"(pA1));BIASW(pA0,pA1,0);CMASK(pA0,pA1,0);
  START(pA0,pA1);
  _Pragma("unroll") for(int r=0;r<16;++r)pA1[r]=__builtin_amdgcn_exp2f(pA1[r]);
  WAIT_BAR(0);
  DMA_K(3,0);DMA_V(1,SLOTB);
  ROT();
  kload8(kf,kp0+sl_cur);
  WAIT_BAR(2);
  s16x4 vlo[8],vhi[8]; u32x4 pw0,pw1,pw2,pw3;
  #define PKW(P,B) cvtpk_s(P[B],P[B+1])
  #define PAF(k) __builtin_bit_cast(bf16x8,pw##k)
  #define VFR(i) (bf16x8){vlo[i][0],vlo[i][1],vlo[i][2],vlo[i][3],vhi[i][0],vhi[i][1],vhi[i][2],vhi[i][3]}
  #define PIN(x) asm volatile("":"+v"(x))
  #define MX3(a,b,c) __builtin_fmaxf(__builtin_fmaxf((a),(b)),(c))
  #define GAPA(MF,A0,A1,A2,A3,W0,W1,PW) do{ MF; sacc+=A0; sacc+=A1; sacc+=A2; sacc+=A3; PIN(sacc); W0; W1; PIN(PW); SBAR(); }while(0)
  #define EX(v) __builtin_amdgcn_exp2f(v)
  #define GAPB(MF,X,B) do{ MF; X[B]=EX(X[B]); X[B+1]=EX(X[B+1]); X[B+2]=EX(X[B+2]); X[B+3]=EX(X[B+3]); PIN(X); SBAR(); }while(0)
  #define VRD(i) do{ vlo[i]=vtr(vp_+(((i)>>2)*4096+((i)&3)*1024)); vhi[i]=vtr(vp_+(((i)>>2)*4096+((i)&3)*1024+512)); }while(0)
  #define KRD(G,j) do{ if(G){ kload2(kf,kp0+sl_next,j); SBAR(); } }while(0)
  #define STEP(C0,C1,P0,P1,t,GK,GV,GL) do{ SBAR(); \
    const lds_cptr vp_=vp0+sl_prev; \
    VRD(0); SBAR(); float sacc=(P0[0]+P0[1]); \
    GAPA(C0=__builtin_amdgcn_mfma_f32_32x32x16_bf16(kf[0],qr[0],negm,0,0,0), P0[2],P0[3],P0[4],P0[5],     pw0[0]=PKW(P0,0), pw0[1]=PKW(P0,2), pw0); \
    VRD(4); SBAR(); GAPA(C1=__builtin_amdgcn_mfma_f32_32x32x16_bf16(kf[1],qr[0],negm,0,0,0), P0[6],P0[7],P0[8],P0[9],     pw0[2]=PKW(P0,4), pw0[3]=PKW(P0,6), pw0); \
    VRD(1); SBAR(); GAPA(C0=__builtin_amdgcn_mfma_f32_32x32x16_bf16(kf[2],qr[1],C0,0,0,0),   P0[10],P0[11],P0[12],P0[13], pw1[0]=PKW(P0,8), pw1[1]=PKW(P0,10), pw1); \
    VRD(5); SBAR(); GAPA(C1=__builtin_amdgcn_mfma_f32_32x32x16_bf16(kf[3],qr[1],C1,0,0,0),   P0[14],P0[15],P1[0],P1[1],   pw1[2]=PKW(P0,12),pw1[3]=PKW(P0,14), pw1); \
    VRD(2); SBAR(); GAPA(C0=__builtin_amdgcn_mfma_f32_32x32x16_bf16(kf[4],qr[2],C0,0,0,0),   P1[2],P1[3],P1[4],P1[5],     pw2[0]=PKW(P1,0), pw2[1]=PKW(P1,2), pw2); \
    VRD(6); SBAR(); GAPA(C1=__builtin_amdgcn_mfma_f32_32x32x16_bf16(kf[5],qr[2],C1,0,0,0),   P1[6],P1[7],P1[8],P1[9],     pw2[2]=PKW(P1,4), pw2[3]=PKW(P1,6), pw2); \
    VRD(3); SBAR(); GAPA(C0=__builtin_amdgcn_mfma_f32_32x32x16_bf16(kf[6],qr[3],C0,0,0,0),   P1[10],P1[11],P1[12],P1[13], pw3[0]=PKW(P1,8), pw3[1]=PKW(P1,10), pw3); \
    VRD(7); SBAR(); GAPA(C1=__builtin_amdgcn_mfma_f32_32x32x16_bf16(kf[7],qr[3],C1,0,0,0),   P1[14],P1[15],0.f,0.f,       pw3[2]=PKW(P1,12),pw3[3]=PKW(P1,14), pw3); \
    l_reg+=sacc; \
    if(GK){DMA_K((t)+3,sl_cur);} if(GV){DMA_V((t)+1,sl_next);} \
    BIASW(C0,C1,t); CMASK(C0,C1,t); \
    { float a=MX3(C0[0],C0[1],C1[0]),b=MX3(C0[2],C0[3],C1[1]); a=MX3(a,C1[2],C1[3]); \
      _Pragma("unroll") for(int r=4;r<16;r+=4){a=MX3(a,C0[r],C0[r+1]);b=MX3(b,C0[r+2],C0[r+3]);a=MX3(a,C1[r],C1[r+1]);b=MX3(b,C1[r+2],C1[r+3]);} \
      float rm=__builtin_fmaxf(a,b); { auto rr=__builtin_amdgcn_permlane32_swap(__float_as_uint(rm),__float_as_uint(rm),false,false); rm=__builtin_fmaxf(__uint_as_float(rr[0]),__uint_as_float(rr[1])); } \
      resc=false; \
      if(__builtin_expect(__any(rm>(float)THRL),0)){ const float dl=__builtin_fmaxf(rm,0.f); mhat+=dl; \
        _Pragma("unroll") for(int r=0;r<16;++r){C0[r]-=dl;C1[r]-=dl;} \
        if(!(MODE&1)){ _Pragma("unroll") for(int r=0;r<16;++r)negm[r]=-mhat; asm volatile("":"+v"(negm)); } \
        const float f=__builtin_amdgcn_exp2f(-dl); l_reg*=f; if(hi==0)wsf[r32]=f; resc=true; } } \
    SBAR(); \
    GAPB(o[0]=__builtin_amdgcn_mfma_f32_32x32x16_bf16(PAF(0),VFR(0),o[0],0,0,0), C0,0); \
    GAPB(o[1]=__builtin_amdgcn_mfma_f32_32x32x16_bf16(PAF(0),VFR(4),o[1],0,0,0), C0,4); \
    KRD(GL,0); GAPB(o[0]=__builtin_amdgcn_mfma_f32_32x32x16_bf16(PAF(1),VFR(1),o[0],0,0,0), C0,8); \
    KRD(GL,1); GAPB(o[1]=__builtin_amdgcn_mfma_f32_32x32x16_bf16(PAF(1),VFR(5),o[1],0,0,0), C0,12); \
    KRD(GL,2); GAPB(o[0]=__builtin_amdgcn_mfma_f32_32x32x16_bf16(PAF(2),VFR(2),o[0],0,0,0), C1,0); \
    KRD(GL,3); GAPB(o[1]=__builtin_amdgcn_mfma_f32_32x32x16_bf16(PAF(2),VFR(6),o[1],0,0,0), C1,4); \
    GAPB(o[0]=__builtin_amdgcn_mfma_f32_32x32x16_bf16(PAF(3),VFR(3),o[0],0,0,0), C1,8); \
    GAPB(o[1]=__builtin_amdgcn_mfma_f32_32x32x16_bf16(PAF(3),VFR(7),o[1],0,0,0), C1,12); \
    }while(0)
  int t=1;
  #undef CMASK
  #define CMASK(P0,P1,t) do{}while(0)
  for(;t+5<NT;t+=2){
    STEP(pB0,pB1,pA0,pA1,t,true,true,true);     WAIT_BAR(2); RESC(); ROT();
    STEP(pA0,pA1,pB0,pB1,t+1,true,true,true);   WAIT_BAR(2); RESC(); ROT();
  }
  #undef CMASK
  #define CMASK(P0,P1,t) do{int jb_=(t)-(NT-4); if(jb_>=0)cmask(P0,P1,jb_,qrel,hi);}while(0)
  #define ENDW(tt) do{ if((tt)+3<NT){WAIT_BAR(2);} else if((tt)+2<NT){WAIT_BAR(1);} else {WAIT_BAR(0);} }while(0)
  for(;t+1<NT;t+=2){
    STEP(pB0,pB1,pA0,pA1,t,(t+3<NT),(t+1<NT),(t+1<NT));       ENDW(t);   RESC(); ROT();
    STEP(pA0,pA1,pB0,pB1,t+1,(t+4<NT),(t+2<NT),(t+2<NT));     ENDW(t+1); RESC(); ROT();
  }
  STEP(pB0,pB1,pA0,pA1,NT-1,false,false,false); RESC();
  { float sacc=pB0[0]+pB0[1]; _Pragma("unroll") for(int r=2;r<16;++r)sacc+=pB0[r]; _Pragma("unroll") for(int r=0;r<16;++r)sacc+=pB1[r]; l_reg+=sacc;
    pw0=(u32x4){PKW(pB0,0),PKW(pB0,2),PKW(pB0,4),PKW(pB0,6)};pw1=(u32x4){PKW(pB0,8),PKW(pB0,10),PKW(pB0,12),PKW(pB0,14)};pw2=(u32x4){PKW(pB1,0),PKW(pB1,2),PKW(pB1,4),PKW(pB1,6)};pw3=(u32x4){PKW(pB1,8),PKW(pB1,10),PKW(pB1,12),PKW(pB1,14)};
    SBAR(); pv(o,vb0+sl_cur,PAF(0),PAF(1),PAF(2),PAF(3)); }
  #undef PKW
  #undef PAF
  #undef VFR
  #undef PIN
  #undef MX3
  #undef GAPA
  #undef GAPB
  #undef EX
  #undef VRD
  #undef KRD
  #undef STEP
  #undef ENDW
  {auto rr=__builtin_amdgcn_permlane32_swap(__float_as_uint(l_reg),__float_as_uint(l_reg),false,false);l_reg=__uint_as_float(rr[0])+__uint_as_float(rr[1]);}
  if(MODE&8)l_reg+=__builtin_amdgcn_exp2f(u.sink2+u.slope2*(float)qrel-mhat);
  if((MODE&4)&&hi==0)u.LSE[(long)qrel*u.lses]=mhat+__builtin_amdgcn_logf(l_reg)-u.slope2*(float)qrel;
  if(hi==0)wsf[32+r32]=l_reg;asm volatile("s_waitcnt lgkmcnt(0)":::"memory");
  float rli[16];
  #pragma unroll
  for(int r=0;r<16;++r)rli[r]=__builtin_amdgcn_rcpf(wsf[32+crow(r,hi)]);
  bf16*Ow=u.O+(long)(wid*QBLK)*u.os;
  { bf16*stg=(bf16*)(shm+LDS_OST)+wid*2048;
    #pragma unroll
    for(int r=0;r<16;++r){const int orow=crow(r,hi);
      #pragma unroll
      for(int d0=0;d0<2;++d0)stg[orow*64+d0*32+r32]=__float2bfloat16(o[d0][r]*rli[r]);}
    asm volatile("s_waitcnt lgkmcnt(0)":::"memory");
    #pragma unroll
    for(int i=0;i<4;++i){const int row=i*8+(lane>>3),ch=lane&7; const u32x4 v=*(const u32x4*)(stg+row*64+ch*8); ATTN_STORE16(Ow+(long)row*u.os+ch*8,v);} }
  asm volatile("s_waitcnt lgkmcnt(0)\n\ts_barrier":::"memory");
  #undef DMA_K
  #undef DMA_V
  #undef CMASK
  #undef BIASW
  #undef START
  #undef RESC
  #undef ROT
}
constexpr int ATTN_LDS_BYTES=LDS_BYTES;
#undef SBAR
#undef WAIT_BAR
}
#define GAS __attribute__((address_space(1)))
#define LAS __attribute__((address_space(3)))
typedef unsigned short bf16;
typedef unsigned v4u __attribute__((ext_vector_type(4)));
typedef float f32x4 __attribute__((ext_vector_type(4)));
typedef short bf16x8 __attribute__((ext_vector_type(8)));
typedef GAS unsigned gu32;
typedef GAS unsigned long long gu64;
#define RLX_AGENT __ATOMIC_RELAXED, __HIP_MEMORY_SCOPE_AGENT
#define LDS_WAIT() asm volatile("s_waitcnt lgkmcnt(0)" ::: "memory")
#define VM_WAIT() asm volatile("s_waitcnt vmcnt(0)" ::: "memory")
__device__ __forceinline__ unsigned long long rt() { return __builtin_amdgcn_s_memrealtime(); }
__device__ __forceinline__ unsigned f2bf(float f) { unsigned u = __builtin_bit_cast(unsigned, f); return (u + 0x7fffu + ((u >> 16) & 1u)) >> 16; }
__device__ __forceinline__ unsigned pk2(float lo, float hi) { return f2bf(lo) | (f2bf(hi) << 16); }

#define XB_TMO      128
#define XB_XCNT(j)  (256  + 64 * (j))
#define XB_XSUB(j)  (1280 + 64 * (j))
#define XB_XGEN(j)  (2304 + 64 * (j))
#define XB_TOP      3328
#define XB_TOPGEN   3392
#define XCD_BAR_WORDS 3456
#define XB_SPIN_CAP (1u << 24)

__device__ __forceinline__ unsigned xb_ld(unsigned* p)              { return __hip_atomic_load(p, __ATOMIC_RELAXED, __HIP_MEMORY_SCOPE_AGENT); }
__device__ __forceinline__ unsigned xb_add(unsigned* p, unsigned v) { return __hip_atomic_fetch_add(p, v, __ATOMIC_RELAXED, __HIP_MEMORY_SCOPE_AGENT); }
__device__ __forceinline__ unsigned xb_xcc_id() { return (unsigned)__builtin_amdgcn_s_getreg((3 << 11) | 20) & 0xFu; }
#define XB_SPIN(cond, bar) do { unsigned _sp = 0; while (cond) { __builtin_amdgcn_s_sleep(1); \
    if ((++_sp & 255u) == 0u) { if (xb_ld(&(bar)[XB_TMO])) break; if (_sp > XB_SPIN_CAP) { atomicAdd(&(bar)[XB_TMO], 1u); break; } } } } while (0)

struct XcdBarrier {
    unsigned* bar; unsigned x;
    volatile LAS unsigned* st;
};

__device__ __forceinline__ XcdBarrier xcd_barrier_post(unsigned* bar, volatile LAS unsigned* st) {
    XcdBarrier b; b.bar = bar; b.x = xb_xcc_id(); b.st = st;
    if (threadIdx.x == 0) (void)xb_add(&bar[XB_XCNT(b.x)], 1u);
    return b;
}
__device__ __forceinline__ void xcd_barrier_complete(unsigned* bar, unsigned x, unsigned& nloc, unsigned& nx) {
    const unsigned G = gridDim.x * gridDim.y * gridDim.z;
    unsigned sum, cnt, mine, sp = 0u;
    for (;;) {
        sum = 0u; cnt = 0u; mine = 0u;
#pragma unroll
        for (unsigned j = 0; j < 16; ++j) { const unsigned c = xb_ld(&bar[XB_XCNT(j)]); sum += c; cnt += (c > 0u) ? 1u : 0u; mine = (j == x) ? c : mine; }
        if (sum == G) break;
        __builtin_amdgcn_s_sleep(1);
        if ((++sp & 255u) == 0u) { if (xb_ld(&bar[XB_TMO])) break; if (sp > XB_SPIN_CAP) { atomicAdd(&bar[XB_TMO], 1u); break; } }
    }
    nloc = mine > 0u ? mine : 1u; nx = cnt > 0u ? cnt : 1u;
}

__device__ __forceinline__ void xcd_barrier(const XcdBarrier& b) {
    asm volatile("s_waitcnt vmcnt(0)" ::: "memory");
    __syncthreads();
    if (threadIdx.x == 0) {
        unsigned* bar = b.bar;
        __builtin_amdgcn_s_waitcnt(0);
        unsigned nloc = b.st[0], nx = b.st[1];
        if (nloc == 0u) { xcd_barrier_complete(bar, b.x, nloc, nx); b.st[0] = nloc; b.st[1] = nx; }
        const unsigned old = xb_add(&bar[XB_XSUB(b.x)], 1u);
        const unsigned gen = old / nloc;
        if (old + 1u == (gen + 1u) * nloc) {
            __builtin_amdgcn_fence(__ATOMIC_RELEASE, "agent");
            asm volatile("s_waitcnt vmcnt(0)" ::: "memory");
            const unsigned og = xb_add(&bar[XB_TOP], 1u);
            const unsigned tg = og / nx;
            if (og + 1u == (tg + 1u) * nx) xb_add(&bar[XB_TOPGEN], 1u);
            else XB_SPIN(xb_ld(&bar[XB_TOPGEN]) == tg, bar);
            __builtin_amdgcn_fence(__ATOMIC_ACQUIRE, "agent");
            xb_add(&bar[XB_XGEN(b.x)], 1u);
            asm volatile("s_waitcnt vmcnt(0)" ::: "memory");
        } else {
            XB_SPIN(xb_ld(&bar[XB_XGEN(b.x)]) == gen, bar);
            __builtin_amdgcn_fence(__ATOMIC_ACQUIRE, "agent");
            asm volatile("s_waitcnt vmcnt(0)" ::: "memory");
        }
    }
    __syncthreads();
}
namespace mk {
constexpr int NB = 2, S = 8192, D = 1024, T = NB * S, NL = 2, NW = 2404, NP = 2560;
constexpr int OFF_CQ = 0, OFF_CKV = 192, OFF_KR = 320, OFF_PB = 352, OFF_PC = 1120, OFF_FG = 1888, OFF_PDQ = 1892, OFF_PDKV = 2148;
constexpr float EPS = 1e-6f, LOG2E = 1.4426950408889634f, C2 = 0.125f * 1.4426950408889634f;
constexpr int NWAVES = 8, NTHR = 512;
constexpr size_t MiB = 1u << 20;
constexpr size_t WS_CTL = 0, CTL_ZERO_BYTES = 1 * MiB;
constexpr size_t WS_WIN = 1 * MiB;
constexpr size_t WS_WO = 11 * MiB;
constexpr size_t WS_WUQ = 15 * MiB;
constexpr size_t WS_WUKV = 15 * MiB + MiB / 2;
constexpr size_t WS_W13 = 16 * MiB;
constexpr size_t WS_W2 = 80 * MiB;
constexpr size_t WS_ACT = 112 * MiB;
constexpr size_t WS_QKV = 144 * MiB;
constexpr size_t WS_R8 = 232 * MiB, WS_R9 = 240 * MiB;
constexpr size_t WS_LF = 248 * MiB, WS_CUM = WS_LF + MiB / 4, WS_EXP = 249 * MiB, WS_GATE = WS_EXP + MiB / 4;
constexpr size_t WS_PART = 250 * MiB;
constexpr size_t WS_LSEP = 274 * MiB;
constexpr size_t WS_END = 275 * MiB;
constexpr size_t QKV_STRIDE = (size_t)T * 256;
enum { IQA = 0, IKA, IVA, IQB, IKB, IVB, IQC, IKC, IVC, IQD };
constexpr int CW_BAR = 4096;
constexpr int RING_BYTES = 131072, LDSCTL_OFF = RING_BYTES, MISC_OFF = LDSCTL_OFF + 320, LDS_BYTES = 147456;
constexpr int PPL = 9, NPHASE = 1 + PPL * NL;

__device__ __forceinline__ float bf2f(bf16 v) { return __uint_as_float((unsigned)v << 16); }
__device__ __forceinline__ float wave_sum(float v) {
#pragma unroll
  for (int o = 32; o; o >>= 1) v += __shfl_xor(v, o);
  return v;
}
__device__ __forceinline__ float log_sigmoid(float x) { return fminf(x, 0.f) - log1pf(expf(-fabsf(x))); }

__device__ __forceinline__ void tr_item(const float* W, int ldw, int srccol0, int nvalid, bf16* WT, int K, int dstrow0, int k0, LAS float* scr, int lane) {
  const int n_ = lane & 31;
#pragma unroll 8
  for (int i = 0; i < 32; ++i) { const int kk = 2 * i + (lane >> 5); scr[kk * 33 + n_] = (n_ < nvalid) ? W[(size_t)(k0 + kk) * ldw + srccol0 + n_] : 0.f; }
  LDS_WAIT(); asm volatile("" ::: "memory");
  const int c = lane & 7;
#pragma unroll
  for (int j = 0; j < 4; ++j) { const int n = (lane >> 3) + 8 * j; const LAS float* s = scr + (8 * c) * 33 + n;
    v4u o; o.x = pk2(s[0 * 33], s[1 * 33]); o.y = pk2(s[2 * 33], s[3 * 33]); o.z = pk2(s[4 * 33], s[5 * 33]); o.w = pk2(s[6 * 33], s[7 * 33]);
    *(GAS v4u*)(WT + (size_t)(dstrow0 + n) * K + k0 + 8 * c) = o; }
  LDS_WAIT(); asm volatile("" ::: "memory");
}
__device__ __forceinline__ void win_src(int n0, int& sc, int& nv) {
  const int pn = n0 >> 8, p = n0 & 255, lc = 64 * ((p >> 5) & 3) + 32 * (p >> 7);
  nv = 32; sc = 0;
  if (pn < 3) sc = OFF_PB + pn * 256 + lc;
  else if (pn < 6) sc = OFF_PC + (pn - 3) * 256 + lc;
  else if (pn == 6) sc = OFF_PDQ + lc;
  else if (pn == 7) sc = OFF_PDKV + lc;
  else if (pn == 8) { sc = OFF_CQ + lc; if (lc >= 192) { nv = 0; sc = 0; } }
  else { if (lc < 128) sc = OFF_CKV + lc; else if (lc < 160) sc = OFF_KR + lc - 128; else if (lc < 192) { sc = OFF_FG; nv = 4; } else { sc = 0; nv = 0; } }
}
__device__ __forceinline__ void prep_rows(const float* X, const bf16* y0, const bf16* y1, float* xout, bf16* XN, const float* g1, int gw, int NGW, int lane) {
  for (int m = gw; m < T; m += NGW) {
    const GAS f32x4* xr = (const GAS f32x4*)(X + (size_t)m * D) + lane;
    f32x4 v[4]; float ss = 0.f;
#pragma unroll
    for (int j = 0; j < 4; ++j) {
      v[j] = xr[64 * j];
      if (y0) {
        const unsigned long long a = *((const GAS unsigned long long*)(y0 + (size_t)m * D) + lane + 64 * j), b = *((const GAS unsigned long long*)(y1 + (size_t)m * D) + lane + 64 * j);
        v[j].x += __uint_as_float((unsigned)a << 16) + __uint_as_float((unsigned)b << 16);
        v[j].y += __uint_as_float((unsigned)a & 0xffff0000u) + __uint_as_float((unsigned)b & 0xffff0000u);
        v[j].z += __uint_as_float((unsigned)(a >> 32) << 16) + __uint_as_float((unsigned)(b >> 32) << 16);
        v[j].w += __uint_as_float((unsigned)(a >> 32) & 0xffff0000u) + __uint_as_float((unsigned)(b >> 32) & 0xffff0000u);
      }
      ss += (v[j].x * v[j].x + v[j].y * v[j].y) + (v[j].z * v[j].z + v[j].w * v[j].w);
    }
    if (xout) {
#pragma unroll
      for (int j = 0; j < 4; ++j) ((GAS f32x4*)(xout + (size_t)m * D) + lane)[64 * j] = v[j];
    }
    if (XN) {
      const float rstd = rsqrtf(wave_sum(ss) * (1.f / D) + EPS);
      GAS unsigned long long* o8 = (GAS unsigned long long*)(XN + (size_t)m * D) + lane;
#pragma unroll
      for (int j = 0; j < 4; ++j) { const f32x4 g = *((const GAS f32x4*)g1 + lane + 64 * j);
        o8[64 * j] = (unsigned long long)pk2(v[j].x * rstd * g.x, v[j].y * rstd * g.y) | ((unsigned long long)pk2(v[j].z * rstd * g.z, v[j].w * rstd * g.w) << 32); }
    }
  }
}

struct EpiInProj {
  static constexpr bool PERM = true, AFTER_DRAIN = false;
  bf16* qkv; bf16* R8; bf16* R9; float* LF; const float* gq; const float* gk; const float* bfox;
  __device__ __forceinline__ void operator()(const pg8::f32x4 (&acc)[2][2][4][2], const pg8::Unit& u, int wr, int wc, int fr, int fq) const {
    const int pn = u.pn;
    bf16* dst; int pitch = 256, cb = 64 * wc; const float* g = nullptr; float sc = 1.f;
    if (pn < 6) { dst = qkv + (size_t)(IQB + pn) * QKV_STRIDE; const int r3 = pn % 3, mx = 1 + pn / 3; if (r3 == 0) { g = gq + mx * 64; sc = C2; } else if (r3 == 1) g = gk + mx * 64; }
    else if (pn == 6) { dst = qkv + (size_t)IQD * QKV_STRIDE; g = gq + 3 * 64; sc = C2; }
    else if (pn == 7) { pitch = 128; if (wc < 2) { dst = qkv + 10 * QKV_STRIDE; g = gk + 3 * 64; } else { dst = qkv + 10 * QKV_STRIDE + (size_t)T * 128; cb = 64 * (wc - 2); } }
    else if (pn == 8) dst = R8; else dst = R9;
    const int rowb = u.pm * 256 + wr * 64 + fr;
    if (g) {
      pg8::f32x4 gv[2][2];
#pragma unroll
      for (int bj = 0; bj < 2; ++bj)
#pragma unroll
        for (int n = 0; n < 2; ++n) gv[bj][n] = *(const pg8::f32x4*)(g + 32 * bj + 8 * fq + 4 * n) * sc;
#pragma unroll
      for (int ai = 0; ai < 2; ++ai)
#pragma unroll
        for (int m = 0; m < 4; ++m) {
          float ss = 0.f;
#pragma unroll
          for (int bj = 0; bj < 2; ++bj)
#pragma unroll
            for (int n = 0; n < 2; ++n) { const pg8::f32x4 x = acc[ai][bj][m][n]; ss += (x[0] * x[0] + x[1] * x[1]) + (x[2] * x[2] + x[3] * x[3]); }
          ss += __shfl_xor(ss, 16); ss += __shfl_xor(ss, 32);
          const float rstd = rsqrtf(ss * (1.f / 64.f) + EPS);
          bf16* rp = dst + (size_t)(rowb + ai * 128 + m * 16) * pitch + cb + 8 * fq;
#pragma unroll
          for (int bj = 0; bj < 2; ++bj) { const pg8::f32x4 v0 = acc[ai][bj][m][0] * gv[bj][0] * rstd, v1 = acc[ai][bj][m][1] * gv[bj][1] * rstd;
            pg8::u32x4 w; w.x = pg8::cvt_pk_bf16(v0[0], v0[1]); w.y = pg8::cvt_pk_bf16(v0[2], v0[3]); w.z = pg8::cvt_pk_bf16(v1[0], v1[1]); w.w = pg8::cvt_pk_bf16(v1[2], v1[3]);
            *(pg8::u32x4*)(rp + 32 * bj) = w; }
        }
    } else {
#pragma unroll
      for (int ai = 0; ai < 2; ++ai)
#pragma unroll
        for (int m = 0; m < 4; ++m) {
          bf16* rp = dst + (size_t)(rowb + ai * 128 + m * 16) * pitch + cb + 8 * fq;
#pragma unroll
          for (int bj = 0; bj < 2; ++bj) { const pg8::f32x4 v0 = acc[ai][bj][m][0], v1 = acc[ai][bj][m][1];
            pg8::u32x4 w; w.x = pg8::cvt_pk_bf16(v0[0], v0[1]); w.y = pg8::cvt_pk_bf16(v0[2], v0[3]); w.z = pg8::cvt_pk_bf16(v1[0], v1[1]); w.w = pg8::cvt_pk_bf16(v1[2], v1[3]);
            *(pg8::u32x4*)(rp + 32 * bj) = w; }
        }
      if (pn == 9 && wc == 2 && fq == 0) {
        const pg8::f32x4 bb = *(const pg8::f32x4*)bfox;
#pragma unroll
        for (int ai = 0; ai < 2; ++ai)
#pragma unroll
          for (int m = 0; m < 4; ++m) { const pg8::f32x4 v = acc[ai][1][m][0] + bb; pg8::f32x4 o;
            o[0] = log_sigmoid(v[0]); o[1] = log_sigmoid(v[1]); o[2] = log_sigmoid(v[2]); o[3] = log_sigmoid(v[3]);
            *(pg8::f32x4*)(LF + (size_t)(rowb + ai * 128 + m * 16) * 4) = o; }
      }
    }
  }
};

__device__ __forceinline__ void n_post(LAS unsigned char* lds, const bf16* R8, const bf16* R9, const float* gcq, const float* gckv, const float* wuq, const float* wukv,
                                       const float* gq0, const float* gk0, bf16* QA, bf16* KA, bf16* VA) {
  LAS float* cqn = (LAS float*)lds; LAS float* ckvn = cqn + 192; LAS float* kva = ckvn + 128; LAS float* tmp = kva + 384; LAS float* red = tmp + 256; LAS float* krs = red + 8;
  const int tid = opq_tid(), lane = tid & 63, w = tid >> 6;
  for (int t = blockIdx.x; t < T; t += gridDim.x) {
    const int pos = t % S;
    const float vq = (tid < 192) ? bf2f(R8[(size_t)t * 256 + tid]) : 0.f;
    const float vk = (tid < 128) ? bf2f(R9[(size_t)t * 256 + tid]) : 0.f;
    const float sq = wave_sum(vq * vq), sk = wave_sum(vk * vk);
    if (lane == 0 && w < 4) { red[w] = sq; red[4 + w] = sk; }
    if (tid < 32) krs[tid] = bf2f(R9[(size_t)t * 256 + 128 + tid]);
    __syncthreads();
    const float rq = rsqrtf((red[0] + red[1] + red[2] + red[3]) * (1.f / 192.f) + EPS);
    const float rk = rsqrtf((red[4] + red[5] + red[6] + red[7]) * (1.f / 128.f) + EPS);
    if (tid < 192) cqn[tid] = vq * rq * gcq[tid];
    if (tid < 128) ckvn[tid] = vk * rk * gckv[tid];
    __syncthreads();
    float qa = 0.f, ka = 0.f;
    if (tid < 256) {
      float k0 = 0.f, k1 = 0.f;
      for (int i = 0; i < 192; ++i) qa += cqn[i] * wuq[i * 256 + tid];
      for (int i = 0; i < 128; ++i) { k0 += ckvn[i] * wukv[i * 384 + tid]; if (tid < 128) k1 += ckvn[i] * wukv[i * 384 + 256 + tid]; }
      kva[tid] = k0; if (tid < 128) kva[256 + tid] = k1;
      const float ss = wave_sum(qa * qa);
      qa = qa * rsqrtf(ss * (1.f / 64.f) + EPS) * gq0[lane];
      tmp[tid] = qa;
    }
    __syncthreads();
    float cs = 1.f, sn = 0.f;
    if (tid < 256 && lane >= 32) { const int j = (lane - 32) & 15; const float inv = powf(10000.f, -(float)(2 * j) / 32.f); const float ang = (float)pos * inv; cs = cosf(ang); sn = sinf(ang); }
    if (tid < 256) {
      float o = qa;
      if (lane >= 32) { if (lane < 48) o = qa * cs - tmp[tid + 16] * sn; else o = qa * cs + tmp[tid - 16] * sn; }
      QA[(size_t)t * 256 + tid] = (bf16)f2bf(o * C2);
      ka = (lane < 32) ? kva[w * 96 + lane] : krs[lane - 32];
      const float ss = wave_sum(ka * ka);
      ka = ka * rsqrtf(ss * (1.f / 64.f) + EPS) * gk0[lane];
    }
    __syncthreads();
    if (tid < 256) tmp[tid] = ka;
    __syncthreads();
    if (tid < 256) {
      float o = ka;
      if (lane >= 32) { if (lane < 48) o = ka * cs - tmp[tid + 16] * sn; else o = ka * cs + tmp[tid - 16] * sn; }
      KA[(size_t)t * 256 + tid] = (bf16)f2bf(o);
      VA[(size_t)t * 256 + tid] = (bf16)f2bf(kva[w * 96 + 32 + lane]);
    }
    __syncthreads();
  }
}
__device__ __forceinline__ void n_cumsum(LAS unsigned char* lds, const float* LF, float* CUM) {
  LAS float* part = (LAS float*)lds + 2048;
  const int tid = opq_tid(); constexpr int per = S / NTHR;
  for (int item = blockIdx.x; item < NB * 4; item += gridDim.x) {
    const int b = item >> 2, h = item & 3;
    float s = 0.f;
    for (int i = 0; i < per; ++i) s += LF[((size_t)b * S + tid * per + i) * 4 + h];
    part[tid] = s;
    __syncthreads();
    if (tid == 0) { float a = 0.f; for (int i = 0; i < NTHR; ++i) { const float v = part[i]; part[i] = a; a += v; } }
    __syncthreads();
    float a = part[tid];
    for (int i = 0; i < per; ++i) { a += LF[((size_t)b * S + tid * per + i) * 4 + h]; CUM[((size_t)b * S + tid * per + i) * 4 + h] = a; }
    __syncthreads();
  }
}
struct Soft { float m, l, o; };
__device__ __forceinline__ void soft_add(Soft& st, float logit2, float v) {
  const float mn = fmaxf(st.m, logit2);
  const float a = exp2f(st.m - mn), pp = exp2f(logit2 - mn);
  st.l = st.l * a + pp; st.o = st.o * a + pp * v; st.m = mn;
}
__device__ __forceinline__ void n_attn(const bf16* qkv, const float* CUM, const float* sink, bf16* MIX, int mask) {
  const int tid_ = opq_tid(), lane = tid_ & 63, wpb = NTHR >> 6;
  const long nitems = (long)T * 16;
  for (long it = (long)blockIdx.x * wpb + (tid_ >> 6); it < nitems; it += (long)gridDim.x * wpb) {
    const int t = T - 1 - (int)(it >> 4), mh = (int)(it & 15), mixer = mh >> 2, h = mh & 3;
    if (!((mask >> mixer) & 1)) continue;
    const int b = t / S, pos = t % S; const long base = (long)b * S;
    Soft st; st.m = -INFINITY; st.l = 0.f; st.o = 0.f;
    if (mixer == 0 || mixer == 2) {
      const bf16* Q = qkv + (size_t)(mixer == 0 ? IQA : IQC) * QKV_STRIDE; const bf16* K = Q + QKV_STRIDE; const bf16* V = K + QKV_STRIDE;
      const float q = bf2f(Q[(size_t)t * 256 + h * 64 + lane]);
      const float ct = (mixer == 2) ? CUM[(size_t)t * 4 + h] : 0.f;
      for (int s = 0; s <= pos; ++s) {
        float d = wave_sum(q * bf2f(K[(size_t)(base + s) * 256 + h * 64 + lane]));
        if (mixer == 2) d += (ct - CUM[(size_t)(base + s) * 4 + h]) * LOG2E;
        soft_add(st, d, bf2f(V[(size_t)(base + s) * 256 + h * 64 + lane]));
      }
    } else if (mixer == 3) {
      const bf16* Q = qkv + (size_t)IQD * QKV_STRIDE; const bf16* K = qkv + 10 * QKV_STRIDE; const bf16* V = K + (size_t)T * 128;
      const int hk = h >> 1;
      const float q = bf2f(Q[(size_t)t * 256 + h * 64 + lane]);
      const float slope = exp2f(-(float)(h + 1)) * LOG2E;
      const int s0 = pos - 127 < 0 ? 0 : pos - 127;
      for (int s = s0; s <= pos; ++s) {
        const float d = wave_sum(q * bf2f(K[(size_t)(base + s) * 128 + hk * 64 + lane])) - slope * (float)(pos - s);
        soft_add(st, d, bf2f(V[(size_t)(base + s) * 128 + hk * 64 + lane]));
      }
      const float sk = sink[h] * LOG2E;
      const float mn = fmaxf(st.m, sk), a = exp2f(st.m - mn);
      st.l = st.l * a + exp2f(sk - mn); st.o *= a; st.m = mn;
    } else {
      const bf16* Q = qkv + (size_t)IQB * QKV_STRIDE; const bf16* K = Q + QKV_STRIDE; const bf16* V = K + QKV_STRIDE;
      const float q = bf2f(Q[(size_t)t * 256 + h * 64 + lane]);
      const float slope = exp2f(-(float)(h + 5)) * LOG2E;
      for (int br = 0; br < 3; ++br) {
        const int dil = br == 0 ? 1 : (br == 1 ? 4 : 16);
        for (int j = 0; j <= 128; ++j) {
          const int s = pos - dil * j;
          if (s < 0) break;
          const float d = wave_sum(q * bf2f(K[(size_t)(base + s) * 256 + h * 64 + lane])) - slope * (float)(dil * j);
          soft_add(st, d, bf2f(V[(size_t)(base + s) * 256 + h * 64 + lane]));
        }
      }
    }
    MIX[(size_t)t * D + mixer * 256 + h * 64 + lane] = (bf16)f2bf(st.o / st.l);
  }
}
__device__ __forceinline__ void n_wo(LAS unsigned char* lds, const bf16* A, const float* Bm, const float* R, float* C) {
  LAS float* As = (LAS float*)lds;
  LAS float* Bs = As + 16 * 129;
  const int tid = opq_tid(), tx = tid & 15, ty = tid >> 4;
  for (int tile = blockIdx.x; tile < (T / 128) * (D / 64); tile += gridDim.x) {
    const int m0 = (tile / (D / 64)) * 128, n0 = (tile % (D / 64)) * 64;
    float acc[4][4];
#pragma unroll
    for (int i = 0; i < 4; ++i)
#pragma unroll
      for (int j = 0; j < 4; ++j) acc[i][j] = 0.f;
    for (int k0 = 0; k0 < D; k0 += 16) {
#pragma unroll
      for (int r = 0; r < 4; ++r) { const int i = tid + NTHR * r, m = i >> 4, k = i & 15; As[k * 129 + m] = bf2f(A[(size_t)(m0 + m) * D + k0 + k]); }
#pragma unroll
      for (int r = 0; r < 2; ++r) { const int i = tid + NTHR * r, k = i >> 6, n = i & 63; Bs[k * 64 + n] = Bm[(size_t)(k0 + k) * D + n0 + n]; }
      __syncthreads();
#pragma unroll
      for (int k = 0; k < 16; ++k) {
        float a[4], b[4];
#pragma unroll
        for (int i = 0; i < 4; ++i) { a[i] = As[k * 129 + ty * 4 + i]; b[i] = Bs[k * 64 + tx * 4 + i]; }
#pragma unroll
        for (int i = 0; i < 4; ++i)
#pragma unroll
          for (int j = 0; j < 4; ++j) acc[i][j] += a[i] * b[j];
      }
      __syncthreads();
    }
#pragma unroll
    for (int i = 0; i < 4; ++i)
#pragma unroll
      for (int j = 0; j < 4; ++j) { const size_t o = (size_t)(m0 + ty * 4 + i) * D + n0 + tx * 4 + j; C[o] = R[o] + acc[i][j]; }
  }
}
__device__ __forceinline__ void n_route(const float* H, const float* g2, const float* wrg, const float* brg, const float* wre, const float* bre, bf16* HN, int* EXPI, float* GATE) {
  const int tid_ = opq_tid(), lane = tid_ & 63, wpb = NTHR >> 6;
  for (int t = blockIdx.x * wpb + (tid_ >> 6); t < T; t += gridDim.x * wpb) {
    const float* hr = H + (size_t)t * D;
    float v[16], ss = 0.f;
#pragma unroll
    for (int j = 0; j < 16; ++j) { v[j] = hr[lane + 64 * j]; ss += v[j] * v[j]; }
    ss = wave_sum(ss);
    const float rstd = rsqrtf(ss * (1.f / D) + EPS);
#pragma unroll
    for (int j = 0; j < 16; ++j) { v[j] = v[j] * rstd * g2[lane + 64 * j]; HN[(size_t)t * D + lane + 64 * j] = (bf16)f2bf(v[j]); }
    float gl[4];
#pragma unroll
    for (int g = 0; g < 4; ++g) {
      float a = 0.f;
#pragma unroll
      for (int j = 0; j < 16; ++j) a += v[j] * wrg[(size_t)(lane + 64 * j) * 4 + g];
      gl[g] = wave_sum(a) + brg[g];
    }
    int gs = 0; float gm = gl[0];
#pragma unroll
    for (int g = 1; g < 4; ++g) if (gl[g] > gm) { gm = gl[g]; gs = g; }
    float den = 0.f;
#pragma unroll
    for (int g = 0; g < 4; ++g) den += expf(gl[g] - gm);
    const float pg = 1.f / den;
    float el[8];
#pragma unroll
    for (int e = 0; e < 8; ++e) {
      float a = 0.f;
#pragma unroll
      for (int j = 0; j < 16; ++j) a += v[j] * wre[(size_t)(lane + 64 * j) * 32 + gs * 8 + e];
      el[e] = wave_sum(a) + bre[gs * 8 + e];
    }
    int i1 = 0; float m1 = el[0];
#pragma unroll
    for (int e = 1; e < 8; ++e) if (el[e] > m1) { m1 = el[e]; i1 = e; }
    int i2 = 0; float m2 = -INFINITY;
#pragma unroll
    for (int e = 0; e < 8; ++e) if (e != i1 && el[e] > m2) { m2 = el[e]; i2 = e; }
    const float e2 = expf(m2 - m1);
    if (lane == 0) {
      EXPI[t * 2] = gs * 8 + i1; EXPI[t * 2 + 1] = gs * 8 + i2;
      GATE[t * 2] = pg / (1.f + e2); GATE[t * 2 + 1] = pg * e2 / (1.f + e2);
    }
  }
}
__device__ __forceinline__ void n_moe(LAS unsigned char* lds, const bf16* HN, const int* EXPI, const float* GATE, const float* w1, const float* w3, const float* w2, float* hio) {
  LAS float* xs = (LAS float*)lds; LAS float* sa = xs + D; LAS float* hid = sa + 512;
  const int tid = opq_tid(), j = tid & 255, half = tid >> 8;
  for (int t = blockIdx.x; t < T; t += gridDim.x) {
    for (int i = tid; i < D; i += NTHR) xs[i] = bf2f(HN[(size_t)t * D + i]);
    __syncthreads();
    float y0 = 0.f, y1 = 0.f;
    for (int k = 0; k < 2; ++k) {
      const int e = EXPI[t * 2 + k]; const float gt = GATE[t * 2 + k];
      const float* W13 = (half ? w3 : w1) + (size_t)e * D * 256; const float* W2 = w2 + (size_t)e * 256 * D;
      float a = 0.f;
      for (int i = 0; i < D; ++i) a += xs[i] * W13[(size_t)i * 256 + j];
      sa[tid] = a;
      __syncthreads();
      if (tid < 256) { const float av = sa[tid], cv = sa[256 + tid]; hid[tid] = av / (1.f + expf(-av)) * cv * gt; }
      __syncthreads();
      for (int jj = 0; jj < 256; ++jj) { const float hv = hid[jj]; y0 += hv * W2[(size_t)jj * D + tid]; y1 += hv * W2[(size_t)jj * D + tid + 512]; }
      __syncthreads();
    }
    hio[(size_t)t * D + tid] += y0; hio[(size_t)t * D + tid + 512] += y1;
  }
}

#ifndef FASTMASK
#define FASTMASK 1
#endif
#ifndef CHK_GAIN
#define CHK_GAIN 10.f
#endif
typedef attn_body::bf16 abf;
template <int MODE> __device__ __forceinline__ void run_unit(const attn_body::AU& u, unsigned char* lds_raw) { attn_body::attn_unit<8, MODE>(u, (char*)lds_raw); }
__device__ __forceinline__ void f_attn(unsigned char* lds_raw, LAS unsigned char* lds, bf16* QKV, const float* CUM, const float* sink, bf16* MIX, bf16* PART, float* LSEP, int mask) {
  const int tid = opq_tid();
  LAS float* bt = (LAS float*)(lds + attn_body::LDS_BIAS);
  const int G = gridDim.x, c = blockIdx.x;
  if (mask & 1) {
    for (int idx = c; idx < 256; idx += G) {
      const int bh = idx & 7, qb = 31 - (idx >> 3), b = bh >> 2, h = bh & 3; const size_t r0 = (size_t)b * S;
      attn_body::AU u{}; u.Q = (const abf*)(QKV + (size_t)IQA * QKV_STRIDE + (r0 + 256 * qb) * 256 + h * 64); u.K = (const abf*)(QKV + (size_t)IKA * QKV_STRIDE + r0 * 256 + h * 64);
      u.V = (const abf*)(QKV + (size_t)IVA * QKV_STRIDE + r0 * 256 + h * 64); u.O = (abf*)(MIX + (r0 + 256 * qb) * D + h * 64); u.qs = 256; u.ks = 256; u.os = D; u.NT = 4 * qb + 4;
      run_unit<0>(u, lds_raw);
    }
  }
  if (mask & 4) {
    for (int idx = c; idx < 256; idx += G) {
      const int bh = idx & 7, qb = 31 - (idx >> 3), b = bh >> 2, h = bh & 3; const size_t r0 = (size_t)b * S;
      attn_body::AU u{}; u.Q = (const abf*)(QKV + (size_t)IQC * QKV_STRIDE + (r0 + 256 * qb) * 256 + h * 64); u.K = (const abf*)(QKV + (size_t)IKC * QKV_STRIDE + r0 * 256 + h * 64);
      u.V = (const abf*)(QKV + (size_t)IVC * QKV_STRIDE + r0 * 256 + h * 64); u.O = (abf*)(MIX + (r0 + 256 * qb) * D + 512 + h * 64); u.qs = 256; u.ks = 256; u.os = D; u.NT = 4 * qb + 4;
      const float cref = CUM[(r0 + 256 * qb) * 4 + h];
      for (int i = tid; i < u.NT * 64; i += NTHR) bt[i] = (cref - CUM[(r0 + i) * 4 + h]) * LOG2E;
      run_unit<1>(u, lds_raw);
    }
  }
  if (mask & 8) {
    for (int idx = c; idx < 256; idx += G) {
      const int bh = idx & 7, qb = idx >> 3, b = bh >> 2, h = bh & 3; const size_t r0 = (size_t)b * S; const int k0 = qb ? 256 * qb - 128 : 0;
      attn_body::AU u{}; u.Q = (const abf*)(QKV + (size_t)IQD * QKV_STRIDE + (r0 + 256 * qb) * 256 + h * 64); u.K = (const abf*)(QKV + 10 * QKV_STRIDE + (r0 + k0) * 128 + (h >> 1) * 64);
      u.V = (const abf*)(QKV + 10 * QKV_STRIDE + (size_t)T * 128 + (r0 + k0) * 128 + (h >> 1) * 64); u.O = (abf*)(MIX + (r0 + 256 * qb) * D + 768 + h * 64); u.qs = 256; u.ks = 128; u.os = D;
      u.NT = qb ? 6 : 4; u.win = 127; u.slope2 = exp2f(-(float)(h + 1)) * LOG2E; u.sink2 = sink[h] * LOG2E;
      const int kq0 = (u.NT - 4) * 64;
      for (int i = tid; i < u.NT * 64; i += NTHR) bt[i] = u.slope2 * (float)(i - kq0);
      run_unit<1 | 2 | 8>(u, lds_raw);
    }
  }
  if (mask & 2) {
    for (int idx = c; idx < 768; idx += G) {
      const int br = idx >> 8, j = idx & 255, dil = br == 0 ? 1 : (br == 1 ? 4 : 16);
      const int bh = j & 7, b = bh >> 2, h = bh & 3; const int rest = j >> 3;
      const int nfb = 32 / dil, cls = rest / nfb, fb = rest % nfb;
      const size_t r0 = (size_t)b * S; const int kf0 = fb ? 256 * fb - 128 : 0;
      const size_t qtok = r0 + cls + (size_t)dil * 256 * fb, ktok = r0 + cls + (size_t)dil * kf0;
      attn_body::AU u{}; u.Q = (const abf*)(QKV + (size_t)IQB * QKV_STRIDE + qtok * 256 + h * 64); u.K = (const abf*)(QKV + (size_t)IKB * QKV_STRIDE + ktok * 256 + h * 64);
      u.V = (const abf*)(QKV + (size_t)IVB * QKV_STRIDE + ktok * 256 + h * 64); u.O = (abf*)(PART + (size_t)br * QKV_STRIDE + qtok * 256 + h * 64); u.LSE = LSEP + (size_t)br * T * 4 + qtok * 4 + h;
      u.qs = 256 * dil; u.ks = 256 * dil; u.os = 256 * dil; u.lses = 4 * dil; u.NT = fb ? 6 : 4; u.win = 128; u.slope2 = exp2f(-(float)(h + 5)) * LOG2E * (float)dil;
      const int kq0 = (u.NT - 4) * 64;
      for (int i = tid; i < u.NT * 64; i += NTHR) bt[i] = u.slope2 * (float)(i - kq0);
      run_unit<1 | 2 | 4>(u, lds_raw);
    }
  }
}
__device__ __forceinline__ void f_bmerge(const bf16* PART, const float* LSEP, bf16* MIX) {
  const int tid = opq_tid();
  for (long i = (long)blockIdx.x * NTHR + tid; i < (long)T * 32; i += (long)gridDim.x * NTHR) {
    const long t = i >> 5; const int ch = (int)(i & 31), h = ch >> 3;
    float l0 = LSEP[t * 4 + h], l1 = LSEP[(size_t)T * 4 + t * 4 + h], l2 = LSEP[(size_t)2 * T * 4 + t * 4 + h];
    const float m = fmaxf(l0, fmaxf(l1, l2)); l0 = exp2f(l0 - m); l1 = exp2f(l1 - m); l2 = exp2f(l2 - m);
    const float inv = 1.f / (l0 + l1 + l2); l0 *= inv; l1 *= inv; l2 *= inv;
    const v4u a = *(const GAS v4u*)(PART + t * 256 + ch * 8), b = *(const GAS v4u*)(PART + QKV_STRIDE + t * 256 + ch * 8), c = *(const GAS v4u*)(PART + 2 * QKV_STRIDE + t * 256 + ch * 8);
    v4u o;
#define MRG(f) { const float lo = l0 * __uint_as_float(a.f << 16) + l1 * __uint_as_float(b.f << 16) + l2 * __uint_as_float(c.f << 16); \
                 const float hi_ = l0 * __uint_as_float(a.f & 0xffff0000u) + l1 * __uint_as_float(b.f & 0xffff0000u) + l2 * __uint_as_float(c.f & 0xffff0000u); o.f = pk2(lo, hi_); }
    MRG(x) MRG(y) MRG(z) MRG(w)
#undef MRG
    *(GAS v4u*)(MIX + t * D + 256 + ch * 8) = o;
  }
}

constexpr int CW_CHK = 1024;
__device__ __forceinline__ void chk_bf16(LAS unsigned char* lds, const bf16* a, const bf16* ref, int pitch, int c0, int nc, float* sums) {
  const int tid = opq_tid(); float d2 = 0.f, r2 = 0.f;
  for (long i = (long)blockIdx.x * NTHR + tid; i < (long)T * nc; i += (long)gridDim.x * NTHR) {
    const long t = i / nc; const int c = c0 + (int)(i % nc);
    const float x = bf2f(a[t * pitch + c]), y = bf2f(ref[t * pitch + c]); const float d = x - y;
    d2 += (d == d) ? d * d : 1e6f; r2 += y * y;
  }
  d2 = wave_sum(d2); r2 = wave_sum(r2);
  if ((tid & 63) == 0) { atomicAdd(sums, d2); atomicAdd(sums + 1, r2); }
}
__device__ __forceinline__ void chk_f32(const float* a, const float* ref, long n, float* sums) {
  const int tid = opq_tid(); float d2 = 0.f, r2 = 0.f;
  for (long i = (long)blockIdx.x * NTHR + tid; i < n; i += (long)gridDim.x * NTHR) { const float d = a[i] - ref[i]; d2 += (d == d) ? d * d : 1e6f; r2 += ref[i] * ref[i]; }
  d2 = wave_sum(d2); r2 = wave_sum(r2);
  if ((tid & 63) == 0) { atomicAdd(sums, d2); atomicAdd(sums + 1, r2); }
}
__device__ __forceinline__ void chk_apply(float* out, const float* sums) {
  const int tid = opq_tid();
  float worst = 0.f;
  for (int k = 0; k < 8; ++k) { const float d2 = __hip_atomic_load(sums + 2 * k, __ATOMIC_RELAXED, __HIP_MEMORY_SCOPE_AGENT), r2 = __hip_atomic_load(sums + 2 * k + 1, __ATOMIC_RELAXED, __HIP_MEMORY_SCOPE_AGENT);
    if (r2 > 0.f || d2 > 0.f) worst = fmaxf(worst, d2 / fmaxf(r2, 1e-30f)); }
  const float f = 1.f + CHK_GAIN * sqrtf(worst);
  for (long i = (long)blockIdx.x * NTHR + tid; i < (long)T * D; i += (long)gridDim.x * NTHR) out[i] *= f;
}

struct Args { const float* in[20]; float* out; unsigned char* ws; int ph_lo, ph_hi, li, pad; };

__global__ void __launch_bounds__(NTHR, 2) mk_fwd(Args args) {
  extern __shared__ __attribute__((aligned(16))) unsigned char lds_raw[];
  LAS unsigned char* lds = (LAS unsigned char*)lds_raw;
  volatile LAS unsigned* MISC = (volatile LAS unsigned*)(lds + MISC_OFF);
  const int tid = opq_tid(), lane = tid & 63, wave = __builtin_amdgcn_readfirstlane(tid >> 6);
  const int G = gridDim.x;
  unsigned char* ws = args.ws;
  gu32* ctl = (gu32*)(ws + WS_CTL);
  for (int u = tid; u < (LDS_BYTES - LDSCTL_OFF) / 4; u += NTHR) ((LAS unsigned*)(lds + LDSCTL_OFF))[u] = 0u;
  __syncthreads();
  XcdBarrier bar = xcd_barrier_post((unsigned*)(ctl + CW_BAR) + args.li * XCD_BAR_WORDS, MISC + 8);
  const int lo = args.ph_lo, hi = args.ph_hi;
#define IN(k) (lo <= (k) && (k) < hi)
#define SEAM(k) do { if (IN(k) && IN((k) + 1)) xcd_barrier(bar); } while (0)
  const float* x = args.in[0]; float* out = args.out;
  bf16* Win_t = (bf16*)(ws + WS_WIN); bf16* Wo_t = (bf16*)(ws + WS_WO);
  bf16* ACT = (bf16*)(ws + WS_ACT); bf16* QKV = (bf16*)(ws + WS_QKV); bf16* R8 = (bf16*)(ws + WS_R8); bf16* R9 = (bf16*)(ws + WS_R9);
  float* LF = (float*)(ws + WS_LF); float* CUM = (float*)(ws + WS_CUM); int* EXPI = (int*)(ws + WS_EXP); float* GATE = (float*)(ws + WS_GATE); bf16* PART = (bf16*)(ws + WS_PART); float* LSEP = (float*)(ws + WS_LSEP);
  const int gw = blockIdx.x * NWAVES + wave, NGW = G * NWAVES;

  if (IN(0)) {
    LAS float* scr = (LAS float*)(lds + wave * 16384);
    constexpr int I_WIN = (NP / 32) * (D / 64), I_WO = (D / 32) * (D / 64);
    constexpr int NITEMS = NL * (I_WIN + I_WO);
    for (int it = gw; it < NITEMS; it += NGW) {
      int r = it;
      if (r < NL * I_WIN) { const int l = r / I_WIN; r %= I_WIN; const int ng = r / (D / 64), kb = r % (D / 64); int sc, nv; win_src(ng * 32, sc, nv);
        tr_item(args.in[2] + (size_t)l * D * NW, NW, sc, nv, Win_t + (size_t)l * NP * D, D, ng * 32, kb * 64, scr, lane); continue; }
      r -= NL * I_WIN;
      { const int l = r / I_WO; r %= I_WO; const int ng = r / (D / 64), kb = r % (D / 64);
        tr_item(args.in[11] + (size_t)l * D * D, D, ng * 32, 32, Wo_t + (size_t)l * D * D, D, ng * 32, kb * 64, scr, lane); }
    }
    prep_rows(x, nullptr, nullptr, nullptr, ACT, args.in[1], gw, NGW, lane);
  }
  SEAM(0);
  for (int l = 0; l < NL; ++l) {
    const int pb = 1 + PPL * l;
    if (IN(pb)) {
      pg8::Gemm g{ACT, Win_t + (size_t)l * NP * D, T, NP, D}; pg8::StaticOrder So; So.init(T, NP, G, (int)blockIdx.x);
      EpiInProj E{QKV, R8, R9, LF, args.in[7] + l * 256, args.in[8] + l * 256, args.in[9] + l * 4};
      pg8::gemm_phase<EpiInProj, pg8::StaticOrder, true, true>(lds, g, So, E);
    }
    SEAM(pb);
    if (IN(pb + 1)) {
      n_post(lds, R8, R9, args.in[3] + l * 192, args.in[4] + l * 128, args.in[5] + (size_t)l * 192 * 256, args.in[6] + (size_t)l * 128 * 384, args.in[7] + l * 256, args.in[8] + l * 256,
             QKV + (size_t)IQA * QKV_STRIDE, QKV + (size_t)IKA * QKV_STRIDE, QKV + (size_t)IVA * QKV_STRIDE);
      n_cumsum(lds, LF, CUM);
    }
    SEAM(pb + 1);
    if (IN(pb + 2)) {
      if (FASTMASK) f_attn(lds_raw, lds, QKV, CUM, args.in[10] + l * 4, ACT, PART, LSEP, FASTMASK);
      if (15 & ~FASTMASK) n_attn(QKV, CUM, args.in[10] + l * 4, ACT, 15 & ~FASTMASK);
    }
    SEAM(pb + 2);
    if (IN(pb + 3)) { if (FASTMASK & 2) f_bmerge(PART, LSEP, ACT); }
    SEAM(pb + 3);
#ifdef CHECK_ATTN
    { bf16* ALT = (bf16*)(ws + WS_W13); n_attn(QKV, CUM, args.in[10] + l * 4, ALT, CHECK_ATTN); xcd_barrier(bar);
      for (int mx = 0; mx < 4; ++mx) if ((CHECK_ATTN >> mx) & 1) chk_bf16(lds, ACT, ALT, D, mx * 256, 256, (float*)(ctl + CW_CHK) + 2 * mx); xcd_barrier(bar); }
#endif
    if (IN(pb + 4)) n_wo(lds, ACT, args.in[11] + (size_t)l * D * D, l == 0 ? x : out, out);
    SEAM(pb + 4);
    if (IN(pb + 5)) n_route(out, args.in[12] + l * D, args.in[13] + (size_t)l * D * 4, args.in[14] + l * 4, args.in[15] + (size_t)l * D * 32, args.in[16] + l * 32, ACT, EXPI, GATE);
    SEAM(pb + 5);
    if (IN(pb + 6)) n_moe(lds, ACT, EXPI, GATE, args.in[17] + (size_t)l * 32 * D * 256, args.in[18] + (size_t)l * 32 * D * 256, args.in[19] + (size_t)l * 32 * 256 * D, out);
    SEAM(pb + 6);
    SEAM(pb + 7);
    if (IN(pb + 8)) { if (l + 1 < NL) prep_rows(out, nullptr, nullptr, nullptr, ACT, args.in[1] + (l + 1) * D, gw, NGW, lane); }
    SEAM(pb + 8);
  }
#if defined(CHECK_ATTN) || defined(CHECK_ANY)
  xcd_barrier(bar); chk_apply(out, (const float*)(ctl + CW_CHK));
#endif
#undef IN
#undef SEAM
}
}

#ifndef MK_N_LAUNCHES
#define MK_N_LAUNCHES 1
#endif
extern "C" void kernel_launch(void* const* d_in, const int* in_sizes, int n_in, void* d_out, int out_size, void* d_ws, size_t ws_size, hipStream_t stream) {
  using namespace mk;
  static int grid = 0;
  if (grid == 0) {
    if (n_in != 20 || out_size != T * D || ws_size < WS_END) { fprintf(stderr, "kernel_launch: unexpected shapes (n_in %d out %d ws %zu)\n", n_in, out_size, ws_size); grid = -1; return; }
    int dev = 0, cus = 0;
    if (hipGetDevice(&dev) != hipSuccess || hipDeviceGetAttribute(&cus, hipDeviceAttributeMultiprocessorCount, dev) != hipSuccess) { grid = -1; return; }
    if (hipFuncSetAttribute((const void*)mk_fwd, hipFuncAttributeMaxDynamicSharedMemorySize, LDS_BYTES) != hipSuccess) { grid = -1; return; }
    grid = cus;
  }
  if (grid < 0) return;
  (void)hipMemsetAsync((char*)d_ws + WS_CTL, 0, CTL_ZERO_BYTES, stream);
  Args a{};
  for (int i = 0; i < 20; ++i) a.in[i] = (const float*)d_in[i];
  a.out = (float*)d_out; a.ws = (unsigned char*)d_ws;
  constexpr int NLA = MK_N_LAUNCHES;
  for (int li = 0; li < NLA; ++li) {
    a.ph_lo = (int)((long)NPHASE * li / NLA); a.ph_hi = (int)((long)NPHASE * (li + 1) / NLA); a.li = li;
    hipLaunchKernelGGL(mk_fwd, dim3(grid), dim3(NTHR), LDS_BYTES, stream, a);
  }
}
```

```cpp
#include <hip/hip_runtime.h>
#include <cstdio>
#include <cstdint>
#include <cmath>
#define OPQ_WMAP_LDS (131072 + 512)
__device__ __forceinline__ int opq_hwkey() { return (int)__builtin_amdgcn_s_getreg((5 << 11) | 4) & 63; }
__device__ __forceinline__ void opq_init() { const int t = threadIdx.x; if ((t & 63) == 0) *(__attribute__((address_space(3))) int*)(OPQ_WMAP_LDS + 4 * opq_hwkey()) = t >> 6; }
__device__ __forceinline__ int opq_tid() {
  int key = opq_hwkey(); asm volatile("" : "+s"(key));
  const int w = *(const volatile __attribute__((address_space(3))) int*)(OPQ_WMAP_LDS + 4 * key);
  int t = (__builtin_amdgcn_readfirstlane(w) << 6) | (int)__builtin_amdgcn_mbcnt_hi(~0u, __builtin_amdgcn_mbcnt_lo(~0u, 0u)); asm volatile("" : "+v"(t)); return t; }
__device__ __forceinline__ int opq_bid() { int t = blockIdx.x; asm volatile("" : "+s"(t)); return t; }

template <int M> __device__ __forceinline__ float xor_lane(float v) {
  if constexpr (M < 32) return __builtin_bit_cast(float, __builtin_amdgcn_ds_swizzle(__builtin_bit_cast(int, v), 0x1f | (M << 10)));
  else { auto r = __builtin_amdgcn_permlane32_swap(__builtin_bit_cast(unsigned, v), __builtin_bit_cast(unsigned, v), false, false); return __builtin_bit_cast(float, (unsigned)(__builtin_amdgcn_mbcnt_hi(~0u, __builtin_amdgcn_mbcnt_lo(~0u, 0u)) < 32 ? r[1] : r[0])); }
}
#define FASTMASK 15

namespace pg8 {
#define PG8_LAS __attribute__((address_space(3)))
typedef unsigned short bf16_t;
typedef short bf16x8 __attribute__((ext_vector_type(8)));
typedef float f32x4 __attribute__((ext_vector_type(4)));
typedef unsigned u32x4 __attribute__((ext_vector_type(4)));
constexpr int BM = 256, BK = 64, HALF = 128, HTB = HALF * BK * 2  , STAGE_BYTES = 8 * HTB, NXCD = 8, WGM = 8;

__host__ __device__ __forceinline__ int lds_byte(int r, int c) { const int st = (r >> 4) * 2 + (c >> 5), rr = r & 15, cc = c & 31, ob = rr * 64 + cc * 2; return st * 1024 + (ob ^ (((ob >> 9) & 1) << 5)); }
__host__ __device__ __forceinline__ void stage_rc(int b, int& R, int& C) { const int st = b / 1024, sb = b % 1024, swz = sb ^ (((sb >> 9) & 1) << 5); R = (st >> 1) * 16 + swz / 64; C = (st & 1) * 32 + (swz % 64) / 2; }
__host__ __device__ __forceinline__ int perm32(int rho) { const int n = rho >> 4, i = rho & 15; return 8 * (i >> 2) + 4 * n + (i & 3); }

struct Unit { int pm, pn; };
struct Gemm { const bf16_t* A; const bf16_t* Bt; int M, N, K; };

struct StaticOrder {
    int nM, nN, nwg, G, c;
    __host__ __device__ void init(int M, int N, int G_, int c_) { nM = M / BM; nN = N / BM; nwg = nM * nN; G = G_; c = c_; }
    __host__ __device__ bool next(int i, Unit& u) const {
        const long L = (long)i * G + c; if (L >= nwg) return false;
        int wgid = (int)L; { const int q = nwg / NXCD, r = nwg % NXCD, xcd = wgid % NXCD, off = wgid / NXCD; wgid = (xcd < r ? xcd * (q + 1) : r * (q + 1) + (xcd - r) * q) + off; }
        const int nig = WGM * nN, gid = wgid / nig, fm = gid * WGM, gsz = (nM - fm) < WGM ? (nM - fm) : WGM;
        u.pm = fm + ((wgid % nig) % gsz); u.pn = (wgid % nig) / gsz; return true;
    }
    __device__ __forceinline__ void a_ready(const Unit&) const {}
    __device__ __forceinline__ void done(const Unit&) const {}
};

__device__ __forceinline__ unsigned cvt_pk_bf16(float lo, float hi) { unsigned r; asm volatile("v_cvt_pk_bf16_f32 %0, %1, %2" : "=v"(r) : "v"(lo), "v"(hi)); return r; }
typedef float f32x2 __attribute__((ext_vector_type(2)));
__device__ __forceinline__ f32x2 gelu_pk(f32x2 v) {
    const f32x2 av = __builtin_elementwise_abs(v), d = av * 0.2316418882f + 1.0f;
    f32x2 t; t.x = __builtin_amdgcn_rcpf(d.x); t.y = __builtin_amdgcn_rcpf(d.y);
    f32x2 q = t * 0.5307027145f + (-0.7265760135f); q = q * t + 0.7107068705f; q = q * t + (-0.142248368f); q = q * t + 0.127414796f; q = q * t;
    const f32x2 s = (v * v) * (-0.72134752044f);
    f32x2 e; e.x = __builtin_amdgcn_exp2f(s.x); e.y = __builtin_amdgcn_exp2f(s.y);
    const f32x2 m = v * (q * e), r = v - m;
    f32x2 o; o.x = v.x < 0.f ? m.x : r.x; o.y = v.y < 0.f ? m.y : r.y; return o;
}

template <int ACT  > struct EpiBf16 {
    static constexpr bool PERM = true, AFTER_DRAIN = false; static_assert(ACT == 0 || ACT == 1, "EpiBf16: ACT is 0 (none) or 1 (gelu_pk)");
    bf16_t* O; int ldc; const float* bias; int split_cols; size_t split_stride; float scale0;
    __device__ __forceinline__ void operator()(const f32x4 (&acc)[2][2][4][2], const Unit& u, int wr, int wc, int fr, int fq) const {
        const int row0 = u.pm * BM + wr * 64 + fr; int colt = u.pn * BM; bf16_t* base = O;
        float sc = 1.f; if (split_cols) { const int t = colt / split_cols; base += (size_t)t * split_stride; colt -= t * split_cols; if (t == 0) sc = scale0; }
        const int col0 = colt + wc * 32 + 8 * fq, bcol0 = u.pn * BM + wc * 32 + 8 * fq;
        f32x4 bv[2][2];
#pragma unroll
        for (int bj = 0; bj < 2; ++bj)
#pragma unroll
            for (int n = 0; n < 2; ++n) bv[bj][n] = bias ? *(const f32x4*)(bias + bcol0 + bj * HALF + 4 * n) : (f32x4){0.f, 0.f, 0.f, 0.f};
#pragma unroll
        for (int ai = 0; ai < 2; ++ai)
#pragma unroll
            for (int m = 0; m < 4; ++m) { bf16_t* rowp = base + (size_t)(row0 + ai * HALF + m * 16) * ldc + col0;
#pragma unroll
                for (int bj = 0; bj < 2; ++bj) { f32x4 v0 = acc[ai][bj][m][0] + bv[bj][0], v1 = acc[ai][bj][m][1] + bv[bj][1];
                    if (ACT == 1) { f32x2 a = gelu_pk((f32x2){v0[0], v0[1]}), b = gelu_pk((f32x2){v0[2], v0[3]}), c = gelu_pk((f32x2){v1[0], v1[1]}), d = gelu_pk((f32x2){v1[2], v1[3]});
                        v0 = (f32x4){a.x, a.y, b.x, b.y}; v1 = (f32x4){c.x, c.y, d.x, d.y}; }
                    v0 = v0 * sc; v1 = v1 * sc; u32x4 w; w.x = cvt_pk_bf16(v0[0], v0[1]); w.y = cvt_pk_bf16(v0[2], v0[3]); w.z = cvt_pk_bf16(v1[0], v1[1]); w.w = cvt_pk_bf16(v1[2], v1[3]);
                    *(u32x4*)(rowp + bj * HALF) = w; } }
    }
};
template <class Epi, class Sched, bool ALIGN_EPI = false, bool SP2 = false>
__device__ __forceinline__ void gemm_phase(PG8_LAS unsigned char* lds, const Gemm g, const Sched& S, const Epi& E) {
    const int tid = opq_tid(), wid = __builtin_amdgcn_readfirstlane(tid >> 6), lane = tid & 63, wr = wid >> 2, wc = wid & 3, fr = lane & 15, fq = lane >> 4;
    const int K = g.K, nt = K / BK;
    unsigned voffA[2], voffB[2];
#pragma unroll
    for (int i = 0; i < 2; ++i) { int R, C; stage_rc(tid * 16 + i * 8192, R, C); const int Rb = Epi::PERM ? ((R & ~31) + perm32(R & 31)) : R;
        voffA[i] = (unsigned)(R * K + C) * 2u; voffB[i] = (unsigned)(Rb * K + C) * 2u; }
    const size_t kstep = (size_t)(BK * 2);
    const size_t hstep = (size_t)HALF * K * 2;
    const size_t tstep = 2 * hstep;
    const unsigned ldsw = (unsigned)wid * 1024u;
    const int aoff = lds_byte(wr * 64 + fr, fq * 8), boff = lds_byte(wc * 32 + fr, fq * 8);
#define PG8_SA(b, h) (((b) * 2 + (h)) * HTB)
#define PG8_SB(b, h) ((4 + (b) * 2 + (h)) * HTB)
#define PG8_STAGE(bufoff, gbase, voff) do { _Pragma("unroll") for (int _i = 0; _i < 2; ++_i) \
        __builtin_amdgcn_global_load_lds((const unsigned*)((const char*)(gbase) + (voff)[_i]), (PG8_LAS unsigned*)(lds + (bufoff) + ldsw + _i * 8192), 16, 0, 0); } while (0)
#define PG8_LDA(dst, b, h) do { _Pragma("unroll") for (int m = 0; m < 4; ++m) _Pragma("unroll") for (int k = 0; k < 2; ++k) dst[m][k] = *(const PG8_LAS bf16x8*)(lds + PG8_SA(b, h) + aoff + m * 2048 + k * 1024); } while (0)
#define PG8_LDB(dst, b, h) do { _Pragma("unroll") for (int n = 0; n < 2; ++n) _Pragma("unroll") for (int k = 0; k < 2; ++k) dst[n][k] = *(const PG8_LAS bf16x8*)(lds + PG8_SB(b, h) + boff + n * 2048 + k * 1024); } while (0)
#define PG8_MMA(ai, bj, At, Bt) do { __builtin_amdgcn_s_setprio(1); _Pragma("unroll") for (int m = 0; m < 4; ++m) _Pragma("unroll") for (int n = 0; n < 2; ++n) _Pragma("unroll") for (int k = 0; k < 2; ++k) \
        acc[ai][bj][m][n] = __builtin_amdgcn_mfma_f32_16x16x32_bf16(Bt[n][k], At[m][k], acc[ai][bj][m][n], 0, 0, 0); __builtin_amdgcn_s_setprio(0); } while (0)
#define PG8_WAIT_V(n) asm volatile("s_waitcnt vmcnt(" #n ")" ::: "memory")
#define PG8_WAIT_L(n) asm volatile("s_waitcnt lgkmcnt(" #n ")" ::: "memory")
#define PG8_BAR __builtin_amdgcn_s_barrier()
#define PG8_SCHED __builtin_amdgcn_sched_barrier(0)
    Unit cur, nxt; int ui = 0;
    if (!S.next(0, cur)) return;
    f32x4 acc[2][2][4][2];
#pragma unroll
    for (int a = 0; a < 2; ++a)
#pragma unroll
        for (int b = 0; b < 2; ++b)
#pragma unroll
            for (int m = 0; m < 4; ++m)
#pragma unroll
                for (int n = 0; n < 2; ++n) acc[a][b][m][n] = (f32x4){0.f, 0.f, 0.f, 0.f};
    bf16x8 At[4][2], B0[2][2], B1[2][2];
    const char* cA = (const char*)g.A + (size_t)cur.pm * tstep; const char* cB = (const char*)g.Bt + (size_t)cur.pn * tstep;
    S.a_ready(cur);
    if constexpr (SP2) {
        PG8_STAGE(PG8_SB(0, 0), cB, voffB); PG8_STAGE(PG8_SB(0, 1), cB + hstep, voffB); PG8_STAGE(PG8_SA(0, 0), cA, voffA); PG8_STAGE(PG8_SA(0, 1), cA + hstep, voffA);
        if (wr == 1) PG8_BAR;
        PG8_WAIT_V(2); PG8_BAR;
        PG8_STAGE(PG8_SB(1, 0), cB + kstep, voffB); PG8_STAGE(PG8_SA(1, 0), cA + kstep, voffA); PG8_STAGE(PG8_SB(1, 1), cB + hstep + kstep, voffB);
        PG8_WAIT_V(6); PG8_BAR;
    } else {
        PG8_STAGE(PG8_SB(0, 0), cB, voffB); PG8_STAGE(PG8_SA(0, 0), cA, voffA); PG8_STAGE(PG8_SB(0, 1), cB + hstep, voffB); PG8_STAGE(PG8_SA(0, 1), cA + hstep, voffA);
        if (wr == 1) PG8_BAR;
        PG8_WAIT_V(4); PG8_BAR;
        PG8_STAGE(PG8_SB(1, 0), cB + kstep, voffB); PG8_STAGE(PG8_SA(1, 0), cA + kstep, voffA); PG8_STAGE(PG8_SB(1, 1), cB + hstep + kstep, voffB);
        PG8_WAIT_V(6); PG8_BAR;
    }
    for (;;) {
        const bool has_next = S.next(ui + 1, nxt);
        const char* nA = has_next ? (const char*)g.A + (size_t)nxt.pm * tstep : cA; const char* nB = has_next ? (const char*)g.Bt + (size_t)nxt.pn * tstep : cB;
        for (int t = 0; t < nt; t += 2) {
            const bool last = (t == nt - 2);
            const char* a1 = cA + (size_t)(t + 1) * kstep;
            const char* a2 = last ? nA : cA + (size_t)(t + 2) * kstep; const char* b2 = last ? nB : cB + (size_t)(t + 2) * kstep;
            const char* a3 = a2 + kstep; const char* b3 = b2 + kstep;
            if (last && has_next) S.a_ready(nxt);
            if constexpr (SP2) {
            PG8_LDB(B0, 0, 0); PG8_LDB(B1, 0, 1); PG8_SCHED; PG8_LDA(At, 0, 0); PG8_STAGE(PG8_SA(1, 1), a1 + hstep, voffA);
            PG8_WAIT_V(8); PG8_WAIT_L(0); PG8_BAR; PG8_MMA(0, 0, At, B0); PG8_MMA(0, 1, At, B1); PG8_BAR; PG8_SCHED;
            PG8_LDA(At, 0, 1); PG8_STAGE(PG8_SB(0, 0), b2, voffB); PG8_STAGE(PG8_SB(0, 1), b2 + hstep, voffB); PG8_STAGE(PG8_SA(0, 0), a2, voffA);
            PG8_WAIT_V(8); PG8_WAIT_L(0); PG8_BAR; PG8_MMA(1, 0, At, B0); PG8_MMA(1, 1, At, B1); PG8_BAR; PG8_SCHED;
            PG8_LDB(B0, 1, 0); PG8_LDB(B1, 1, 1); PG8_SCHED; PG8_LDA(At, 1, 0); PG8_STAGE(PG8_SA(0, 1), a2 + hstep, voffA);
            PG8_WAIT_V(8); PG8_WAIT_L(0); PG8_BAR; PG8_MMA(0, 0, At, B0); PG8_MMA(0, 1, At, B1); PG8_BAR; PG8_SCHED;
            PG8_LDA(At, 1, 1); PG8_STAGE(PG8_SB(1, 0), b3, voffB); PG8_STAGE(PG8_SB(1, 1), b3 + hstep, voffB); PG8_STAGE(PG8_SA(1, 0), a3, voffA);
            PG8_WAIT_V(8); PG8_WAIT_L(0); PG8_BAR; PG8_MMA(1, 0, At, B0); PG8_MMA(1, 1, At, B1); PG8_BAR; PG8_SCHED;
            } else {
            PG8_LDB(B0, 0, 0); PG8_SCHED; PG8_LDA(At, 0, 0); PG8_STAGE(PG8_SA(1, 1), a1 + hstep, voffA);
            PG8_WAIT_L(8); PG8_BAR; PG8_WAIT_L(0); PG8_MMA(0, 0, At, B0); PG8_BAR; PG8_SCHED;
            PG8_LDB(B1, 0, 1); PG8_STAGE(PG8_SB(0, 0), b2, voffB);
            PG8_BAR; PG8_WAIT_L(0); PG8_MMA(0, 1, At, B1); PG8_BAR;
            PG8_LDA(At, 0, 1); PG8_STAGE(PG8_SA(0, 0), a2, voffA);
            PG8_BAR; PG8_WAIT_L(0); PG8_MMA(1, 0, At, B0); PG8_BAR; PG8_SCHED;
            PG8_STAGE(PG8_SB(0, 1), b2 + hstep, voffB);
            PG8_WAIT_V(6); PG8_BAR; PG8_MMA(1, 1, At, B1); PG8_BAR;
            PG8_LDB(B0, 1, 0); PG8_SCHED; PG8_LDA(At, 1, 0); PG8_STAGE(PG8_SA(0, 1), a2 + hstep, voffA);
            PG8_WAIT_L(8); PG8_BAR; PG8_WAIT_L(0); PG8_MMA(0, 0, At, B0); PG8_BAR; PG8_SCHED;
            PG8_LDB(B1, 1, 1); PG8_STAGE(PG8_SB(1, 0), b3, voffB);
            PG8_BAR; PG8_WAIT_L(0); PG8_MMA(0, 1, At, B1); PG8_BAR;
            PG8_LDA(At, 1, 1); PG8_STAGE(PG8_SA(1, 0), a3, voffA);
            PG8_BAR; PG8_WAIT_L(0); PG8_MMA(1, 0, At, B0); PG8_BAR; PG8_SCHED;
            PG8_STAGE(PG8_SB(1, 1), b3 + hstep, voffB);
            PG8_WAIT_V(6); PG8_BAR; PG8_MMA(1, 1, At, B1); PG8_BAR;
            }
        }
        if constexpr (ALIGN_EPI) { if (wr == 0) PG8_BAR; }
        if constexpr (!Epi::AFTER_DRAIN) { E(acc, cur, wr, wc, fr, fq); S.done(cur); }
        if (!has_next) break;
#pragma unroll
        for (int a = 0; a < 2; ++a)
#pragma unroll
            for (int b = 0; b < 2; ++b)
#pragma unroll
                for (int m = 0; m < 4; ++m)
#pragma unroll
                    for (int n = 0; n < 2; ++n) acc[a][b][m][n] = (f32x4){0.f, 0.f, 0.f, 0.f};
        cur = nxt; cA = nA; cB = nB; ++ui;
        if constexpr (ALIGN_EPI) { if (wr == 1) PG8_BAR; }
    }
    PG8_WAIT_V(0);
    if constexpr (!ALIGN_EPI) { if (wr == 0) PG8_BAR; }
    PG8_BAR;
    if constexpr (Epi::AFTER_DRAIN) { E.fused(acc, cur, wr, wc, fr, fq, lds, wid, lane); S.done(cur); }
#undef PG8_SA
#undef PG8_SB
#undef PG8_STAGE
#undef PG8_LDA
#undef PG8_LDB
#undef PG8_MMA
#undef PG8_WAIT_V
#undef PG8_WAIT_L
#undef PG8_BAR
#undef PG8_SCHED
}
}

#ifndef PG8_SP2
#define PG8_SP2 true
#endif
#ifndef PG8_ALIGN
#define PG8_ALIGN true
#endif
namespace pg8 {
template <class Epi, class Sched, bool ALIGN_EPI = false>
__device__ __forceinline__ void gemm_phase_g(PG8_LAS unsigned char* lds, const Gemm g, const Sched& S, const Epi& E, const PG8_LAS int* tab) {
    const int tid = opq_tid(), wid = __builtin_amdgcn_readfirstlane(tid >> 6), lane = tid & 63, wr = wid >> 2, wc = wid & 3, fr = lane & 15, fq = lane >> 4;
    const int K = g.K, nt = K / BK;
    unsigned voffB[2]; int Rl[2]; unsigned Cl[2];
#pragma unroll
    for (int i = 0; i < 2; ++i) { int R, C; stage_rc(tid * 16 + i * 8192, R, C); const int Rb = Epi::PERM ? ((R & ~31) + perm32(R & 31)) : R;
        Rl[i] = R; Cl[i] = (unsigned)C * 2u; voffB[i] = (unsigned)(Rb * K + C) * 2u; }
    unsigned vC0[2], vC1[2], vN0[2], vN1[2];
#define PG8_LDOFF(i_, h0, h1) do { _Pragma("unroll") for (int _i = 0; _i < 2; ++_i) { h0[_i] = (unsigned)tab[(i_) * 256 + Rl[_i]] * (unsigned)(K * 2) + Cl[_i]; h1[_i] = (unsigned)tab[(i_) * 256 + 128 + Rl[_i]] * (unsigned)(K * 2) + Cl[_i]; } } while (0)
    const size_t kstep = (size_t)(BK * 2);
    const size_t hstep = (size_t)HALF * K * 2;
    const size_t tstep = 2 * hstep;
    const unsigned ldsw = (unsigned)wid * 1024u;
    const int aoff = lds_byte(wr * 64 + fr, fq * 8), boff = lds_byte(wc * 32 + fr, fq * 8);
#define PG8_SA(b, h) (((b) * 2 + (h)) * HTB)
#define PG8_SB(b, h) ((4 + (b) * 2 + (h)) * HTB)
#define PG8_STAGE(bufoff, gbase, voff) do { _Pragma("unroll") for (int _i = 0; _i < 2; ++_i) \
        __builtin_amdgcn_global_load_lds((const unsigned*)((const char*)(gbase) + (voff)[_i]), (PG8_LAS unsigned*)(lds + (bufoff) + ldsw + _i * 8192), 16, 0, 0); } while (0)
#define PG8_LDA(dst, b, h) do { _Pragma("unroll") for (int m = 0; m < 4; ++m) _Pragma("unroll") for (int k = 0; k < 2; ++k) dst[m][k] = *(const PG8_LAS bf16x8*)(lds + PG8_SA(b, h) + aoff + m * 2048 + k * 1024); } while (0)
#define PG8_LDB(dst, b, h) do { _Pragma("unroll") for (int n = 0; n < 2; ++n) _Pragma("unroll") for (int k = 0; k < 2; ++k) dst[n][k] = *(const PG8_LAS bf16x8*)(lds + PG8_SB(b, h) + boff + n * 2048 + k * 1024); } while (0)
#define PG8_MMA(ai, bj, At, Bt) do { __builtin_amdgcn_s_setprio(1); _Pragma("unroll") for (int m = 0; m < 4; ++m) _Pragma("unroll") for (int n = 0; n < 2; ++n) _Pragma("unroll") for (int k = 0; k < 2; ++k) \
        acc[ai][bj][m][n] = __builtin_amdgcn_mfma_f32_16x16x32_bf16(Bt[n][k], At[m][k], acc[ai][bj][m][n], 0, 0, 0); __builtin_amdgcn_s_setprio(0); } while (0)
#define PG8_WAIT_V(n) asm volatile("s_waitcnt vmcnt(" #n ")" ::: "memory")
#define PG8_WAIT_L(n) asm volatile("s_waitcnt lgkmcnt(" #n ")" ::: "memory")
#define PG8_BAR __builtin_amdgcn_s_barrier()
#define PG8_SCHED __builtin_amdgcn_sched_barrier(0)
    Unit cur, nxt; int ui = 0;
    if (!S.next(0, cur)) return;
    f32x4 acc[2][2][4][2];
#pragma unroll
    for (int a = 0; a < 2; ++a)
#pragma unroll
        for (int b = 0; b < 2; ++b)
#pragma unroll
            for (int m = 0; m < 4; ++m)
#pragma unroll
                for (int n = 0; n < 2; ++n) acc[a][b][m][n] = (f32x4){0.f, 0.f, 0.f, 0.f};
    bf16x8 At[4][2], B0[2][2], B1[2][2];
    const char* const cA = (const char*)g.A; const char* cB = (const char*)g.Bt + (size_t)cur.pn * tstep;
    PG8_LDOFF(0, vC0, vC1);
    S.a_ready(cur);
    {
        PG8_STAGE(PG8_SB(0, 0), cB, voffB); PG8_STAGE(PG8_SB(0, 1), cB + hstep, voffB); PG8_STAGE(PG8_SA(0, 0), cA, vC0); PG8_STAGE(PG8_SA(0, 1), cA, vC1);
        if (wr == 1) PG8_BAR;
        PG8_WAIT_V(2); PG8_BAR;
        PG8_STAGE(PG8_SB(1, 0), cB + kstep, voffB); PG8_STAGE(PG8_SA(1, 0), cA + kstep, vC0); PG8_STAGE(PG8_SB(1, 1), cB + hstep + kstep, voffB);
        PG8_WAIT_V(6); PG8_BAR;
    }
    for (;;) {
        const bool has_next = S.next(ui + 1, nxt);
        const char* nB = has_next ? (const char*)g.Bt + (size_t)nxt.pn * tstep : cB;
        if (has_next) PG8_LDOFF(ui + 1, vN0, vN1); else { vN0[0] = vC0[0]; vN0[1] = vC0[1]; vN1[0] = vC1[0]; vN1[1] = vC1[1]; }
        for (int t = 0; t < nt; t += 2) {
            const bool last = (t == nt - 2);
            const char* a1 = cA + (size_t)(t + 1) * kstep;
            const char* a2 = last ? cA : cA + (size_t)(t + 2) * kstep; const char* b2 = last ? nB : cB + (size_t)(t + 2) * kstep;
            unsigned s0[2], s1[2]; s0[0] = last ? vN0[0] : vC0[0]; s0[1] = last ? vN0[1] : vC0[1]; s1[0] = last ? vN1[0] : vC1[0]; s1[1] = last ? vN1[1] : vC1[1];
            const char* a3 = a2 + kstep; const char* b3 = b2 + kstep;
            if (last && has_next) S.a_ready(nxt);
            PG8_LDB(B0, 0, 0); PG8_LDB(B1, 0, 1); PG8_SCHED; PG8_LDA(At, 0, 0); PG8_STAGE(PG8_SA(1, 1), a1, vC1);
            PG8_WAIT_V(8); PG8_WAIT_L(0); PG8_BAR; PG8_MMA(0, 0, At, B0); PG8_MMA(0, 1, At, B1); PG8_BAR; PG8_SCHED;
            PG8_LDA(At, 0, 1); PG8_STAGE(PG8_SB(0, 0), b2, voffB); PG8_STAGE(PG8_SB(0, 1), b2 + hstep, voffB); PG8_STAGE(PG8_SA(0, 0), a2, s0);
            PG8_WAIT_V(8); PG8_WAIT_L(0); PG8_BAR; PG8_MMA(1, 0, At, B0); PG8_MMA(1, 1, At, B1); PG8_BAR; PG8_SCHED;
            PG8_LDB(B0, 1, 0); PG8_LDB(B1, 1, 1); PG8_SCHED; PG8_LDA(At, 1, 0); PG8_STAGE(PG8_SA(0, 1), a2, s1);
            PG8_WAIT_V(8); PG8_WAIT_L(0); PG8_BAR; PG8_MMA(0, 0, At, B0); PG8_MMA(0, 1, At, B1); PG8_BAR; PG8_SCHED;
            PG8_LDA(At, 1, 1); PG8_STAGE(PG8_SB(1, 0), b3, voffB); PG8_STAGE(PG8_SB(1, 1), b3 + hstep, voffB); PG8_STAGE(PG8_SA(1, 0), a3, s0);
            PG8_WAIT_V(8); PG8_WAIT_L(0); PG8_BAR; PG8_MMA(1, 0, At, B0); PG8_MMA(1, 1, At, B1); PG8_BAR; PG8_SCHED;
        }
        if constexpr (ALIGN_EPI) { if (wr == 0) PG8_BAR; }
        if constexpr (!Epi::AFTER_DRAIN) { E(acc, cur, wr, wc, fr, fq); S.done(cur); }
        if (!has_next) break;
#pragma unroll
        for (int a = 0; a < 2; ++a)
#pragma unroll
            for (int b = 0; b < 2; ++b)
#pragma unroll
                for (int m = 0; m < 4; ++m)
#pragma unroll
                    for (int n = 0; n < 2; ++n) acc[a][b][m][n] = (f32x4){0.f, 0.f, 0.f, 0.f};
        cur = nxt; cB = nB; ++ui; vC0[0] = vN0[0]; vC0[1] = vN0[1]; vC1[0] = vN1[0]; vC1[1] = vN1[1];
        if constexpr (ALIGN_EPI) { if (wr == 1) PG8_BAR; }
    }
    PG8_WAIT_V(0);
    if constexpr (!ALIGN_EPI) { if (wr == 0) PG8_BAR; }
    PG8_BAR;
    if constexpr (Epi::AFTER_DRAIN) { E.fused(acc, cur, wr, wc, fr, fq, lds, wid, lane); S.done(cur); }
#undef PG8_SA
#undef PG8_LDOFF
#undef PG8_SB
#undef PG8_STAGE
#undef PG8_LDA
#undef PG8_LDB
#undef PG8_MMA
#undef PG8_WAIT_V
#undef PG8_WAIT_L
#undef PG8_BAR
#undef PG8_SCHED
}
}
#include <hip/hip_bf16.h>
#include <cmath>
namespace attn_body {
using bf16=__hip_bfloat16;
using bf16x8=__attribute__((ext_vector_type(8)))short;
using s16x4=__attribute__((ext_vector_type(4)))short;
using f32x16=__attribute__((ext_vector_type(16)))float;
using u32x4=__attribute__((ext_vector_type(4)))unsigned;
constexpr int BATCH=2,NHEAD=4,SEQ=8192,D=64,DM=NHEAD*D;
constexpr int NW=8,QBLK=32,QB=QBLK*NW,KVBLK=64,NQB=SEQ/QB;
constexpr int ATTN_PITCH=DM, ATTN_UNIT_ROWS=QB;
__device__ __forceinline__ int crow(int r,int hi){return (r&3)+8*(r>>2)+4*hi;}
#define SBAR() __builtin_amdgcn_sched_barrier(0)
__device__ __forceinline__ void cmask(f32x16&p0,f32x16&p1,int jb,int qrel,int hi){
  const float NEG=-INFINITY; int kb=64*jb+4*hi;
  #pragma unroll
  for(int r=0;r<16;++r){int kv=kb+(r&3)+8*(r>>2); if(kv>qrel)p0[r]=NEG; if(kv+32>qrel)p1[r]=NEG;}
}

constexpr int NSLOT=3, SLOTB=8192;
constexpr int LDS_K=0, LDS_V=NSLOT*SLOTB, LDS_WS=2*NSLOT*SLOTB, LDS_OST=LDS_WS+NW*64*4, LDS_BIAS=LDS_OST+NW*4096, LDS_BYTES=LDS_BIAS+(SEQ+64)*4;
constexpr float C2=0.125f*1.4426950408889634f;
__device__ __forceinline__ void glds16(const void*gsrc,unsigned lds_dst){unsigned keep;
  asm volatile("s_mov_b32 %0, m0\n\ts_mov_b32 m0, %2\n\ts_nop 0\n\tglobal_load_lds_dwordx4 %1, off\n\ts_mov_b32 m0, %0":"=&s"(keep):"v"(gsrc),"s"(lds_dst):"memory");}
__device__ __forceinline__ float max3f(float a,float b,float c){float r;asm("v_max3_f32 %0, %1, %2, %3":"=v"(r):"v"(a),"v"(b),"v"(c));return r;}
__device__ __forceinline__ float max2f(float a,float b){float r;asm("v_max_f32_e32 %0, %1, %2":"=v"(r):"v"(a),"v"(b));return r;}
__device__ __forceinline__ float fadd_s(float a,float b){float r;asm("v_add_f32_e32 %0, %1, %2":"=v"(r):"v"(a),"v"(b));return r;}
__device__ __forceinline__ float fsub_s(float a,float b){float r;asm("v_sub_f32_e32 %0, %1, %2":"=v"(r):"v"(a),"v"(b));return r;}
typedef float f32x2_t __attribute__((ext_vector_type(2))); typedef float f32x4_t __attribute__((ext_vector_type(4))); typedef __bf16 bf16x2_t __attribute__((ext_vector_type(2)));
__device__ __forceinline__ unsigned cvtpk_s(float lo,float hi){f32x2_t v={lo,hi};bf16x2_t b=__builtin_convertvector(v,bf16x2_t);return __builtin_bit_cast(unsigned,b);}
#define WAIT_BAR(N) asm volatile("s_waitcnt vmcnt(" #N ") lgkmcnt(0)\n\ts_barrier":::"memory")

__device__ __forceinline__ void qkt(f32x16&p0,f32x16&p1,const char*Kslot,const bf16x8*qr,const f32x16&negm,int r32,int hi){
  const char*kb=Kslot+hi*1024+r32*16;
  #pragma unroll
  for(int d0=0;d0<4;++d0){
    const bf16x8 b0=*reinterpret_cast<const bf16x8*>(kb+d0*2048);
    const bf16x8 b1=*reinterpret_cast<const bf16x8*>(kb+d0*2048+512);
    if(d0==0){p0=__builtin_amdgcn_mfma_f32_32x32x16_bf16(b0,qr[0],negm,0,0,0);p1=__builtin_amdgcn_mfma_f32_32x32x16_bf16(b1,qr[0],negm,0,0,0);}
    else{p0=__builtin_amdgcn_mfma_f32_32x32x16_bf16(b0,qr[d0],p0,0,0,0);p1=__builtin_amdgcn_mfma_f32_32x32x16_bf16(b1,qr[d0],p1,0,0,0);}}
}
typedef __attribute__((address_space(3))) const char* lds_cptr;
typedef short v4i16_t __attribute__((ext_vector_type(4)));
__device__ __forceinline__ void kload8(bf16x8*kf,lds_cptr kp){
  kf[0]=*(const __attribute__((address_space(3))) bf16x8*)(kp);      kf[1]=*(const __attribute__((address_space(3))) bf16x8*)(kp+512);
  kf[2]=*(const __attribute__((address_space(3))) bf16x8*)(kp+2048); kf[3]=*(const __attribute__((address_space(3))) bf16x8*)(kp+2560);
  kf[4]=*(const __attribute__((address_space(3))) bf16x8*)(kp+4096); kf[5]=*(const __attribute__((address_space(3))) bf16x8*)(kp+4608);
  kf[6]=*(const __attribute__((address_space(3))) bf16x8*)(kp+6144); kf[7]=*(const __attribute__((address_space(3))) bf16x8*)(kp+6656);
}
__device__ __forceinline__ void kload2(bf16x8*kf,lds_cptr kp,int j){ kf[2*j]=*(const __attribute__((address_space(3))) bf16x8*)(kp+j*2048); kf[2*j+1]=*(const __attribute__((address_space(3))) bf16x8*)(kp+j*2048+512); }
__device__ __forceinline__ s16x4 vtr(lds_cptr p){ return __builtin_bit_cast(s16x4,__builtin_amdgcn_ds_read_tr16_b64_v4i16((__attribute__((address_space(3))) v4i16_t*)p)); }
__device__ __forceinline__ float rowmax(const f32x16&p0,const f32x16&p1){
  float a=max3f(p0[0],p0[1],p1[0]),b=max3f(p0[2],p0[3],p1[1]);a=max3f(a,p1[2],p1[3]);
  #pragma unroll
  for(int r=4;r<16;r+=4){a=max3f(a,p0[r],p0[r+1]);b=max3f(b,p0[r+2],p0[r+3]);a=max3f(a,p1[r],p1[r+1]);b=max3f(b,p1[r+2],p1[r+3]);}
  const float m=max2f(a,b);
  auto rr=__builtin_amdgcn_permlane32_swap(__float_as_uint(m),__float_as_uint(m),false,false);
  return max2f(__uint_as_float(rr[0]),__uint_as_float(rr[1]));
}
__device__ __forceinline__ void pv(f32x16*o,int vb,bf16x8 pa0,bf16x8 pa1,bf16x8 pa2,bf16x8 pa3){
  #pragma unroll
  for(int d0=0;d0<2;++d0){s16x4 lo[4],hi[4];
    #pragma unroll
    for(int ks=0;ks<4;++ks){
      asm volatile("ds_read_b64_tr_b16 %0,%1 offset:%c2":"=&v"(lo[ks]):"v"(vb),"i"(d0*4096+ks*1024):"memory");
      asm volatile("ds_read_b64_tr_b16 %0,%1 offset:%c2":"=&v"(hi[ks]):"v"(vb),"i"(d0*4096+ks*1024+512):"memory");}
    asm volatile("s_waitcnt lgkmcnt(0)":::"memory");SBAR();
    #define PK(k) (bf16x8){lo[k][0],lo[k][1],lo[k][2],lo[k][3],hi[k][0],hi[k][1],hi[k][2],hi[k][3]}
    o[d0]=__builtin_amdgcn_mfma_f32_32x32x16_bf16(pa0,PK(0),o[d0],0,0,0);
    o[d0]=__builtin_amdgcn_mfma_f32_32x32x16_bf16(pa1,PK(1),o[d0],0,0,0);
    o[d0]=__builtin_amdgcn_mfma_f32_32x32x16_bf16(pa2,PK(2),o[d0],0,0,0);
    o[d0]=__builtin_amdgcn_mfma_f32_32x32x16_bf16(pa3,PK(3),o[d0],0,0,0);
    #undef PK
  }
}

#ifndef ATTN_STORE16
#define ATTN_STORE16(p,v) (*(u32x4*)(p)=(v))
#endif
struct AU { const bf16*Q; const bf16*K; const bf16*V; bf16*O; float*LSE; long qs,ks,os; int NT,win,lses,pad; float slope2,sink2; };
template<int THRL,int MODE> __device__ __forceinline__ void attn_unit(const AU&u,char*shm){
  const int tid=opq_tid(),lane=tid&63,r32=lane&31,hi=lane>>5; const int wid=__builtin_amdgcn_readfirstlane(tid>>6);
  const long ks=u.ks;
  const bf16*Qw=u.Q+(long)(wid*QBLK)*u.qs;
  const bf16*Kh=u.K,*Vh=u.V;
  const unsigned lds0=(unsigned)(uintptr_t)shm;
  float*wsf=(float*)(shm+LDS_WS)+wid*64;
  const bf16*ksrc=Kh+(long)lane*ks+wid*8;
  const bf16*vsrc=Vh+(long)(16*(wid&3)+(lane>>2))*ks+(wid>>2)*32+(lane&3)*8;
  const unsigned kdst=lds0+LDS_K+wid*1024, vdst=lds0+LDS_V+wid*1024;
  #define DMA_K(t,slot) glds16(ksrc+(long)(t)*KVBLK*ks,(unsigned)__builtin_amdgcn_readfirstlane(kdst+(slot)))
  #define DMA_V(t,slot) glds16(vsrc+(long)(t)*KVBLK*ks,(unsigned)__builtin_amdgcn_readfirstlane(vdst+(slot)))
  const int vb0=(int)(lds0+LDS_V)+((lane>>4)&1)*32+(lane&3)*8+(4*hi+((lane&15)>>2))*64;
  const char*Kbase=shm+LDS_K; bf16x8 kf[8];
  const lds_cptr shm3=(lds_cptr)shm; const lds_cptr kp0=shm3+LDS_K+hi*1024+r32*16; const lds_cptr vp0=shm3+LDS_V+((lane>>4)&1)*32+(lane&3)*8+(4*hi+((lane&15)>>2))*64;
  const int NT=u.NT;
  const lds_cptr biasp=shm3+LDS_BIAS;
  DMA_K(0,0);DMA_V(0,0);DMA_K(1,SLOTB);
  bf16x8 qr[4];
  #pragma unroll
  for(int d0=0;d0<4;++d0)qr[d0]=*reinterpret_cast<const bf16x8*>(&Qw[(long)r32*u.qs+d0*16+hi*8]);
  float mhat=0.f,l_reg=0.f;f32x16 o[2];o[0]=f32x16{};o[1]=f32x16{};f32x16 negm=f32x16{};if(!(MODE&1)){asm volatile("":"+v"(negm));}
  const int qrel=wid*QBLK+r32;
  #define CMASK(P0,P1,t) do{int jb_=(t)-(NT-4); if(jb_>=0)cmask(P0,P1,jb_,qrel,hi);}while(0)
  #define BIASW(P0,P1,t) do{ if(MODE&1){ const lds_cptr bt_=biasp+((t)*64+4*hi)*4; const float nm_=-mhat; SBAR(); \
      { f32x4_t b_[2]; _Pragma("unroll") for(int g_=0;g_<2;++g_) b_[g_]=*(const __attribute__((address_space(3))) f32x4_t*)(bt_+0+32*(g_+0)); \
        _Pragma("unroll") for(int g_=0;g_<2;++g_){ P0[4*(g_+0)]+=b_[g_][0]+nm_;P0[4*(g_+0)+1]+=b_[g_][1]+nm_;P0[4*(g_+0)+2]+=b_[g_][2]+nm_;P0[4*(g_+0)+3]+=b_[g_][3]+nm_; } } \
      asm volatile("":"+v"(P0)); SBAR(); \
      { f32x4_t b_[2]; _Pragma("unroll") for(int g_=0;g_<2;++g_) b_[g_]=*(const __attribute__((address_space(3))) f32x4_t*)(bt_+0+32*(g_+2)); \
        _Pragma("unroll") for(int g_=0;g_<2;++g_){ P0[4*(g_+2)]+=b_[g_][0]+nm_;P0[4*(g_+2)+1]+=b_[g_][1]+nm_;P0[4*(g_+2)+2]+=b_[g_][2]+nm_;P0[4*(g_+2)+3]+=b_[g_][3]+nm_; } } \
      asm volatile("":"+v"(P0)); SBAR(); \
      { f32x4_t b_[2]; _Pragma("unroll") for(int g_=0;g_<2;++g_) b_[g_]=*(const __attribute__((address_space(3))) f32x4_t*)(bt_+128+32*(g_+0)); \
        _Pragma("unroll") for(int g_=0;g_<2;++g_){ P1[4*(g_+0)]+=b_[g_][0]+nm_;P1[4*(g_+0)+1]+=b_[g_][1]+nm_;P1[4*(g_+0)+2]+=b_[g_][2]+nm_;P1[4*(g_+0)+3]+=b_[g_][3]+nm_; } } \
      asm volatile("":"+v"(P1)); SBAR(); \
      { f32x4_t b_[2]; _Pragma("unroll") for(int g_=0;g_<2;++g_) b_[g_]=*(const __attribute__((address_space(3))) f32x4_t*)(bt_+128+32*(g_+2)); \
        _Pragma("unroll") for(int g_=0;g_<2;++g_){ P1[4*(g_+2)]+=b_[g_][0]+nm_;P1[4*(g_+2)+1]+=b_[g_][1]+nm_;P1[4*(g_+2)+2]+=b_[g_][2]+nm_;P1[4*(g_+2)+3]+=b_[g_][3]+nm_; } } \
      asm volatile("":"+v"(P1)); SBAR(); \
      } \
    if(MODE&2){ const int kw_=64*((t)-(NT-4))+4*hi-qrel+u.win; \
      _Pragma("unroll") for(int r=0;r<16;++r){ const int kv_=kw_+(r&3)+8*(r>>2); if(kv_<0)P0[r]=-INFINITY; if(kv_+32<0)P1[r]=-INFINITY; } } }while(0)
  bool resc=false;
  #define START(P0,P1) do{ const float rm=rowmax(P0,P1); resc=false; \
    { const float dl=(MODE&2)?max2f(rm,-1000.f):rm; mhat=fadd_s(mhat,dl); \
      _Pragma("unroll") for(int r=0;r<16;++r){P0[r]=fsub_s(P0[r],dl);P1[r]=fsub_s(P1[r],dl);} \
      if(!(MODE&1)){ _Pragma("unroll") for(int r=0;r<16;++r)negm[r]=-mhat; asm volatile("":"+v"(negm)); } } \
    _Pragma("unroll") for(int r=0;r<16;++r)P0[r]=__builtin_amdgcn_exp2f(P0[r]); }while(0)
  #define RESC() do{ if(resc){ asm volatile("s_waitcnt lgkmcnt(0)":::"memory"); \
      _Pragma("unroll") for(int d_=0;d_<2;++d_) _Pragma("unroll") for(int r=0;r<16;++r)o[d_][r]*=wsf[crow(r,hi)]; } }while(0)
  f32x16 pA0,pA1,pB0,pB1;
  int sl_prev=0,sl_cur=0,sl_next=SLOTB;
  #define ROT() do{sl_prev=sl_cur;sl_cur=sl_next;sl_next=(sl_next==(NSLOT-1)*SLOTB)?0:sl_next+SLOTB;}while(0)
  DMA_K(2,2*SLOTB);
  WAIT_BAR(3);
  qkt(pA0,pA1,Kbase,qr,negm,r32,hi);asm volatile("s_nop 15\n\ts_nop 7":"+v"(pA0),"+v"(pA1));BIASW(pA0,pA1,0);CMASK(pA0,pA1,0);
  START(pA0,pA1);
  _Pragma("unroll") for(int r=0;r<16;++r)pA1[r]=__builtin_amdgcn_exp2f(pA1[r]);
  WAIT_BAR(0);
  DMA_K(3,0);DMA_V(1,SLOTB);
  ROT();
  kload8(kf,kp0+sl_cur);
  WAIT_BAR(2);
  s16x4 vlo[8],vhi[8]; u32x4 pw0,pw1,pw2,pw3;
  #define PKW(P,B) cvtpk_s(P[B],P[B+1])
  #define PAF(k) __builtin_bit_cast(bf16x8,pw##k)
  #define VFR(i) (bf16x8){vlo[i][0],vlo[i][1],vlo[i][2],vlo[i][3],vhi[i][0],vhi[i][1],vhi[i][2],vhi[i][3]}
  #define PIN(x) asm volatile("":"+v"(x))
  #define MX3(a,b,c) __builtin_fmaxf(__builtin_fmaxf((a),(b)),(c))
  #define GAPA(MF,A0,A1,A2,A3,W0,W1,PW) do{ MF; sacc+=A0; sacc+=A1; sacc+=A2; sacc+=A3; PIN(sacc); W0; W1; PIN(PW); SBAR(); }while(0)
  #define EX(v) __builtin_amdgcn_exp2f(v)
  #define GAPB(MF,X,B) do{ MF; X[B]=EX(X[B]); X[B+1]=EX(X[B+1]); X[B+2]=EX(X[B+2]); X[B+3]=EX(X[B+3]); PIN(X); SBAR(); }while(0)
  #define VRD(i) do{ vlo[i]=vtr(vp_+(((i)>>2)*4096+((i)&3)*1024)); vhi[i]=vtr(vp_+(((i)>>2)*4096+((i)&3)*1024+512)); }while(0)
  #define KRD(G,j) do{ if(G){ kload2(kf,kp0+sl_next,j); SBAR(); } }while(0)
  #define STEP(C0,C1,P0,P1,t,GK,GV,GL) do{ SBAR(); \
    const lds_cptr vp_=vp0+sl_prev; \
    VRD(0); SBAR(); float sacc=(P0[0]+P0[1]); \
    GAPA(C0=__builtin_amdgcn_mfma_f32_32x32x16_bf16(kf[0],qr[0],negm,0,0,0), P0[2],P0[3],P0[4],P0[5],     pw0[0]=PKW(P0,0), pw0[1]=PKW(P0,2), pw0); \
    VRD(4); SBAR(); GAPA(C1=__builtin_amdgcn_mfma_f32_32x32x16_bf16(kf[1],qr[0],negm,0,0,0), P0[6],P0[7],P0[8],P0[9],     pw0[2]=PKW(P0,4), pw0[3]=PKW(P0,6), pw0); \
    VRD(1); SBAR(); GAPA(C0=__builtin_amdgcn_mfma_f32_32x32x16_bf16(kf[2],qr[1],C0,0,0,0),   P0[10],P0[11],P0[12],P0[13], pw1[0]=PKW(P0,8), pw1[1]=PKW(P0,10), pw1); \
    VRD(5); SBAR(); GAPA(C1=__builtin_amdgcn_mfma_f32_32x32x16_bf16(kf[3],qr[1],C1,0,0,0),   P0[14],P0[15],P1[0],P1[1],   pw1[2]=PKW(P0,12),pw1[3]=PKW(P0,14), pw1); \
    VRD(2); SBAR(); GAPA(C0=__builtin_amdgcn_mfma_f32_32x32x16_bf16(kf[4],qr[2],C0,0,0,0),   P1[2],P1[3],P1[4],P1[5],     pw2[0]=PKW(P1,0), pw2[1]=PKW(P1,2), pw2); \
    VRD(6); SBAR(); GAPA(C1=__builtin_amdgcn_mfma_f32_32x32x16_bf16(kf[5],qr[2],C1,0,0,0),   P1[6],P1[7],P1[8],P1[9],     pw2[2]=PKW(P1,4), pw2[3]=PKW(P1,6), pw2); \
    VRD(3); SBAR(); GAPA(C0=__builtin_amdgcn_mfma_f32_32x32x16_bf16(kf[6],qr[3],C0,0,0,0),   P1[10],P1[11],P1[12],P1[13], pw3[0]=PKW(P1,8), pw3[1]=PKW(P1,10), pw3); \
    VRD(7); SBAR(); GAPA(C1=__builtin_amdgcn_mfma_f32_32x32x16_bf16(kf[7],qr[3],C1,0,0,0),   P1[14],P1[15],0.f,0.f,       pw3[2]=PKW(P1,12),pw3[3]=PKW(P1,14), pw3); \
    l_reg+=sacc; \
    if(GK){DMA_K((t)+3,sl_cur);} if(GV){DMA_V((t)+1,sl_next);} \
    BIASW(C0,C1,t); CMASK(C0,C1,t); \
    { float a=MX3(C0[0],C0[1],C1[0]),b=MX3(C0[2],C0[3],C1[1]); a=MX3(a,C1[2],C1[3]); \
      _Pragma("unroll") for(int r=4;r<16;r+=4){a=MX3(a,C0[r],C0[r+1]);b=MX3(b,C0[r+2],C0[r+3]);a=MX3(a,C1[r],C1[r+1]);b=MX3(b,C1[r+2],C1[r+3]);} \
      float rm=__builtin_fmaxf(a,b); { auto rr=__builtin_amdgcn_permlane32_swap(__float_as_uint(rm),__float_as_uint(rm),false,false); rm=__builtin_fmaxf(__uint_as_float(rr[0]),__uint_as_float(rr[1])); } \
      resc=false; \
      if(__builtin_expect(__any(rm>(float)THRL),0)){ const float dl=__builtin_fmaxf(rm,0.f); mhat+=dl; \
        _Pragma("unroll") for(int r=0;r<16;++r){C0[r]-=dl;C1[r]-=dl;} \
        if(!(MODE&1)){ _Pragma("unroll") for(int r=0;r<16;++r)negm[r]=-mhat; asm volatile("":"+v"(negm)); } \
        const float f=__builtin_amdgcn_exp2f(-dl); l_reg*=f; if(hi==0)wsf[r32]=f; resc=true; } } \
    SBAR(); \
    GAPB(o[0]=__builtin_amdgcn_mfma_f32_32x32x16_bf16(PAF(0),VFR(0),o[0],0,0,0), C0,0); \
    GAPB(o[1]=__builtin_amdgcn_mfma_f32_32x32x16_bf16(PAF(0),VFR(4),o[1],0,0,0), C0,4); \
    KRD(GL,0); GAPB(o[0]=__builtin_amdgcn_mfma_f32_32x32x16_bf16(PAF(1),VFR(1),o[0],0,0,0), C0,8); \
    KRD(GL,1); GAPB(o[1]=__builtin_amdgcn_mfma_f32_32x32x16_bf16(PAF(1),VFR(5),o[1],0,0,0), C0,12); \
    KRD(GL,2); GAPB(o[0]=__builtin_amdgcn_mfma_f32_32x32x16_bf16(PAF(2),VFR(2),o[0],0,0,0), C1,0); \
    KRD(GL,3); GAPB(o[1]=__builtin_amdgcn_mfma_f32_32x32x16_bf16(PAF(2),VFR(6),o[1],0,0,0), C1,4); \
    GAPB(o[0]=__builtin_amdgcn_mfma_f32_32x32x16_bf16(PAF(3),VFR(3),o[0],0,0,0), C1,8); \
    GAPB(o[1]=__builtin_amdgcn_mfma_f32_32x32x16_bf16(PAF(3),VFR(7),o[1],0,0,0), C1,12); \
    }while(0)
  int t=1;
  #undef CMASK
  #define CMASK(P0,P1,t) do{}while(0)
  for(;t+5<NT;t+=2){
    STEP(pB0,pB1,pA0,pA1,t,true,true,true);     WAIT_BAR(2); RESC(); ROT();
    STEP(pA0,pA1,pB0,pB1,t+1,true,true,true);   WAIT_BAR(2); RESC(); ROT();
  }
  #undef CMASK
  #define CMASK(P0,P1,t) do{int jb_=(t)-(NT-4); if(jb_>=0)cmask(P0,P1,jb_,qrel,hi);}while(0)
  #define ENDW(tt) do{ if((tt)+3<NT){WAIT_BAR(2);} else if((tt)+2<NT){WAIT_BAR(1);} else {WAIT_BAR(0);} }while(0)
  for(;t+1<NT;t+=2){
    STEP(pB0,pB1,pA0,pA1,t,(t+3<NT),(t+1<NT),(t+1<NT));       ENDW(t);   RESC(); ROT();
    STEP(pA0,pA1,pB0,pB1,t+1,(t+4<NT),(t+2<NT),(t+2<NT));     ENDW(t+1); RESC(); ROT();
  }
  STEP(pB0,pB1,pA0,pA1,NT-1,false,false,false); RESC();
  { float sacc=pB0[0]+pB0[1]; _Pragma("unroll") for(int r=2;r<16;++r)sacc+=pB0[r]; _Pragma("unroll") for(int r=0;r<16;++r)sacc+=pB1[r]; l_reg+=sacc;
    pw0=(u32x4){PKW(pB0,0),PKW(pB0,2),PKW(pB0,4),PKW(pB0,6)};pw1=(u32x4){PKW(pB0,8),PKW(pB0,10),PKW(pB0,12),PKW(pB0,14)};pw2=(u32x4){PKW(pB1,0),PKW(pB1,2),PKW(pB1,4),PKW(pB1,6)};pw3=(u32x4){PKW(pB1,8),PKW(pB1,10),PKW(pB1,12),PKW(pB1,14)};
    SBAR(); pv(o,vb0+sl_cur,PAF(0),PAF(1),PAF(2),PAF(3)); }
  #undef PKW
  #undef PAF
  #undef VFR
  #undef PIN
  #undef MX3
  #undef GAPA
  #undef GAPB
  #undef EX
  #undef VRD
  #undef KRD
  #undef STEP
  #undef ENDW
  {auto rr=__builtin_amdgcn_permlane32_swap(__float_as_uint(l_reg),__float_as_uint(l_reg),false,false);l_reg=__uint_as_float(rr[0])+__uint_as_float(rr[1]);}
  if(MODE&8)l_reg+=__builtin_amdgcn_exp2f(u.sink2+u.slope2*(float)qrel-mhat);
  if((MODE&4)&&hi==0)u.LSE[(long)qrel*u.lses]=mhat+__builtin_amdgcn_logf(l_reg)-u.slope2*(float)qrel;
  if(hi==0)wsf[32+r32]=l_reg;asm volatile("s_waitcnt lgkmcnt(0)":::"memory");
  float rli[16];
  #pragma unroll
  for(int r=0;r<16;++r)rli[r]=__builtin_amdgcn_rcpf(wsf[32+crow(r,hi)]);
  bf16*Ow=u.O+(long)(wid*QBLK)*u.os;
  { bf16*stg=(bf16*)(shm+LDS_OST)+wid*2048;
    #pragma unroll
    for(int r=0;r<16;++r){const int orow=crow(r,hi);
      #pragma unroll
      for(int d0=0;d0<2;++d0)stg[orow*64+d0*32+r32]=__float2bfloat16(o[d0][r]*rli[r]);}
    asm volatile("s_waitcnt lgkmcnt(0)":::"memory");
    #pragma unroll
    for(int i=0;i<4;++i){const int row=i*8+(lane>>3),ch=lane&7; const u32x4 v=*(const u32x4*)(stg+row*64+ch*8); ATTN_STORE16(Ow+(long)row*u.os+ch*8,v);} }
  asm volatile("s_waitcnt lgkmcnt(0)\n\ts_barrier":::"memory");
  #undef DMA_K
  #undef DMA_V
  #undef CMASK
  #undef BIASW
  #undef START
  #undef RESC
  #undef ROT
}
constexpr int ATTN_LDS_BYTES=LDS_BYTES;
#undef SBAR
#undef WAIT_BAR
}
#define GAS __attribute__((address_space(1)))
#define LAS __attribute__((address_space(3)))
typedef unsigned short bf16;
typedef unsigned v4u __attribute__((ext_vector_type(4)));
typedef float f32x4 __attribute__((ext_vector_type(4)));
typedef short bf16x8 __attribute__((ext_vector_type(8)));
typedef GAS unsigned gu32;
typedef GAS unsigned long long gu64;
#define RLX_AGENT __ATOMIC_RELAXED, __HIP_MEMORY_SCOPE_AGENT
#define LDS_WAIT() asm volatile("s_waitcnt lgkmcnt(0)" ::: "memory")
#define VM_WAIT() asm volatile("s_waitcnt vmcnt(0)" ::: "memory")
__device__ __forceinline__ unsigned long long rt() { return __builtin_amdgcn_s_memrealtime(); }
__device__ __forceinline__ unsigned f2bf(float f) { unsigned u = __builtin_bit_cast(unsigned, f); return (u + 0x7fffu + ((u >> 16) & 1u)) >> 16; }
__device__ __forceinline__ unsigned pk2(float lo, float hi) { return f2bf(lo) | (f2bf(hi) << 16); }

#define XB_TMO      128
#define XB_XCNT(j)  (256  + 64 * (j))
#define XB_XSUB(j)  (1280 + 64 * (j))
#define XB_XGEN(j)  (2304 + 64 * (j))
#define XB_TOP      3328
#define XB_TOPGEN   3392
#define XCD_BAR_WORDS 3456
#define XB_SPIN_CAP (1u << 24)

__device__ __forceinline__ unsigned xb_ld(unsigned* p)              { return __hip_atomic_load(p, __ATOMIC_RELAXED, __HIP_MEMORY_SCOPE_AGENT); }
__device__ __forceinline__ unsigned xb_add(unsigned* p, unsigned v) { return __hip_atomic_fetch_add(p, v, __ATOMIC_RELAXED, __HIP_MEMORY_SCOPE_AGENT); }
__device__ __forceinline__ unsigned xb_xcc_id() { return (unsigned)__builtin_amdgcn_s_getreg((3 << 11) | 20) & 0xFu; }
#define XB_SPIN(cond, bar) do { unsigned _sp = 0; while (cond) { __builtin_amdgcn_s_sleep(1); \
    if ((++_sp & 255u) == 0u) { if (xb_ld(&(bar)[XB_TMO])) break; if (_sp > XB_SPIN_CAP) { atomicAdd(&(bar)[XB_TMO], 1u); break; } } } } while (0)

struct XcdBarrier {
    unsigned* bar; unsigned x;
    volatile LAS unsigned* st;
};

__device__ __forceinline__ XcdBarrier xcd_barrier_post(unsigned* bar, volatile LAS unsigned* st) {
    XcdBarrier b; b.bar = bar; b.x = xb_xcc_id(); b.st = st;
    if (opq_tid() == 0) (void)xb_add(&bar[XB_XCNT(b.x)], 1u);
    return b;
}
__device__ __forceinline__ void xcd_barrier_complete(unsigned* bar, unsigned x, unsigned& nloc, unsigned& nx) {
    const unsigned G = gridDim.x * gridDim.y * gridDim.z;
    unsigned sum, cnt, mine, sp = 0u;
    for (;;) {
        sum = 0u; cnt = 0u; mine = 0u;
#pragma unroll
        for (unsigned j = 0; j < 16; ++j) { const unsigned c = xb_ld(&bar[XB_XCNT(j)]); sum += c; cnt += (c > 0u) ? 1u : 0u; mine = (j == x) ? c : mine; }
        if (sum == G) break;
        __builtin_amdgcn_s_sleep(1);
        if ((++sp & 255u) == 0u) { if (xb_ld(&bar[XB_TMO])) break; if (sp > XB_SPIN_CAP) { atomicAdd(&bar[XB_TMO], 1u); break; } }
    }
    nloc = mine > 0u ? mine : 1u; nx = cnt > 0u ? cnt : 1u;
}

__device__ __forceinline__ void xcd_barrier(const XcdBarrier& b) {
    asm volatile("s_waitcnt vmcnt(0)" ::: "memory");
    __syncthreads();
    if (opq_tid() == 0) {
        unsigned* bar = b.bar;
        __builtin_amdgcn_s_waitcnt(0);
        unsigned nloc = b.st[0], nx = b.st[1];
        if (nloc == 0u) { xcd_barrier_complete(bar, b.x, nloc, nx); b.st[0] = nloc; b.st[1] = nx; }
        const unsigned old = xb_add(&bar[XB_XSUB(b.x)], 1u);
        const unsigned gen = old / nloc;
        if (old + 1u == (gen + 1u) * nloc) {
            __builtin_amdgcn_fence(__ATOMIC_RELEASE, "agent");
            asm volatile("s_waitcnt vmcnt(0)" ::: "memory");
            const unsigned og = xb_add(&bar[XB_TOP], 1u);
            const unsigned tg = og / nx;
            if (og + 1u == (tg + 1u) * nx) xb_add(&bar[XB_TOPGEN], 1u);
            else XB_SPIN(xb_ld(&bar[XB_TOPGEN]) == tg, bar);
            __builtin_amdgcn_fence(__ATOMIC_ACQUIRE, "agent");
            xb_add(&bar[XB_XGEN(b.x)], 1u);
            asm volatile("s_waitcnt vmcnt(0)" ::: "memory");
        } else {
            XB_SPIN(xb_ld(&bar[XB_XGEN(b.x)]) == gen, bar);
            __builtin_amdgcn_fence(__ATOMIC_ACQUIRE, "agent");
            asm volatile("s_waitcnt vmcnt(0)" ::: "memory");
        }
    }
    __syncthreads();
}
namespace mk {
constexpr int NB = 2, S = 8192, D = 1024, T = NB * S, NL = 2, NW = 2404, NP = 2560;
constexpr int OFF_CQ = 0, OFF_CKV = 192, OFF_KR = 320, OFF_PB = 352, OFF_PC = 1120, OFF_FG = 1888, OFF_PDQ = 1892, OFF_PDKV = 2148;
constexpr float EPS = 1e-6f, LOG2E = 1.4426950408889634f, C2 = 0.125f * 1.4426950408889634f;
constexpr int NWAVES = 8, NTHR = 512;
constexpr size_t MiB = 1u << 20;
constexpr size_t WS_CTL = 0, CTL_ZERO_BYTES = 1 * MiB;
constexpr size_t WS_WIN = 1 * MiB;
constexpr size_t WS_WO = 11 * MiB;
constexpr size_t WS_WUQ = 15 * MiB;
constexpr size_t WS_WUKV = 15 * MiB + MiB / 2;
constexpr size_t WS_W13 = 16 * MiB;
constexpr size_t WS_W2 = 80 * MiB;
constexpr size_t WS_ACT = 112 * MiB;
constexpr size_t WS_QKV = 144 * MiB;
constexpr size_t WS_R8 = 232 * MiB, WS_R9 = 240 * MiB;
constexpr size_t WS_LF = 248 * MiB, WS_CUM = WS_LF + MiB / 4, WS_EXP = 249 * MiB, WS_GATE = WS_EXP + MiB / 4;
constexpr size_t WS_PART = 250 * MiB;
constexpr size_t WS_LSEP = 274 * MiB;
constexpr size_t WS_Y0 = 144 * MiB, WS_Y1 = 176 * MiB;
constexpr size_t WS_HID = 208 * MiB;
constexpr size_t WS_LIST = 276 * MiB;
constexpr size_t WS_END = 278 * MiB;
constexpr int CW_CNT = 2048;
constexpr size_t QKV_STRIDE = (size_t)T * 256;
enum { IQA = 0, IKA, IVA, IQB, IKB, IVB, IQC, IKC, IVC, IQD };
constexpr int CW_BAR = 4096;
constexpr int RING_BYTES = 131072, LDSCTL_OFF = RING_BYTES, MISC_OFF = LDSCTL_OFF + 320, LDS_BYTES = 147456;
constexpr int LDS_TILES = RING_BYTES + 1024, LDS_NTI = RING_BYTES + 2560, LDS_TAB = RING_BYTES + 3072;
constexpr int PPL = 9, NPHASE = 1 + PPL * NL;

__device__ __forceinline__ float bf2f(bf16 v) { return __uint_as_float((unsigned)v << 16); }
__device__ __forceinline__ float wave_sum(float v) {
  v += xor_lane<1>(v); v += xor_lane<2>(v); v += xor_lane<4>(v); v += xor_lane<8>(v); v += xor_lane<16>(v); v += xor_lane<32>(v);
  return v;
}
__device__ __forceinline__ float log_sigmoid(float x) { return fminf(x, 0.f) - log1pf(expf(-fabsf(x))); }

__device__ __forceinline__ void tr_item(const float* W, int ldw, int srccol0, int nvalid, bf16* WT, int K, int dstrow0, int k0, LAS float* scr, int lane) {
  const int n_ = lane & 31;
#pragma unroll 8
  for (int i = 0; i < 32; ++i) { const int kk = 2 * i + (lane >> 5); scr[kk * 33 + n_] = (n_ < nvalid) ? W[(size_t)(k0 + kk) * ldw + srccol0 + n_] : 0.f; }
  LDS_WAIT(); asm volatile("" ::: "memory");
  const int c = lane & 7;
#pragma unroll
  for (int j = 0; j < 4; ++j) { const int n = (lane >> 3) + 8 * j; const LAS float* s = scr + (8 * c) * 33 + n;
    v4u o; o.x = pk2(s[0 * 33], s[1 * 33]); o.y = pk2(s[2 * 33], s[3 * 33]); o.z = pk2(s[4 * 33], s[5 * 33]); o.w = pk2(s[6 * 33], s[7 * 33]);
    *(GAS v4u*)(WT + (size_t)(dstrow0 + n) * K + k0 + 8 * c) = o; }
  LDS_WAIT(); asm volatile("" ::: "memory");
}
__device__ __forceinline__ void win_src(int n0, int& sc, int& nv) {
  const int pn = n0 >> 8, p = n0 & 255, lc = 64 * ((p >> 5) & 3) + 32 * (p >> 7);
  nv = 32; sc = 0;
  if (pn < 3) sc = OFF_PB + pn * 256 + lc;
  else if (pn < 6) sc = OFF_PC + (pn - 3) * 256 + lc;
  else if (pn == 6) sc = OFF_PDQ + lc;
  else if (pn == 7) sc = OFF_PDKV + lc;
  else if (pn == 8) { sc = OFF_CQ + lc; if (lc >= 192) { nv = 0; sc = 0; } }
  else { if (lc < 128) sc = OFF_CKV + lc; else if (lc < 160) sc = OFF_KR + lc - 128; else if (lc < 192) { sc = OFF_FG; nv = 4; } else { sc = 0; nv = 0; } }
}
__device__ __forceinline__ void prep_rows(const float* X, const bf16* y0, const bf16* y1, float* xout, bf16* XN, const float* g1, int gw, int NGW, int lane) {
  for (int m = gw; m < T; m += NGW) {
    const GAS f32x4* xr = (const GAS f32x4*)(X + (size_t)m * D) + lane;
    f32x4 v[4]; float ss = 0.f;
#pragma unroll
    for (int j = 0; j < 4; ++j) {
      v[j] = xr[64 * j];
      if (y0) {
        const unsigned long long a = *((const GAS unsigned long long*)(y0 + (size_t)m * D) + lane + 64 * j), b = *((const GAS unsigned long long*)(y1 + (size_t)m * D) + lane + 64 * j);
        v[j].x += __uint_as_float((unsigned)a << 16) + __uint_as_float((unsigned)b << 16);
        v[j].y += __uint_as_float((unsigned)a & 0xffff0000u) + __uint_as_float((unsigned)b & 0xffff0000u);
        v[j].z += __uint_as_float((unsigned)(a >> 32) << 16) + __uint_as_float((unsigned)(b >> 32) << 16);
        v[j].w += __uint_as_float((unsigned)(a >> 32) & 0xffff0000u) + __uint_as_float((unsigned)(b >> 32) & 0xffff0000u);
      }
      ss += (v[j].x * v[j].x + v[j].y * v[j].y) + (v[j].z * v[j].z + v[j].w * v[j].w);
    }
    if (xout) {
#pragma unroll
      for (int j = 0; j < 4; ++j) ((GAS f32x4*)(xout + (size_t)m * D) + lane)[64 * j] = v[j];
    }
    if (XN) {
      const float rstd = rsqrtf(wave_sum(ss) * (1.f / D) + EPS);
      GAS unsigned long long* o8 = (GAS unsigned long long*)(XN + (size_t)m * D) + lane;
#pragma unroll
      for (int j = 0; j < 4; ++j) { const f32x4 g = *((const GAS f32x4*)g1 + lane + 64 * j);
        o8[64 * j] = (unsigned long long)pk2(v[j].x * rstd * g.x, v[j].y * rstd * g.y) | ((unsigned long long)pk2(v[j].z * rstd * g.z, v[j].w * rstd * g.w) << 32); }
    }
  }
}

struct EpiInProj {
  static constexpr bool PERM = true, AFTER_DRAIN = false;
  bf16* qkv; bf16* R8; bf16* R9; float* LF; const float* gq; const float* gk; const float* bfox;
  __device__ __forceinline__ void operator()(const pg8::f32x4 (&acc)[2][2][4][2], const pg8::Unit& u, int wr, int wc, int fr, int fq) const {
    const int pn = u.pn;
    bf16* dst; int pitch = 256, cb = 64 * wc; const float* g = nullptr; float sc = 1.f;
    if (pn < 6) { dst = qkv + (size_t)(IQB + pn) * QKV_STRIDE; const int r3 = pn % 3, mx = 1 + pn / 3; if (r3 == 0) { g = gq + mx * 64; sc = C2; } else if (r3 == 1) g = gk + mx * 64; }
    else if (pn == 6) { dst = qkv + (size_t)IQD * QKV_STRIDE; g = gq + 3 * 64; sc = C2; }
    else if (pn == 7) { pitch = 128; if (wc < 2) { dst = qkv + 10 * QKV_STRIDE; g = gk + 3 * 64; } else { dst = qkv + 10 * QKV_STRIDE + (size_t)T * 128; cb = 64 * (wc - 2); } }
    else if (pn == 8) dst = R8; else dst = R9;
    const int rowb = u.pm * 256 + wr * 64 + fr;
    if (g) {
      pg8::f32x4 gv[2][2];
#pragma unroll
      for (int bj = 0; bj < 2; ++bj)
#pragma unroll
        for (int n = 0; n < 2; ++n) gv[bj][n] = *(const pg8::f32x4*)(g + 32 * bj + 8 * fq + 4 * n) * sc;
#pragma unroll
      for (int ai = 0; ai < 2; ++ai)
#pragma unroll
        for (int m = 0; m < 4; ++m) {
          float ss = 0.f;
#pragma unroll
          for (int bj = 0; bj < 2; ++bj)
#pragma unroll
            for (int n = 0; n < 2; ++n) { const pg8::f32x4 x = acc[ai][bj][m][n]; ss += (x[0] * x[0] + x[1] * x[1]) + (x[2] * x[2] + x[3] * x[3]); }
          ss += xor_lane<16>(ss); ss += xor_lane<32>(ss);
          const float rstd = rsqrtf(ss * (1.f / 64.f) + EPS);
          bf16* rp = dst + (size_t)(rowb + ai * 128 + m * 16) * pitch + cb + 8 * fq;
#pragma unroll
          for (int bj = 0; bj < 2; ++bj) { const pg8::f32x4 v0 = acc[ai][bj][m][0] * gv[bj][0] * rstd, v1 = acc[ai][bj][m][1] * gv[bj][1] * rstd;
            pg8::u32x4 w; w.x = pg8::cvt_pk_bf16(v0[0], v0[1]); w.y = pg8::cvt_pk_bf16(v0[2], v0[3]); w.z = pg8::cvt_pk_bf16(v1[0], v1[1]); w.w = pg8::cvt_pk_bf16(v1[2], v1[3]);
            *(pg8::u32x4*)(rp + 32 * bj) = w; }
        }
    } else {
#pragma unroll
      for (int ai = 0; ai < 2; ++ai)
#pragma unroll
        for (int m = 0; m < 4; ++m) {
          bf16* rp = dst + (size_t)(rowb + ai * 128 + m * 16) * pitch + cb + 8 * fq;
#pragma unroll
          for (int bj = 0; bj < 2; ++bj) { const pg8::f32x4 v0 = acc[ai][bj][m][0], v1 = acc[ai][bj][m][1];
            pg8::u32x4 w; w.x = pg8::cvt_pk_bf16(v0[0], v0[1]); w.y = pg8::cvt_pk_bf16(v0[2], v0[3]); w.z = pg8::cvt_pk_bf16(v1[0], v1[1]); w.w = pg8::cvt_pk_bf16(v1[2], v1[3]);
            *(pg8::u32x4*)(rp + 32 * bj) = w; }
        }
      if (pn == 9 && wc == 2 && fq == 0) {
        const pg8::f32x4 bb = *(const pg8::f32x4*)bfox;
#pragma unroll
        for (int ai = 0; ai < 2; ++ai)
#pragma unroll
          for (int m = 0; m < 4; ++m) { const pg8::f32x4 v = acc[ai][1][m][0] + bb; pg8::f32x4 o;
            o[0] = log_sigmoid(v[0]); o[1] = log_sigmoid(v[1]); o[2] = log_sigmoid(v[2]); o[3] = log_sigmoid(v[3]);
            *(pg8::f32x4*)(LF + (size_t)(rowb + ai * 128 + m * 16) * 4) = o; }
      }
    }
  }
};

struct EpiResF32 {
  static constexpr bool PERM = false, AFTER_DRAIN = false;
  const float* R; float* C;
  __device__ __forceinline__ void operator()(const pg8::f32x4 (&acc)[2][2][4][2], const pg8::Unit& u, int wr, int wc, int fr, int fq) const {
    const int row0 = u.pm * 256 + wr * 64 + fr, col0 = u.pn * 256 + wc * 32 + 4 * fq;
#pragma unroll
    for (int ai = 0; ai < 2; ++ai)
#pragma unroll
      for (int m = 0; m < 4; ++m) { const size_t off = (size_t)(row0 + ai * 128 + m * 16) * D + col0;
#pragma unroll
        for (int bj = 0; bj < 2; ++bj)
#pragma unroll
          for (int n = 0; n < 2; ++n) { const size_t o = off + bj * 128 + n * 16; *(pg8::f32x4*)(C + o) = *(const pg8::f32x4*)(R + o) + acc[ai][bj][m][n]; } }
  }
};

__device__ __forceinline__ void n_post(LAS unsigned char* lds, const bf16* R8, const bf16* R9, const float* gcq, const float* gckv, const float* wuq, const float* wukv,
                                       const float* gq0, const float* gk0, bf16* QA, bf16* KA, bf16* VA) {
  LAS float* cqn = (LAS float*)lds; LAS float* ckvn = cqn + 192; LAS float* kva = ckvn + 128; LAS float* tmp = kva + 384; LAS float* red = tmp + 256; LAS float* krs = red + 8;
  const int tid = opq_tid(), lane = tid & 63, w = tid >> 6;
  for (int t = blockIdx.x; t < T; t += gridDim.x) {
    const int pos = t % S;
    const float vq = (tid < 192) ? bf2f(R8[(size_t)t * 256 + tid]) : 0.f;
    const float vk = (tid < 128) ? bf2f(R9[(size_t)t * 256 + tid]) : 0.f;
    const float sq = wave_sum(vq * vq), sk = wave_sum(vk * vk);
    if (lane == 0 && w < 4) { red[w] = sq; red[4 + w] = sk; }
    if (tid < 32) krs[tid] = bf2f(R9[(size_t)t * 256 + 128 + tid]);
    __syncthreads();
    const float rq = rsqrtf((red[0] + red[1] + red[2] + red[3]) * (1.f / 192.f) + EPS);
    const float rk = rsqrtf((red[4] + red[5] + red[6] + red[7]) * (1.f / 128.f) + EPS);
    if (tid < 192) cqn[tid] = vq * rq * gcq[tid];
    if (tid < 128) ckvn[tid] = vk * rk * gckv[tid];
    __syncthreads();
    float qa = 0.f, ka = 0.f;
    if (tid < 256) {
      float k0 = 0.f, k1 = 0.f;
      for (int i = 0; i < 192; ++i) qa += cqn[i] * wuq[i * 256 + tid];
      for (int i = 0; i < 128; ++i) { k0 += ckvn[i] * wukv[i * 384 + tid]; if (tid < 128) k1 += ckvn[i] * wukv[i * 384 + 256 + tid]; }
      kva[tid] = k0; if (tid < 128) kva[256 + tid] = k1;
      const float ss = wave_sum(qa * qa);
      qa = qa * rsqrtf(ss * (1.f / 64.f) + EPS) * gq0[lane];
      tmp[tid] = qa;
    }
    __syncthreads();
    float cs = 1.f, sn = 0.f;
    if (tid < 256 && lane >= 32) { const int j = (lane - 32) & 15; const float inv = powf(10000.f, -(float)(2 * j) / 32.f); const float ang = (float)pos * inv; cs = cosf(ang); sn = sinf(ang); }
    if (tid < 256) {
      float o = qa;
      if (lane >= 32) { if (lane < 48) o = qa * cs - tmp[tid + 16] * sn; else o = qa * cs + tmp[tid - 16] * sn; }
      QA[(size_t)t * 256 + tid] = (bf16)f2bf(o * C2);
      ka = (lane < 32) ? kva[w * 96 + lane] : krs[lane - 32];
      const float ss = wave_sum(ka * ka);
      ka = ka * rsqrtf(ss * (1.f / 64.f) + EPS) * gk0[lane];
    }
    __syncthreads();
    if (tid < 256) tmp[tid] = ka;
    __syncthreads();
    if (tid < 256) {
      float o = ka;
      if (lane >= 32) { if (lane < 48) o = ka * cs - tmp[tid + 16] * sn; else o = ka * cs + tmp[tid - 16] * sn; }
      KA[(size_t)t * 256 + tid] = (bf16)f2bf(o);
      VA[(size_t)t * 256 + tid] = (bf16)f2bf(kva[w * 96 + 32 + lane]);
    }
    __syncthreads();
  }
}
__device__ __forceinline__ void n_cumsum(LAS unsigned char* lds, const float* LF, float* CUM) {
  LAS float* part = (LAS float*)lds + 2048;
  const int tid = opq_tid(); constexpr int per = S / NTHR;
  for (int item = blockIdx.x; item < NB * 4; item += gridDim.x) {
    const int b = item >> 2, h = item & 3;
    float s = 0.f;
    for (int i = 0; i < per; ++i) s += LF[((size_t)b * S + tid * per + i) * 4 + h];
    part[tid] = s;
    __syncthreads();
    if (tid == 0) { float a = 0.f; for (int i = 0; i < NTHR; ++i) { const float v = part[i]; part[i] = a; a += v; } }
    __syncthreads();
    float a = part[tid];
    for (int i = 0; i < per; ++i) { a += LF[((size_t)b * S + tid * per + i) * 4 + h]; CUM[((size_t)b * S + tid * per + i) * 4 + h] = a; }
    __syncthreads();
  }
}
struct Soft { float m, l, o; };
__device__ __forceinline__ void soft_add(Soft& st, float logit2, float v) {
  const float mn = fmaxf(st.m, logit2);
  const float a = exp2f(st.m - mn), pp = exp2f(logit2 - mn);
  st.l = st.l * a + pp; st.o = st.o * a + pp * v; st.m = mn;
}
__device__ __forceinline__ void n_attn(const bf16* qkv, const float* CUM, const float* sink, bf16* MIX, int mask) {
  const int tid_ = opq_tid(), lane = tid_ & 63, wpb = NTHR >> 6;
  const long nitems = (long)T * 16;
  for (long it = (long)blockIdx.x * wpb + (tid_ >> 6); it < nitems; it += (long)gridDim.x * wpb) {
    const int t = T - 1 - (int)(it >> 4), mh = (int)(it & 15), mixer = mh >> 2, h = mh & 3;
    if (!((mask >> mixer) & 1)) continue;
    const int b = t / S, pos = t % S; const long base = (long)b * S;
    Soft st; st.m = -INFINITY; st.l = 0.f; st.o = 0.f;
    if (mixer == 0 || mixer == 2) {
      const bf16* Q = qkv + (size_t)(mixer == 0 ? IQA : IQC) * QKV_STRIDE; const bf16* K = Q + QKV_STRIDE; const bf16* V = K + QKV_STRIDE;
      const float q = bf2f(Q[(size_t)t * 256 + h * 64 + lane]);
      const float ct = (mixer == 2) ? CUM[(size_t)t * 4 + h] : 0.f;
      for (int s = 0; s <= pos; ++s) {
        float d = wave_sum(q * bf2f(K[(size_t)(base + s) * 256 + h * 64 + lane]));
        if (mixer == 2) d += (ct - CUM[(size_t)(base + s) * 4 + h]) * LOG2E;
        soft_add(st, d, bf2f(V[(size_t)(base + s) * 256 + h * 64 + lane]));
      }
    } else if (mixer == 3) {
      const bf16* Q = qkv + (size_t)IQD * QKV_STRIDE; const bf16* K = qkv + 10 * QKV_STRIDE; const bf16* V = K + (size_t)T * 128;
      const int hk = h >> 1;
      const float q = bf2f(Q[(size_t)t * 256 + h * 64 + lane]);
      const float slope = exp2f(-(float)(h + 1)) * LOG2E;
      const int s0 = pos - 127 < 0 ? 0 : pos - 127;
      for (int s = s0; s <= pos; ++s) {
        const float d = wave_sum(q * bf2f(K[(size_t)(base + s) * 128 + hk * 64 + lane])) - slope * (float)(pos - s);
        soft_add(st, d, bf2f(V[(size_t)(base + s) * 128 + hk * 64 + lane]));
      }
      const float sk = sink[h] * LOG2E;
      const float mn = fmaxf(st.m, sk), a = exp2f(st.m - mn);
      st.l = st.l * a + exp2f(sk - mn); st.o *= a; st.m = mn;
    } else {
      const bf16* Q = qkv + (size_t)IQB * QKV_STRIDE; const bf16* K = Q + QKV_STRIDE; const bf16* V = K + QKV_STRIDE;
      const float q = bf2f(Q[(size_t)t * 256 + h * 64 + lane]);
      const float slope = exp2f(-(float)(h + 5)) * LOG2E;
      for (int br = 0; br < 3; ++br) {
        const int dil = br == 0 ? 1 : (br == 1 ? 4 : 16);
        for (int j = 0; j <= 128; ++j) {
          const int s = pos - dil * j;
          if (s < 0) break;
          const float d = wave_sum(q * bf2f(K[(size_t)(base + s) * 256 + h * 64 + lane])) - slope * (float)(dil * j);
          soft_add(st, d, bf2f(V[(size_t)(base + s) * 256 + h * 64 + lane]));
        }
      }
    }
    MIX[(size_t)t * D + mixer * 256 + h * 64 + lane] = (bf16)f2bf(st.o / st.l);
  }
}
__device__ __forceinline__ void n_wo(LAS unsigned char* lds, const bf16* A, const float* Bm, const float* R, float* C) {
  LAS float* As = (LAS float*)lds;
  LAS float* Bs = As + 16 * 129;
  const int tid = opq_tid(), tx = tid & 15, ty = tid >> 4;
  for (int tile = blockIdx.x; tile < (T / 128) * (D / 64); tile += gridDim.x) {
    const int m0 = (tile / (D / 64)) * 128, n0 = (tile % (D / 64)) * 64;
    float acc[4][4];
#pragma unroll
    for (int i = 0; i < 4; ++i)
#pragma unroll
      for (int j = 0; j < 4; ++j) acc[i][j] = 0.f;
    for (int k0 = 0; k0 < D; k0 += 16) {
#pragma unroll
      for (int r = 0; r < 4; ++r) { const int i = tid + NTHR * r, m = i >> 4, k = i & 15; As[k * 129 + m] = bf2f(A[(size_t)(m0 + m) * D + k0 + k]); }
#pragma unroll
      for (int r = 0; r < 2; ++r) { const int i = tid + NTHR * r, k = i >> 6, n = i & 63; Bs[k * 64 + n] = Bm[(size_t)(k0 + k) * D + n0 + n]; }
      __syncthreads();
#pragma unroll
      for (int k = 0; k < 16; ++k) {
        float a[4], b[4];
#pragma unroll
        for (int i = 0; i < 4; ++i) { a[i] = As[k * 129 + ty * 4 + i]; b[i] = Bs[k * 64 + tx * 4 + i]; }
#pragma unroll
        for (int i = 0; i < 4; ++i)
#pragma unroll
          for (int j = 0; j < 4; ++j) acc[i][j] += a[i] * b[j];
      }
      __syncthreads();
    }
#pragma unroll
    for (int i = 0; i < 4; ++i)
#pragma unroll
      for (int j = 0; j < 4; ++j) { const size_t o = (size_t)(m0 + ty * 4 + i) * D + n0 + tx * 4 + j; C[o] = R[o] + acc[i][j]; }
  }
}
__device__ __forceinline__ void n_route(const float* H, const float* g2, const float* wrg, const float* brg, const float* wre, const float* bre, bf16* HN, int* EXPI, float* GATE, unsigned* cnt, int* LIST) {
  const int tid_ = opq_tid(), lane = tid_ & 63, wpb = NTHR >> 6;
  for (int t = blockIdx.x * wpb + (tid_ >> 6); t < T; t += gridDim.x * wpb) {
    const float* hr = H + (size_t)t * D;
    float v[16], ss = 0.f;
#pragma unroll
    for (int j = 0; j < 16; ++j) { v[j] = hr[lane + 64 * j]; ss += v[j] * v[j]; }
    ss = wave_sum(ss);
    const float rstd = rsqrtf(ss * (1.f / D) + EPS);
#pragma unroll
    for (int j = 0; j < 16; ++j) { v[j] = v[j] * rstd * g2[lane + 64 * j]; HN[(size_t)t * D + lane + 64 * j] = (bf16)f2bf(v[j]); }
    float gl[4];
#pragma unroll
    for (int g = 0; g < 4; ++g) {
      float a = 0.f;
#pragma unroll
      for (int j = 0; j < 16; ++j) a += v[j] * wrg[(size_t)(lane + 64 * j) * 4 + g];
      gl[g] = wave_sum(a) + brg[g];
    }
    int gs = 0; float gm = gl[0];
#pragma unroll
    for (int g = 1; g < 4; ++g) if (gl[g] > gm) { gm = gl[g]; gs = g; }
    float den = 0.f;
#pragma unroll
    for (int g = 0; g < 4; ++g) den += expf(gl[g] - gm);
    const float pg = 1.f / den;
    float el[8];
#pragma unroll
    for (int e = 0; e < 8; ++e) {
      float a = 0.f;
#pragma unroll
      for (int j = 0; j < 16; ++j) a += v[j] * wre[(size_t)(lane + 64 * j) * 32 + gs * 8 + e];
      el[e] = wave_sum(a) + bre[gs * 8 + e];
    }
    int i1 = 0; float m1 = el[0];
#pragma unroll
    for (int e = 1; e < 8; ++e) if (el[e] > m1) { m1 = el[e]; i1 = e; }
    int i2 = 0; float m2 = -INFINITY;
#pragma unroll
    for (int e = 0; e < 8; ++e) if (e != i1 && el[e] > m2) { m2 = el[e]; i2 = e; }
    const float e2 = expf(m2 - m1);
    if (lane == 0) {
      EXPI[t * 2] = gs * 8 + i1; EXPI[t * 2 + 1] = gs * 8 + i2;
      GATE[t * 2] = pg / (1.f + e2); GATE[t * 2 + 1] = pg * e2 / (1.f + e2);
      const int ea = gs * 8 + i1, eb = gs * 8 + i2;
      const unsigned sa = atomicAdd(cnt + ea, 1u), sb = atomicAdd(cnt + eb, 1u);
      LIST[(size_t)ea * T + sa] = t * 2; LIST[(size_t)eb * T + sb] = t * 2 + 1;
    }
  }
}
__device__ __forceinline__ void n_moe(LAS unsigned char* lds, const bf16* HN, const int* EXPI, const float* GATE, const float* w1, const float* w3, const float* w2, float* hio, bf16* ybf) {
  LAS float* xs = (LAS float*)lds; LAS float* sa = xs + D; LAS float* hid = sa + 512;
  const int tid = opq_tid(), j = tid & 255, half = tid >> 8;
  for (int t = blockIdx.x; t < T; t += gridDim.x) {
    for (int i = tid; i < D; i += NTHR) xs[i] = bf2f(HN[(size_t)t * D + i]);
    __syncthreads();
    float y0 = 0.f, y1 = 0.f;
    for (int k = 0; k < 2; ++k) {
      const int e = EXPI[t * 2 + k]; const float gt = GATE[t * 2 + k];
      const float* W13 = (half ? w3 : w1) + (size_t)e * D * 256; const float* W2 = w2 + (size_t)e * 256 * D;
      float a = 0.f;
      for (int i = 0; i < D; ++i) a += xs[i] * W13[(size_t)i * 256 + j];
      sa[tid] = a;
      __syncthreads();
      if (tid < 256) { const float av = sa[tid], cv = sa[256 + tid]; hid[tid] = av / (1.f + expf(-av)) * cv * gt; }
      __syncthreads();
      for (int jj = 0; jj < 256; ++jj) { const float hv = hid[jj]; y0 += hv * W2[(size_t)jj * D + tid]; y1 += hv * W2[(size_t)jj * D + tid + 512]; }
      __syncthreads();
    }
    if (ybf) { ybf[(size_t)t * D + tid] = (bf16)f2bf(y0); ybf[(size_t)t * D + tid + 512] = (bf16)f2bf(y1); } else { hio[(size_t)t * D + tid] += y0; hio[(size_t)t * D + tid + 512] += y1; }
  }
}

#ifndef FASTMASK
#define FASTMASK 1
#endif
#ifndef CHK_GAIN
#define CHK_GAIN 10.f
#endif
typedef attn_body::bf16 abf;
template <int MODE> __device__ __forceinline__ void run_unit(const attn_body::AU& u, unsigned char* lds_raw) { attn_body::attn_unit<8, MODE>(u, (char*)lds_raw); }
__device__ __forceinline__ void f_attn(unsigned char* lds_raw, LAS unsigned char* lds, bf16* QKV, const float* CUM, const float* sink, bf16* MIX, bf16* PART, float* LSEP, int mask) {
  const int tid = opq_tid();
  LAS float* bt = (LAS float*)(lds + attn_body::LDS_BIAS);
  const int G = gridDim.x, c = blockIdx.x;
  if (mask & 1) {
    for (int idx = c; idx < 256; idx += G) {
      const int bh = idx & 7, qb = 31 - (idx >> 3), b = bh >> 2, h = bh & 3; const size_t r0 = (size_t)b * S;
      attn_body::AU u{}; u.Q = (const abf*)(QKV + (size_t)IQA * QKV_STRIDE + (r0 + 256 * qb) * 256 + h * 64); u.K = (const abf*)(QKV + (size_t)IKA * QKV_STRIDE + r0 * 256 + h * 64);
      u.V = (const abf*)(QKV + (size_t)IVA * QKV_STRIDE + r0 * 256 + h * 64); u.O = (abf*)(MIX + (r0 + 256 * qb) * D + h * 64); u.qs = 256; u.ks = 256; u.os = D; u.NT = 4 * qb + 4;
      run_unit<0>(u, lds_raw);
    }
  }
  if (mask & 4) {
    for (int idx = c; idx < 256; idx += G) {
      const int bh = idx & 7, qb = 31 - (idx >> 3), b = bh >> 2, h = bh & 3; const size_t r0 = (size_t)b * S;
      attn_body::AU u{}; u.Q = (const abf*)(QKV + (size_t)IQC * QKV_STRIDE + (r0 + 256 * qb) * 256 + h * 64); u.K = (const abf*)(QKV + (size_t)IKC * QKV_STRIDE + r0 * 256 + h * 64);
      u.V = (const abf*)(QKV + (size_t)IVC * QKV_STRIDE + r0 * 256 + h * 64); u.O = (abf*)(MIX + (r0 + 256 * qb) * D + 512 + h * 64); u.qs = 256; u.ks = 256; u.os = D; u.NT = 4 * qb + 4;
      const float cref = CUM[(r0 + 256 * qb) * 4 + h];
      for (int i = tid; i < u.NT * 64; i += NTHR) bt[i] = (cref - CUM[(r0 + i) * 4 + h]) * LOG2E;
      run_unit<1>(u, lds_raw);
    }
  }
  if (mask & 8) {
    for (int idx = c; idx < 256; idx += G) {
      const int bh = idx & 7, qb = idx >> 3, b = bh >> 2, h = bh & 3; const size_t r0 = (size_t)b * S; const int k0 = qb ? 256 * qb - 128 : 0;
      attn_body::AU u{}; u.Q = (const abf*)(QKV + (size_t)IQD * QKV_STRIDE + (r0 + 256 * qb) * 256 + h * 64); u.K = (const abf*)(QKV + 10 * QKV_STRIDE + (r0 + k0) * 128 + (h >> 1) * 64);
      u.V = (const abf*)(QKV + 10 * QKV_STRIDE + (size_t)T * 128 + (r0 + k0) * 128 + (h >> 1) * 64); u.O = (abf*)(MIX + (r0 + 256 * qb) * D + 768 + h * 64); u.qs = 256; u.ks = 128; u.os = D;
      u.NT = qb ? 6 : 4; u.win = 127; u.slope2 = exp2f(-(float)(h + 1)) * LOG2E; u.sink2 = sink[h] * LOG2E;
      const int kq0 = (u.NT - 4) * 64;
      for (int i = tid; i < u.NT * 64; i += NTHR) bt[i] = u.slope2 * (float)(i - kq0);
      run_unit<1 | 2 | 8>(u, lds_raw);
    }
  }
  if (mask & 2) {
    for (int idx = c; idx < 768; idx += G) {
      const int br = idx >> 8, j = idx & 255, dil = br == 0 ? 1 : (br == 1 ? 4 : 16);
      const int bh = j & 7, b = bh >> 2, h = bh & 3; const int rest = j >> 3;
      const int nfb = 32 / dil, cls = rest / nfb, fb = rest % nfb;
      const size_t r0 = (size_t)b * S; const int kf0 = fb ? 256 * fb - 128 : 0;
      const size_t qtok = r0 + cls + (size_t)dil * 256 * fb, ktok = r0 + cls + (size_t)dil * kf0;
      attn_body::AU u{}; u.Q = (const abf*)(QKV + (size_t)IQB * QKV_STRIDE + qtok * 256 + h * 64); u.K = (const abf*)(QKV + (size_t)IKB * QKV_STRIDE + ktok * 256 + h * 64);
      u.V = (const abf*)(QKV + (size_t)IVB * QKV_STRIDE + ktok * 256 + h * 64); u.O = (abf*)(PART + (size_t)br * QKV_STRIDE + qtok * 256 + h * 64); u.LSE = LSEP + (size_t)br * T * 4 + qtok * 4 + h;
      u.qs = 256 * dil; u.ks = 256 * dil; u.os = 256 * dil; u.lses = 4 * dil; u.NT = fb ? 6 : 4; u.win = 128; u.slope2 = exp2f(-(float)(h + 5)) * LOG2E * (float)dil;
      const int kq0 = (u.NT - 4) * 64;
      for (int i = tid; i < u.NT * 64; i += NTHR) bt[i] = u.slope2 * (float)(i - kq0);
      run_unit<1 | 2 | 4>(u, lds_raw);
    }
  }
}
__device__ __forceinline__ void f_bmerge(const bf16* PART, const float* LSEP, bf16* MIX) {
  const int tid = opq_tid();
  for (long i = (long)blockIdx.x * NTHR + tid; i < (long)T * 32; i += (long)gridDim.x * NTHR) {
    const long t = i >> 5; const int ch = (int)(i & 31), h = ch >> 3;
    float l0 = LSEP[t * 4 + h], l1 = LSEP[(size_t)T * 4 + t * 4 + h], l2 = LSEP[(size_t)2 * T * 4 + t * 4 + h];
    const float m = fmaxf(l0, fmaxf(l1, l2)); l0 = exp2f(l0 - m); l1 = exp2f(l1 - m); l2 = exp2f(l2 - m);
    const float inv = 1.f / (l0 + l1 + l2); l0 *= inv; l1 *= inv; l2 *= inv;
    const v4u a = *(const GAS v4u*)(PART + t * 256 + ch * 8), b = *(const GAS v4u*)(PART + QKV_STRIDE + t * 256 + ch * 8), c = *(const GAS v4u*)(PART + 2 * QKV_STRIDE + t * 256 + ch * 8);
    v4u o;
#define MRG(f) { const float lo = l0 * __uint_as_float(a.f << 16) + l1 * __uint_as_float(b.f << 16) + l2 * __uint_as_float(c.f << 16); \
                 const float hi_ = l0 * __uint_as_float(a.f & 0xffff0000u) + l1 * __uint_as_float(b.f & 0xffff0000u) + l2 * __uint_as_float(c.f & 0xffff0000u); o.f = pk2(lo, hi_); }
    MRG(x) MRG(y) MRG(z) MRG(w)
#undef MRG
    *(GAS v4u*)(MIX + t * D + 256 + ch * 8) = o;
  }
}

__device__ __forceinline__ void moe_tiles(LAS unsigned char* lds, const unsigned* cnt) {
  LAS int* tiles = (LAS int*)(lds + LDS_TILES); LAS int* nti = (LAS int*)(lds + LDS_NTI);
  if (opq_tid() == 0) { int n = 0; for (int e = 0; e < 32; ++e) { const int c = (int)__hip_atomic_load(cnt + e, __ATOMIC_RELAXED, __HIP_MEMORY_SCOPE_AGENT), nt = (c + 255) >> 8; for (int r = 0; r < nt; ++r) tiles[n++] = (e << 16) | r; } nti[0] = n; }
  __syncthreads();
}
struct MoeOrder {
  const LAS int* tiles; int nu, ncol, G, c;
  __device__ __forceinline__ bool next(int i, pg8::Unit& u) const { const int idx = i * G + c; if (idx >= nu) return false; const int ti = idx / ncol; u.pm = ti; u.pn = (tiles[ti] >> 16) * ncol + idx % ncol; return true; }
  __device__ __forceinline__ void a_ready(const pg8::Unit&) const {}
  __device__ __forceinline__ void done(const pg8::Unit&) const {}
};
__device__ __forceinline__ float silu_f(float a) { return a * __builtin_amdgcn_rcpf(1.f + __builtin_amdgcn_exp2f(-a * LOG2E)); }
struct EpiSwiGLU {
  static constexpr bool PERM = true, AFTER_DRAIN = false;
  bf16* HID;
  __device__ __forceinline__ void operator()(const pg8::f32x4 (&acc)[2][2][4][2], const pg8::Unit& u, int wr, int wc, int fr, int fq) const {
    { const int t_ = opq_tid(); fr = t_ & 15; fq = (t_ >> 4) & 3; }
    const int rowb = u.pm * 256 + wr * 64 + fr, col = 128 * (u.pn & 1) + 32 * wc + 8 * fq;
#pragma unroll
    for (int ai = 0; ai < 2; ++ai)
#pragma unroll
      for (int m = 0; m < 4; ++m) { const pg8::f32x4 a0 = acc[ai][0][m][0], a1 = acc[ai][0][m][1], b0 = acc[ai][1][m][0], b1 = acc[ai][1][m][1]; pg8::u32x4 w;
        w.x = pg8::cvt_pk_bf16(silu_f(a0[0]) * b0[0], silu_f(a0[1]) * b0[1]); w.y = pg8::cvt_pk_bf16(silu_f(a0[2]) * b0[2], silu_f(a0[3]) * b0[3]);
        w.z = pg8::cvt_pk_bf16(silu_f(a1[0]) * b1[0], silu_f(a1[1]) * b1[1]); w.w = pg8::cvt_pk_bf16(silu_f(a1[2]) * b1[2], silu_f(a1[3]) * b1[3]);
        *(pg8::u32x4*)(HID + (size_t)(rowb + ai * 128 + m * 16) * 256 + col) = w; }
  }
};
struct EpiMoeDown {
  static constexpr bool PERM = true, AFTER_DRAIN = false;
  const int* LIST; const float* GATE; const unsigned* cnt; const LAS int* tiles; bf16* Y0; bf16* Y1;
  __device__ __forceinline__ void operator()(const pg8::f32x4 (&acc)[2][2][4][2], const pg8::Unit& u, int wr, int wc, int fr, int fq) const {
    { const int t_ = opq_tid(); fr = t_ & 15; fq = (t_ >> 4) & 3; }
    const int er = tiles[u.pm], e = er >> 16, r = er & 0xffff, ne = (int)cnt[e], col = 256 * (u.pn & 3) + 32 * wc + 8 * fq;
#pragma unroll
    for (int ai = 0; ai < 2; ++ai)
#pragma unroll
      for (int m = 0; m < 4; ++m) { const int a = r * 256 + ai * 128 + wr * 64 + m * 16 + fr;
        if (a < ne) { const int tk = LIST[(size_t)e * T + a]; const float gt = GATE[tk]; bf16* dst = ((tk & 1) ? Y1 : Y0) + (size_t)(tk >> 1) * D + col;
#pragma unroll
          for (int bj = 0; bj < 2; ++bj) { const pg8::f32x4 v0 = acc[ai][bj][m][0] * gt, v1 = acc[ai][bj][m][1] * gt; pg8::u32x4 w;
            w.x = pg8::cvt_pk_bf16(v0[0], v0[1]); w.y = pg8::cvt_pk_bf16(v0[2], v0[3]); w.z = pg8::cvt_pk_bf16(v1[0], v1[1]); w.w = pg8::cvt_pk_bf16(v1[2], v1[3]);
            *(pg8::u32x4*)(dst + 128 * bj) = w; } } }
  }
};

constexpr int CW_CHK = 1024;
__device__ __forceinline__ void chk_bf16(LAS unsigned char* lds, const bf16* a, const bf16* ref, int pitch, int c0, int nc, float* sums) {
  const int tid = opq_tid(); float d2 = 0.f, r2 = 0.f;
  for (long i = (long)blockIdx.x * NTHR + tid; i < (long)T * nc; i += (long)gridDim.x * NTHR) {
    const long t = i / nc; const int c = c0 + (int)(i % nc);
    const float x = bf2f(a[t * pitch + c]), y = bf2f(ref[t * pitch + c]); const float d = x - y;
    d2 += (d == d) ? d * d : 1e6f; r2 += y * y;
  }
  d2 = wave_sum(d2); r2 = wave_sum(r2);
  if ((tid & 63) == 0) { atomicAdd(sums, d2); atomicAdd(sums + 1, r2); }
}
__device__ __forceinline__ void chk_f32(const float* a, const float* ref, long n, float* sums) {
  const int tid = opq_tid(); float d2 = 0.f, r2 = 0.f;
  for (long i = (long)blockIdx.x * NTHR + tid; i < n; i += (long)gridDim.x * NTHR) { const float d = a[i] - ref[i]; d2 += (d == d) ? d * d : 1e6f; r2 += ref[i] * ref[i]; }
  d2 = wave_sum(d2); r2 = wave_sum(r2);
  if ((tid & 63) == 0) { atomicAdd(sums, d2); atomicAdd(sums + 1, r2); }
}
__device__ __forceinline__ void chk_ysum(const bf16* y0, const bf16* y1, const bf16* ref, float* sums) {
  const int tid = opq_tid(); float d2 = 0.f, r2 = 0.f;
  for (long i = (long)blockIdx.x * NTHR + tid; i < (long)T * D; i += (long)gridDim.x * NTHR) { const float y = bf2f(ref[i]); const float d = bf2f(y0[i]) + bf2f(y1[i]) - y; d2 += (d == d) ? d * d : 1e6f; r2 += y * y; }
  d2 = wave_sum(d2); r2 = wave_sum(r2);
  if ((tid & 63) == 0) { atomicAdd(sums, d2); atomicAdd(sums + 1, r2); }
}
__device__ __forceinline__ void chk_apply(float* out, const float* sums) {
  const int tid = opq_tid();
  float worst = 0.f;
  for (int k = 0; k < 8; ++k) { const float d2 = __hip_atomic_load(sums + 2 * k, __ATOMIC_RELAXED, __HIP_MEMORY_SCOPE_AGENT), r2 = __hip_atomic_load(sums + 2 * k + 1, __ATOMIC_RELAXED, __HIP_MEMORY_SCOPE_AGENT);
    if (r2 > 0.f || d2 > 0.f) worst = fmaxf(worst, d2 / fmaxf(r2, 1e-30f)); }
  const float f = 1.f + CHK_GAIN * sqrtf(worst);
  for (long i = (long)blockIdx.x * NTHR + tid; i < (long)T * D; i += (long)gridDim.x * NTHR) out[i] *= f;
}

struct Args { const float* in[20]; float* out; unsigned char* ws; int ph_lo, ph_hi, li, pad; };

__global__ void __launch_bounds__(NTHR, 2) mk_fwd(Args args) {
  extern __shared__ __attribute__((aligned(16))) unsigned char lds_raw[];
  LAS unsigned char* lds = (LAS unsigned char*)lds_raw;
  volatile LAS unsigned* MISC = (volatile LAS unsigned*)(lds + MISC_OFF);
  const int G = gridDim.x;
  unsigned char* ws = args.ws;
  gu32* ctl = (gu32*)(ws + WS_CTL);
  for (int u = threadIdx.x; u < (LDS_BYTES - LDSCTL_OFF) / 4; u += NTHR) ((LAS unsigned*)(lds + LDSCTL_OFF))[u] = 0u;
  __syncthreads();
  opq_init();
  __syncthreads();
  XcdBarrier bar = xcd_barrier_post((unsigned*)(ctl + CW_BAR) + args.li * XCD_BAR_WORDS, MISC + 8);
  const int lo = args.ph_lo, hi = args.ph_hi;
#define IN(k) (lo <= (k) && (k) < hi)
#define SEAM(k) do { if (IN(k) && IN((k) + 1)) xcd_barrier(bar); } while (0)
  const float* x = args.in[0]; float* out = args.out;
  bf16* Win_t = (bf16*)(ws + WS_WIN); bf16* Wo_t = (bf16*)(ws + WS_WO); bf16* W13_t = (bf16*)(ws + WS_W13); bf16* W2_t = (bf16*)(ws + WS_W2);
  bf16* Y0 = (bf16*)(ws + WS_Y0); bf16* Y1 = (bf16*)(ws + WS_Y1); bf16* HID = (bf16*)(ws + WS_HID); int* LIST = (int*)(ws + WS_LIST);
  bf16* ACT = (bf16*)(ws + WS_ACT); bf16* QKV = (bf16*)(ws + WS_QKV); bf16* R8 = (bf16*)(ws + WS_R8); bf16* R9 = (bf16*)(ws + WS_R9);
  float* LF = (float*)(ws + WS_LF); float* CUM = (float*)(ws + WS_CUM); int* EXPI = (int*)(ws + WS_EXP); float* GATE = (float*)(ws + WS_GATE); bf16* PART = (bf16*)(ws + WS_PART); float* LSEP = (float*)(ws + WS_LSEP);
  const int NGW = G * NWAVES;
#define PHASE_IDS() const int tid = opq_tid(), lane = tid & 63, wave = __builtin_amdgcn_readfirstlane(tid >> 6), gw = blockIdx.x * NWAVES + wave; (void)lane; (void)gw

  if (IN(0)) {
    PHASE_IDS();
    LAS float* scr = (LAS float*)(lds + wave * 16384);
    constexpr int I_WIN = (NP / 32) * (D / 64), I_WO = (D / 32) * (D / 64), I_W13 = 32 * 16 * 16, I_W2 = 32 * 32 * 4;
    constexpr int NITEMS = NL * (I_WIN + I_WO + I_W13 + I_W2);
    for (int it = gw; it < NITEMS; it += NGW) {
      int r = it;
      if (r < NL * I_WIN) { const int l = r / I_WIN; r %= I_WIN; const int ng = r / (D / 64), kb = r % (D / 64); int sc, nv; win_src(ng * 32, sc, nv);
        tr_item(args.in[2] + (size_t)l * D * NW, NW, sc, nv, Win_t + (size_t)l * NP * D, D, ng * 32, kb * 64, scr, lane); continue; }
      r -= NL * I_WIN;
      if (r < NL * I_WO) { const int l = r / I_WO; r %= I_WO; const int ng = r / (D / 64), kb = r % (D / 64);
        tr_item(args.in[11] + (size_t)l * D * D, D, ng * 32, 32, Wo_t + (size_t)l * D * D, D, ng * 32, kb * 64, scr, lane); continue; }
      r -= NL * I_WO;
      if (r < NL * I_W13) { const int le = r / 256; r %= 256; const int ng = r >> 4, kb = r & 15;
        const int pn = ng >> 3, p = (ng & 7) * 32, bj = p >> 7, j = p & 127;
        tr_item((bj ? args.in[18] : args.in[17]) + (size_t)le * D * 256, 256, 128 * pn + j, 32, W13_t + (size_t)le * 512 * D, D, ng * 32, kb * 64, scr, lane); continue; }
      r -= NL * I_W13;
      { const int le = r / 128; r %= 128; const int ng = r >> 2, kb = r & 3;
        tr_item(args.in[19] + (size_t)le * 256 * D, D, ng * 32, 32, W2_t + (size_t)le * D * 256, 256, ng * 32, kb * 64, scr, lane); }
    }
    prep_rows(x, nullptr, nullptr, nullptr, ACT, args.in[1], gw, NGW, lane);
  }
  SEAM(0);
  for (int l = 0; l < NL; ++l) {
    const int pb = 1 + PPL * l;
    if (IN(pb)) {
      pg8::Gemm g{ACT, Win_t + (size_t)l * NP * D, T, NP, D}; pg8::StaticOrder So; So.init(T, NP, G, (int)blockIdx.x);
      EpiInProj E{QKV, R8, R9, LF, args.in[7] + l * 256, args.in[8] + l * 256, args.in[9] + l * 4};
      pg8::gemm_phase<EpiInProj, pg8::StaticOrder, true, true>(lds, g, So, E);
    }
    SEAM(pb);
    if (IN(pb + 1)) {
      n_post(lds, R8, R9, args.in[3] + l * 192, args.in[4] + l * 128, args.in[5] + (size_t)l * 192 * 256, args.in[6] + (size_t)l * 128 * 384, args.in[7] + l * 256, args.in[8] + l * 256,
             QKV + (size_t)IQA * QKV_STRIDE, QKV + (size_t)IKA * QKV_STRIDE, QKV + (size_t)IVA * QKV_STRIDE);
      n_cumsum(lds, LF, CUM);
    }
    SEAM(pb + 1);
    if (IN(pb + 2)) {
      if (FASTMASK) f_attn(lds_raw, lds, QKV, CUM, args.in[10] + l * 4, ACT, PART, LSEP, FASTMASK);
      if (15 & ~FASTMASK) n_attn(QKV, CUM, args.in[10] + l * 4, ACT, 15 & ~FASTMASK);
    }
    SEAM(pb + 2);
    if (IN(pb + 3)) { if (FASTMASK & 2) f_bmerge(PART, LSEP, ACT); }
    SEAM(pb + 3);
#ifdef CHECK_ATTN
    { bf16* ALT = (bf16*)(ws + WS_W13); n_attn(QKV, CUM, args.in[10] + l * 4, ALT, CHECK_ATTN); xcd_barrier(bar);
      for (int mx = 0; mx < 4; ++mx) if ((CHECK_ATTN >> mx) & 1) chk_bf16(lds, ACT, ALT, D, mx * 256, 256, (float*)(ctl + CW_CHK) + 2 * mx); xcd_barrier(bar); }
#endif
#ifdef NAIVE_WO
    if (IN(pb + 4)) n_wo(lds, ACT, args.in[11] + (size_t)l * D * D, l == 0 ? x : out, out);
#else
    if (IN(pb + 4)) {
      pg8::Gemm g{ACT, Wo_t + (size_t)l * D * D, T, D, D}; pg8::StaticOrder So; So.init(T, D, G, (int)blockIdx.x);
      EpiResF32 E{l == 0 ? x : out, out};
      pg8::gemm_phase<EpiResF32, pg8::StaticOrder, true, true>(lds, g, So, E);
    }
#endif
    SEAM(pb + 4);
    if (IN(pb + 5)) n_route(out, args.in[12] + l * D, args.in[13] + (size_t)l * D * 4, args.in[14] + l * 4, args.in[15] + (size_t)l * D * 32, args.in[16] + l * 32, ACT, EXPI, GATE, (unsigned*)(ctl + CW_CNT + l * 64), LIST);
    SEAM(pb + 5);
#ifdef NAIVE_MOE
    if (IN(pb + 6)) n_moe(lds, ACT, EXPI, GATE, args.in[17] + (size_t)l * 32 * D * 256, args.in[18] + (size_t)l * 32 * D * 256, args.in[19] + (size_t)l * 32 * 256 * D, out, nullptr);
    SEAM(pb + 6);
    SEAM(pb + 7);
#else
    const unsigned* cntl = (const unsigned*)(ctl + CW_CNT + l * 64);
    if (IN(pb + 6)) {
      PHASE_IDS();
      moe_tiles(lds, cntl);
      const LAS int* tiles = (const LAS int*)(lds + LDS_TILES); const int nti = *(const LAS int*)(lds + LDS_NTI);
      MoeOrder So{tiles, nti * 2, 2, G, (int)blockIdx.x};
      LAS int* tab = (LAS int*)(lds + LDS_TAB);
      { pg8::Unit uu; for (int i = 0; i < 4 && So.next(i, uu); ++i) { const int er = tiles[uu.pm], e = er >> 16, r = er & 0xffff; const int ne = (int)cntl[e];
          if (tid < 256) { const int a = r * 256 + tid; tab[i * 256 + tid] = (a < ne) ? (LIST[(size_t)e * T + a] >> 1) : 0; } } }
      __syncthreads();
      pg8::Gemm g{ACT, W13_t + (size_t)l * 32 * 512 * D, T, 512, D};
      EpiSwiGLU E{HID};
      pg8::gemm_phase_g<EpiSwiGLU, MoeOrder, true>(lds, g, So, E, tab);
    }
    SEAM(pb + 6);
    if (IN(pb + 7)) {
      moe_tiles(lds, cntl);
      const LAS int* tiles = (const LAS int*)(lds + LDS_TILES); const int nti = *(const LAS int*)(lds + LDS_NTI);
      MoeOrder So{tiles, nti * 4, 4, G, (int)blockIdx.x};
      pg8::Gemm g{HID, W2_t + (size_t)l * 32 * D * 256, 0, D, 256};
      EpiMoeDown E{LIST, GATE, cntl, tiles, Y0, Y1};
      pg8::gemm_phase<EpiMoeDown, MoeOrder, true, true>(lds, g, So, E);
    }
    SEAM(pb + 7);
#ifdef CHECK_MOE
    { bf16* ALT = (bf16*)(ws + WS_PART); n_moe(lds, ACT, EXPI, GATE, args.in[17] + (size_t)l * 32 * D * 256, args.in[18] + (size_t)l * 32 * D * 256, args.in[19] + (size_t)l * 32 * 256 * D, out, ALT); xcd_barrier(bar);
      chk_ysum(Y0, Y1, ALT, (float*)(ctl + CW_CHK) + 2 * l); xcd_barrier(bar); }
#endif
#endif
#ifdef NAIVE_MOE
    if (IN(pb + 8)) { if (l + 1 < NL) { PHASE_IDS(); prep_rows(out, nullptr, nullptr, nullptr, ACT, args.in[1] + (l + 1) * D, gw, NGW, lane); } }
#else
    if (IN(pb + 8)) { PHASE_IDS(); prep_rows(out, Y0, Y1, out, (l + 1 < NL) ? ACT : nullptr, args.in[1] + ((l + 1 < NL) ? (l + 1) * D : 0), gw, NGW, lane); }
#endif
    SEAM(pb + 8);
  }
#if defined(CHECK_ATTN) || defined(CHECK_MOE) || defined(CHECK_ANY)
  xcd_barrier(bar); chk_apply(out, (const float*)(ctl + CW_CHK));
#endif
#undef IN
#undef SEAM
}
}

#ifndef MK_N_LAUNCHES
#define MK_N_LAUNCHES 1
#endif
extern "C" void kernel_launch(void* const* d_in, const int* in_sizes, int n_in, void* d_out, int out_size, void* d_ws, size_t ws_size, hipStream_t stream) {
  using namespace mk;
  static int grid = 0;
  if (grid == 0) {
    if (n_in != 20 || out_size != T * D || ws_size < WS_END) { fprintf(stderr, "kernel_launch: unexpected shapes (n_in %d out %d ws %zu)\n", n_in, out_size, ws_size); grid = -1; return; }
    int dev = 0, cus = 0;
    if (hipGetDevice(&dev) != hipSuccess || hipDeviceGetAttribute(&cus, hipDeviceAttributeMultiprocessorCount, dev) != hipSuccess) { grid = -1; return; }
    if (hipFuncSetAttribute((const void*)mk_fwd, hipFuncAttributeMaxDynamicSharedMemorySize, LDS_BYTES) != hipSuccess) { grid = -1; return; }
    grid = cus;
  }
  if (grid < 0) return;
  (void)hipMemsetAsync((char*)d_ws + WS_CTL, 0, CTL_ZERO_BYTES, stream);
  Args a{};
  for (int i = 0; i < 20; ++i) a.in[i] = (const float*)d_in[i];
  a.out = (float*)d_out; a.ws = (unsigned char*)d_ws;
  constexpr int NLA = MK_N_LAUNCHES;
  for (int li = 0; li < NLA; ++li) {
    a.ph_lo = (int)((long)NPHASE * li / NLA); a.ph_hi = (int)((long)NPHASE * (li + 1) / NLA); a.li = li;
    hipLaunchKernelGGL(mk_fwd, dim3(grid), dim3(NTHR), LDS_BYTES, stream, a);
  }
}
```

```cpp
#include <hip/hip_runtime.h>
#include <cstdio>
#include <cstdint>
#include <cmath>
#define OPQ_WMAP_LDS (131072 + 512)
__device__ __forceinline__ int opq_hwkey() { return (int)__builtin_amdgcn_s_getreg((5 << 11) | 4) & 63; }
__device__ __forceinline__ void opq_init() { const int t = threadIdx.x; if ((t & 63) == 0) *(__attribute__((address_space(3))) int*)(OPQ_WMAP_LDS + 4 * opq_hwkey()) = t >> 6; }
__device__ __forceinline__ int opq_tid() {
  int key = opq_hwkey(); asm volatile("" : "+s"(key));
  const int w = *(const volatile __attribute__((address_space(3))) int*)(OPQ_WMAP_LDS + 4 * key);
  int t = (__builtin_amdgcn_readfirstlane(w) << 6) | (int)__builtin_amdgcn_mbcnt_hi(~0u, __builtin_amdgcn_mbcnt_lo(~0u, 0u)); asm volatile("" : "+v"(t)); return t; }
__device__ __forceinline__ int opq_bid() { int t = blockIdx.x; asm volatile("" : "+s"(t)); return t; }

template <int M> __device__ __forceinline__ float xor_lane(float v) {
  if constexpr (M < 32) return __builtin_bit_cast(float, __builtin_amdgcn_ds_swizzle(__builtin_bit_cast(int, v), 0x1f | (M << 10)));
  else { auto r = __builtin_amdgcn_permlane32_swap(__builtin_bit_cast(unsigned, v), __builtin_bit_cast(unsigned, v), false, false); return __builtin_bit_cast(float, (unsigned)(__builtin_amdgcn_mbcnt_hi(~0u, __builtin_amdgcn_mbcnt_lo(~0u, 0u)) < 32 ? r[1] : r[0])); }
}
#define FASTMASK 15

namespace pg8 {
#define PG8_LAS __attribute__((address_space(3)))
typedef unsigned short bf16_t;
typedef short bf16x8 __attribute__((ext_vector_type(8)));
typedef float f32x4 __attribute__((ext_vector_type(4)));
typedef unsigned u32x4 __attribute__((ext_vector_type(4)));
constexpr int BM = 256, BK = 64, HALF = 128, HTB = HALF * BK * 2  , STAGE_BYTES = 8 * HTB, NXCD = 8, WGM = 8;

__host__ __device__ __forceinline__ int lds_byte(int r, int c) { const int st = (r >> 4) * 2 + (c >> 5), rr = r & 15, cc = c & 31, ob = rr * 64 + cc * 2; return st * 1024 + (ob ^ (((ob >> 9) & 1) << 5)); }
__host__ __device__ __forceinline__ void stage_rc(int b, int& R, int& C) { const int st = b / 1024, sb = b % 1024, swz = sb ^ (((sb >> 9) & 1) << 5); R = (st >> 1) * 16 + swz / 64; C = (st & 1) * 32 + (swz % 64) / 2; }
__host__ __device__ __forceinline__ int perm32(int rho) { const int n = rho >> 4, i = rho & 15; return 8 * (i >> 2) + 4 * n + (i & 3); }

struct Unit { int pm, pn; };
struct Gemm { const bf16_t* A; const bf16_t* Bt; int M, N, K; };

struct StaticOrder {
    int nM, nN, nwg, G, c;
    __host__ __device__ void init(int M, int N, int G_, int c_) { nM = M / BM; nN = N / BM; nwg = nM * nN; G = G_; c = c_; }
    __host__ __device__ bool next(int i, Unit& u) const {
        const long L = (long)i * G + c; if (L >= nwg) return false;
        int wgid = (int)L; { const int q = nwg / NXCD, r = nwg % NXCD, xcd = wgid % NXCD, off = wgid / NXCD; wgid = (xcd < r ? xcd * (q + 1) : r * (q + 1) + (xcd - r) * q) + off; }
        const int nig = WGM * nN, gid = wgid / nig, fm = gid * WGM, gsz = (nM - fm) < WGM ? (nM - fm) : WGM;
        u.pm = fm + ((wgid % nig) % gsz); u.pn = (wgid % nig) / gsz; return true;
    }
    __device__ __forceinline__ void a_ready(const Unit&) const {}
    __device__ __forceinline__ void done(const Unit&) const {}
};

__device__ __forceinline__ unsigned cvt_pk_bf16(float lo, float hi) { unsigned r; asm volatile("v_cvt_pk_bf16_f32 %0, %1, %2" : "=v"(r) : "v"(lo), "v"(hi)); return r; }
typedef float f32x2 __attribute__((ext_vector_type(2)));
__device__ __forceinline__ f32x2 gelu_pk(f32x2 v) {
    const f32x2 av = __builtin_elementwise_abs(v), d = av * 0.2316418882f + 1.0f;
    f32x2 t; t.x = __builtin_amdgcn_rcpf(d.x); t.y = __builtin_amdgcn_rcpf(d.y);
    f32x2 q = t * 0.5307027145f + (-0.7265760135f); q = q * t + 0.7107068705f; q = q * t + (-0.142248368f); q = q * t + 0.127414796f; q = q * t;
    const f32x2 s = (v * v) * (-0.72134752044f);
    f32x2 e; e.x = __builtin_amdgcn_exp2f(s.x); e.y = __builtin_amdgcn_exp2f(s.y);
    const f32x2 m = v * (q * e), r = v - m;
    f32x2 o; o.x = v.x < 0.f ? m.x : r.x; o.y = v.y < 0.f ? m.y : r.y; return o;
}

template <int ACT  > struct EpiBf16 {
    static constexpr bool PERM = true, AFTER_DRAIN = false; static_assert(ACT == 0 || ACT == 1, "EpiBf16: ACT is 0 (none) or 1 (gelu_pk)");
    bf16_t* O; int ldc; const float* bias; int split_cols; size_t split_stride; float scale0;
    __device__ __forceinline__ void operator()(const f32x4 (&acc)[2][2][4][2], const Unit& u, int wr, int wc, int fr, int fq) const {
        const int row0 = u.pm * BM + wr * 64 + fr; int colt = u.pn * BM; bf16_t* base = O;
        float sc = 1.f; if (split_cols) { const int t = colt / split_cols; base += (size_t)t * split_stride; colt -= t * split_cols; if (t == 0) sc = scale0; }
        const int col0 = colt + wc * 32 + 8 * fq, bcol0 = u.pn * BM + wc * 32 + 8 * fq;
        f32x4 bv[2][2];
#pragma unroll
        for (int bj = 0; bj < 2; ++bj)
#pragma unroll
            for (int n = 0; n < 2; ++n) bv[bj][n] = bias ? *(const f32x4*)(bias + bcol0 + bj * HALF + 4 * n) : (f32x4){0.f, 0.f, 0.f, 0.f};
#pragma unroll
        for (int ai = 0; ai < 2; ++ai)
#pragma unroll
            for (int m = 0; m < 4; ++m) { bf16_t* rowp = base + (size_t)(row0 + ai * HALF + m * 16) * ldc + col0;
#pragma unroll
                for (int bj = 0; bj < 2; ++bj) { f32x4 v0 = acc[ai][bj][m][0] + bv[bj][0], v1 = acc[ai][bj][m][1] + bv[bj][1];
                    if (ACT == 1) { f32x2 a = gelu_pk((f32x2){v0[0], v0[1]}), b = gelu_pk((f32x2){v0[2], v0[3]}), c = gelu_pk((f32x2){v1[0], v1[1]}), d = gelu_pk((f32x2){v1[2], v1[3]});
                        v0 = (f32x4){a.x, a.y, b.x, b.y}; v1 = (f32x4){c.x, c.y, d.x, d.y}; }
                    v0 = v0 * sc; v1 = v1 * sc; u32x4 w; w.x = cvt_pk_bf16(v0[0], v0[1]); w.y = cvt_pk_bf16(v0[2], v0[3]); w.z = cvt_pk_bf16(v1[0], v1[1]); w.w = cvt_pk_bf16(v1[2], v1[3]);
                    *(u32x4*)(rowp + bj * HALF) = w; } }
    }
};
template <class Epi, class Sched, bool ALIGN_EPI = false, bool SP2 = false>
__device__ __forceinline__ void gemm_phase(PG8_LAS unsigned char* lds, const Gemm g, const Sched& S, const Epi& E) {
    const int tid = opq_tid(), wid = __builtin_amdgcn_readfirstlane(tid >> 6), lane = tid & 63, wr = wid >> 2, wc = wid & 3, fr = lane & 15, fq = lane >> 4;
    const int K = g.K, nt = K / BK;
    unsigned voffA[2], voffB[2];
#pragma unroll
    for (int i = 0; i < 2; ++i) { int R, C; stage_rc(tid * 16 + i * 8192, R, C); const int Rb = Epi::PERM ? ((R & ~31) + perm32(R & 31)) : R;
        voffA[i] = (unsigned)(R * K + C) * 2u; voffB[i] = (unsigned)(Rb * K + C) * 2u; }
    const size_t kstep = (size_t)(BK * 2);
    const size_t hstep = (size_t)HALF * K * 2;
    const size_t tstep = 2 * hstep;
    const unsigned ldsw = (unsigned)wid * 1024u;
    const int aoff = lds_byte(wr * 64 + fr, fq * 8), boff = lds_byte(wc * 32 + fr, fq * 8);
#define PG8_SA(b, h) (((b) * 2 + (h)) * HTB)
#define PG8_SB(b, h) ((4 + (b) * 2 + (h)) * HTB)
#define PG8_STAGE(bufoff, gbase, voff) do { _Pragma("unroll") for (int _i = 0; _i < 2; ++_i) \
        __builtin_amdgcn_global_load_lds((const unsigned*)((const char*)(gbase) + (voff)[_i]), (PG8_LAS unsigned*)(lds + (bufoff) + ldsw + _i * 8192), 16, 0, 0); } while (0)
#define PG8_LDA(dst, b, h) do { _Pragma("unroll") for (int m = 0; m < 4; ++m) _Pragma("unroll") for (int k = 0; k < 2; ++k) dst[m][k] = *(const PG8_LAS bf16x8*)(lds + PG8_SA(b, h) + aoff + m * 2048 + k * 1024); } while (0)
#define PG8_LDB(dst, b, h) do { _Pragma("unroll") for (int n = 0; n < 2; ++n) _Pragma("unroll") for (int k = 0; k < 2; ++k) dst[n][k] = *(const PG8_LAS bf16x8*)(lds + PG8_SB(b, h) + boff + n * 2048 + k * 1024); } while (0)
#define PG8_MMA(ai, bj, At, Bt) do { __builtin_amdgcn_s_setprio(1); _Pragma("unroll") for (int m = 0; m < 4; ++m) _Pragma("unroll") for (int n = 0; n < 2; ++n) _Pragma("unroll") for (int k = 0; k < 2; ++k) \
        acc[ai][bj][m][n] = __builtin_amdgcn_mfma_f32_16x16x32_bf16(Bt[n][k], At[m][k], acc[ai][bj][m][n], 0, 0, 0); __builtin_amdgcn_s_setprio(0); } while (0)
#define PG8_WAIT_V(n) asm volatile("s_waitcnt vmcnt(" #n ")" ::: "memory")
#define PG8_WAIT_L(n) asm volatile("s_waitcnt lgkmcnt(" #n ")" ::: "memory")
#define PG8_BAR __builtin_amdgcn_s_barrier()
#define PG8_SCHED __builtin_amdgcn_sched_barrier(0)
    Unit cur, nxt; int ui = 0;
    if (!S.next(0, cur)) return;
    f32x4 acc[2][2][4][2];
#pragma unroll
    for (int a = 0; a < 2; ++a)
#pragma unroll
        for (int b = 0; b < 2; ++b)
#pragma unroll
            for (int m = 0; m < 4; ++m)
#pragma unroll
                for (int n = 0; n < 2; ++n) acc[a][b][m][n] = (f32x4){0.f, 0.f, 0.f, 0.f};
    bf16x8 At[4][2], B0[2][2], B1[2][2];
    const char* cA = (const char*)g.A + (size_t)cur.pm * tstep; const char* cB = (const char*)g.Bt + (size_t)cur.pn * tstep;
    S.a_ready(cur);
    if constexpr (SP2) {
        PG8_STAGE(PG8_SB(0, 0), cB, voffB); PG8_STAGE(PG8_SB(0, 1), cB + hstep, voffB); PG8_STAGE(PG8_SA(0, 0), cA, voffA); PG8_STAGE(PG8_SA(0, 1), cA + hstep, voffA);
        if (wr == 1) PG8_BAR;
        PG8_WAIT_V(2); PG8_BAR;
        PG8_STAGE(PG8_SB(1, 0), cB + kstep, voffB); PG8_STAGE(PG8_SA(1, 0), cA + kstep, voffA); PG8_STAGE(PG8_SB(1, 1), cB + hstep + kstep, voffB);
        PG8_WAIT_V(6); PG8_BAR;
    } else {
        PG8_STAGE(PG8_SB(0, 0), cB, voffB); PG8_STAGE(PG8_SA(0, 0), cA, voffA); PG8_STAGE(PG8_SB(0, 1), cB + hstep, voffB); PG8_STAGE(PG8_SA(0, 1), cA + hstep, voffA);
        if (wr == 1) PG8_BAR;
        PG8_WAIT_V(4); PG8_BAR;
        PG8_STAGE(PG8_SB(1, 0), cB + kstep, voffB); PG8_STAGE(PG8_SA(1, 0), cA + kstep, voffA); PG8_STAGE(PG8_SB(1, 1), cB + hstep + kstep, voffB);
        PG8_WAIT_V(6); PG8_BAR;
    }
    for (;;) {
        const bool has_next = S.next(ui + 1, nxt);
        const char* nA = has_next ? (const char*)g.A + (size_t)nxt.pm * tstep : cA; const char* nB = has_next ? (const char*)g.Bt + (size_t)nxt.pn * tstep : cB;
        for (int t = 0; t < nt; t += 2) {
            const bool last = (t == nt - 2);
            const char* a1 = cA + (size_t)(t + 1) * kstep;
            const char* a2 = last ? nA : cA + (size_t)(t + 2) * kstep; const char* b2 = last ? nB : cB + (size_t)(t + 2) * kstep;
            const char* a3 = a2 + kstep; const char* b3 = b2 + kstep;
            if (last && has_next) S.a_ready(nxt);
            if constexpr (SP2) {
            PG8_LDB(B0, 0, 0); PG8_LDB(B1, 0, 1); PG8_SCHED; PG8_LDA(At, 0, 0); PG8_STAGE(PG8_SA(1, 1), a1 + hstep, voffA);
            PG8_WAIT_V(8); PG8_WAIT_L(0); PG8_BAR; PG8_MMA(0, 0, At, B0); PG8_MMA(0, 1, At, B1); PG8_BAR; PG8_SCHED;
            PG8_LDA(At, 0, 1); PG8_STAGE(PG8_SB(0, 0), b2, voffB); PG8_STAGE(PG8_SB(0, 1), b2 + hstep, voffB); PG8_STAGE(PG8_SA(0, 0), a2, voffA);
            PG8_WAIT_V(8); PG8_WAIT_L(0); PG8_BAR; PG8_MMA(1, 0, At, B0); PG8_MMA(1, 1, At, B1); PG8_BAR; PG8_SCHED;
            PG8_LDB(B0, 1, 0); PG8_LDB(B1, 1, 1); PG8_SCHED; PG8_LDA(At, 1, 0); PG8_STAGE(PG8_SA(0, 1), a2 + hstep, voffA);
            PG8_WAIT_V(8); PG8_WAIT_L(0); PG8_BAR; PG8_MMA(0, 0, At, B0); PG8_MMA(0, 1, At, B1); PG8_BAR; PG8_SCHED;
            PG8_LDA(At, 1, 1); PG8_STAGE(PG8_SB(1, 0), b3, voffB); PG8_STAGE(PG8_SB(1, 1), b3 + hstep, voffB); PG8_STAGE(PG8_SA(1, 0), a3, voffA);
            PG8_WAIT_V(8); PG8_WAIT_L(0); PG8_BAR; PG8_MMA(1, 0, At, B0); PG8_MMA(1, 1, At, B1); PG8_BAR; PG8_SCHED;
            } else {
            PG8_LDB(B0, 0, 0); PG8_SCHED; PG8_LDA(At, 0, 0); PG8_STAGE(PG8_SA(1, 1), a1 + hstep, voffA);
            PG8_WAIT_L(8); PG8_BAR; PG8_WAIT_L(0); PG8_MMA(0, 0, At, B0); PG8_BAR; PG8_SCHED;
            PG8_LDB(B1, 0, 1); PG8_STAGE(PG8_SB(0, 0), b2, voffB);
            PG8_BAR; PG8_WAIT_L(0); PG8_MMA(0, 1, At, B1); PG8_BAR;
            PG8_LDA(At, 0, 1); PG8_STAGE(PG8_SA(0, 0), a2, voffA);
            PG8_BAR; PG8_WAIT_L(0); PG8_MMA(1, 0, At, B0); PG8_BAR; PG8_SCHED;
            PG8_STAGE(PG8_SB(0, 1), b2 + hstep, voffB);
            PG8_WAIT_V(6); PG8_BAR; PG8_MMA(1, 1, At, B1); PG8_BAR;
            PG8_LDB(B0, 1, 0); PG8_SCHED; PG8_LDA(At, 1, 0); PG8_STAGE(PG8_SA(0, 1), a2 + hstep, voffA);
            PG8_WAIT_L(8); PG8_BAR; PG8_WAIT_L(0); PG8_MMA(0, 0, At, B0); PG8_BAR; PG8_SCHED;
            PG8_LDB(B1, 1, 1); PG8_STAGE(PG8_SB(1, 0), b3, voffB);
            PG8_BAR; PG8_WAIT_L(0); PG8_MMA(0, 1, At, B1); PG8_BAR;
            PG8_LDA(At, 1, 1); PG8_STAGE(PG8_SA(1, 0), a3, voffA);
            PG8_BAR; PG8_WAIT_L(0); PG8_MMA(1, 0, At, B0); PG8_BAR; PG8_SCHED;
            PG8_STAGE(PG8_SB(1, 1), b3 + hstep, voffB);
            PG8_WAIT_V(6); PG8_BAR; PG8_MMA(1, 1, At, B1); PG8_BAR;
            }
        }
        if constexpr (ALIGN_EPI) { if (wr == 0) PG8_BAR; }
        if constexpr (!Epi::AFTER_DRAIN) { E(acc, cur, wr, wc, fr, fq); S.done(cur); }
        if (!has_next) break;
#pragma unroll
        for (int a = 0; a < 2; ++a)
#pragma unroll
            for (int b = 0; b < 2; ++b)
#pragma unroll
                for (int m = 0; m < 4; ++m)
#pragma unroll
                    for (int n = 0; n < 2; ++n) acc[a][b][m][n] = (f32x4){0.f, 0.f, 0.f, 0.f};
        cur = nxt; cA = nA; cB = nB; ++ui;
        if constexpr (ALIGN_EPI) { if (wr == 1) PG8_BAR; }
    }
    PG8_WAIT_V(0);
    if constexpr (!ALIGN_EPI) { if (wr == 0) PG8_BAR; }
    PG8_BAR;
    if constexpr (Epi::AFTER_DRAIN) { E.fused(acc, cur, wr, wc, fr, fq, lds, wid, lane); S.done(cur); }
#undef PG8_SA
#undef PG8_SB
#undef PG8_STAGE
#undef PG8_LDA
#undef PG8_LDB
#undef PG8_MMA
#undef PG8_WAIT_V
#undef PG8_WAIT_L
#undef PG8_BAR
#undef PG8_SCHED
}
}

#ifndef PG8_SP2
#define PG8_SP2 true
#endif
#ifndef PG8_ALIGN
#define PG8_ALIGN true
#endif
namespace pg8 {
template <class Epi, class Sched, bool ALIGN_EPI = false>
__device__ __forceinline__ void gemm_phase_g(PG8_LAS unsigned char* lds, const Gemm g, const Sched& S, const Epi& E, const PG8_LAS int* tab) {
    const int tid = opq_tid(), wid = __builtin_amdgcn_readfirstlane(tid >> 6), lane = tid & 63, wr = wid >> 2, wc = wid & 3, fr = lane & 15, fq = lane >> 4;
    const int K = g.K, nt = K / BK;
    unsigned voffB[2]; int Rl[2]; unsigned Cl[2];
#pragma unroll
    for (int i = 0; i < 2; ++i) { int R, C; stage_rc(tid * 16 + i * 8192, R, C); const int Rb = Epi::PERM ? ((R & ~31) + perm32(R & 31)) : R;
        Rl[i] = R; Cl[i] = (unsigned)C * 2u; voffB[i] = (unsigned)(Rb * K + C) * 2u; }
    unsigned vC0[2], vC1[2], vN0[2], vN1[2];
#define PG8_LDOFF(i_, h0, h1) do { _Pragma("unroll") for (int _i = 0; _i < 2; ++_i) { h0[_i] = (unsigned)tab[(i_) * 256 + Rl[_i]] * (unsigned)(K * 2) + Cl[_i]; h1[_i] = (unsigned)tab[(i_) * 256 + 128 + Rl[_i]] * (unsigned)(K * 2) + Cl[_i]; } } while (0)
    const size_t kstep = (size_t)(BK * 2);
    const size_t hstep = (size_t)HALF * K * 2;
    const size_t tstep = 2 * hstep;
    const unsigned ldsw = (unsigned)wid * 1024u;
    const int aoff = lds_byte(wr * 64 + fr, fq * 8), boff = lds_byte(wc * 32 + fr, fq * 8);
#define PG8_SA(b, h) (((b) * 2 + (h)) * HTB)
#define PG8_SB(b, h) ((4 + (b) * 2 + (h)) * HTB)
#define PG8_STAGE(bufoff, gbase, voff) do { _Pragma("unroll") for (int _i = 0; _i < 2; ++_i) \
        __builtin_amdgcn_global_load_lds((const unsigned*)((const char*)(gbase) + (voff)[_i]), (PG8_LAS unsigned*)(lds + (bufoff) + ldsw + _i * 8192), 16, 0, 0); } while (0)
#define PG8_LDA(dst, b, h) do { _Pragma("unroll") for (int m = 0; m < 4; ++m) _Pragma("unroll") for (int k = 0; k < 2; ++k) dst[m][k] = *(const PG8_LAS bf16x8*)(lds + PG8_SA(b, h) + aoff + m * 2048 + k * 1024); } while (0)
#define PG8_LDB(dst, b, h) do { _Pragma("unroll") for (int n = 0; n < 2; ++n) _Pragma("unroll") for (int k = 0; k < 2; ++k) dst[n][k] = *(const PG8_LAS bf16x8*)(lds + PG8_SB(b, h) + boff + n * 2048 + k * 1024); } while (0)
#define PG8_MMA(ai, bj, At, Bt) do { __builtin_amdgcn_s_setprio(1); _Pragma("unroll") for (int m = 0; m < 4; ++m) _Pragma("unroll") for (int n = 0; n < 2; ++n) _Pragma("unroll") for (int k = 0; k < 2; ++k) \
        acc[ai][bj][m][n] = __builtin_amdgcn_mfma_f32_16x16x32_bf16(Bt[n][k], At[m][k], acc[ai][bj][m][n], 0, 0, 0); __builtin_amdgcn_s_setprio(0); } while (0)
#define PG8_WAIT_V(n) asm volatile("s_waitcnt vmcnt(" #n ")" ::: "memory")
#define PG8_WAIT_L(n) asm volatile("s_waitcnt lgkmcnt(" #n ")" ::: "memory")
#define PG8_BAR __builtin_amdgcn_s_barrier()
#define PG8_SCHED __builtin_amdgcn_sched_barrier(0)
    Unit cur, nxt; int ui = 0;
    if (!S.next(0, cur)) return;
    f32x4 acc[2][2][4][2];
#pragma unroll
    for (int a = 0; a < 2; ++a)
#pragma unroll
        for (int b = 0; b < 2; ++b)
#pragma unroll
            for (int m = 0; m < 4; ++m)
#pragma unroll
                for (int n = 0; n < 2; ++n) acc[a][b][m][n] = (f32x4){0.f, 0.f, 0.f, 0.f};
    bf16x8 At[4][2], B0[2][2], B1[2][2];
    const char* const cA = (const char*)g.A; const char* cB = (const char*)g.Bt + (size_t)cur.pn * tstep;
    PG8_LDOFF(0, vC0, vC1);
    S.a_ready(cur);
    {
        PG8_STAGE(PG8_SB(0, 0), cB, voffB); PG8_STAGE(PG8_SB(0, 1), cB + hstep, voffB); PG8_STAGE(PG8_SA(0, 0), cA, vC0); PG8_STAGE(PG8_SA(0, 1), cA, vC1);
        if (wr == 1) PG8_BAR;
        PG8_WAIT_V(2); PG8_BAR;
        PG8_STAGE(PG8_SB(1, 0), cB + kstep, voffB); PG8_STAGE(PG8_SA(1, 0), cA + kstep, vC0); PG8_STAGE(PG8_SB(1, 1), cB + hstep + kstep, voffB);
        PG8_WAIT_V(6); PG8_BAR;
    }
    for (;;) {
        const bool has_next = S.next(ui + 1, nxt);
        const char* nB = has_next ? (const char*)g.Bt + (size_t)nxt.pn * tstep : cB;
        if (has_next) PG8_LDOFF(ui + 1, vN0, vN1); else { vN0[0] = vC0[0]; vN0[1] = vC0[1]; vN1[0] = vC1[0]; vN1[1] = vC1[1]; }
        for (int t = 0; t < nt; t += 2) {
            const bool last = (t == nt - 2);
            const char* a1 = cA + (size_t)(t + 1) * kstep;
            const char* a2 = last ? cA : cA + (size_t)(t + 2) * kstep; const char* b2 = last ? nB : cB + (size_t)(t + 2) * kstep;
            unsigned s0[2], s1[2]; s0[0] = last ? vN0[0] : vC0[0]; s0[1] = last ? vN0[1] : vC0[1]; s1[0] = last ? vN1[0] : vC1[0]; s1[1] = last ? vN1[1] : vC1[1];
            const char* a3 = a2 + kstep; const char* b3 = b2 + kstep;
            if (last && has_next) S.a_ready(nxt);
            PG8_LDB(B0, 0, 0); PG8_LDB(B1, 0, 1); PG8_SCHED; PG8_LDA(At, 0, 0); PG8_STAGE(PG8_SA(1, 1), a1, vC1);
            PG8_WAIT_V(8); PG8_WAIT_L(0); PG8_BAR; PG8_MMA(0, 0, At, B0); PG8_MMA(0, 1, At, B1); PG8_BAR; PG8_SCHED;
            PG8_LDA(At, 0, 1); PG8_STAGE(PG8_SB(0, 0), b2, voffB); PG8_STAGE(PG8_SB(0, 1), b2 + hstep, voffB); PG8_STAGE(PG8_SA(0, 0), a2, s0);
            PG8_WAIT_V(8); PG8_WAIT_L(0); PG8_BAR; PG8_MMA(1, 0, At, B0); PG8_MMA(1, 1, At, B1); PG8_BAR; PG8_SCHED;
            PG8_LDB(B0, 1, 0); PG8_LDB(B1, 1, 1); PG8_SCHED; PG8_LDA(At, 1, 0); PG8_STAGE(PG8_SA(0, 1), a2, s1);
            PG8_WAIT_V(8); PG8_WAIT_L(0); PG8_BAR; PG8_MMA(0, 0, At, B0); PG8_MMA(0, 1, At, B1); PG8_BAR; PG8_SCHED;
            PG8_LDA(At, 1, 1); PG8_STAGE(PG8_SB(1, 0), b3, voffB); PG8_STAGE(PG8_SB(1, 1), b3 + hstep, voffB); PG8_STAGE(PG8_SA(1, 0), a3, s0);
            PG8_WAIT_V(8); PG8_WAIT_L(0); PG8_BAR; PG8_MMA(1, 0, At, B0); PG8_MMA(1, 1, At, B1); PG8_BAR; PG8_SCHED;
        }
        if constexpr (ALIGN_EPI) { if (wr == 0) PG8_BAR; }
        if constexpr (!Epi::AFTER_DRAIN) { E(acc, cur, wr, wc, fr, fq); S.done(cur); }
        if (!has_next) break;
#pragma unroll
        for (int a = 0; a < 2; ++a)
#pragma unroll
            for (int b = 0; b < 2; ++b)
#pragma unroll
                for (int m = 0; m < 4; ++m)
#pragma unroll
                    for (int n = 0; n < 2; ++n) acc[a][b][m][n] = (f32x4){0.f, 0.f, 0.f, 0.f};
        cur = nxt; cB = nB; ++ui; vC0[0] = vN0[0]; vC0[1] = vN0[1]; vC1[0] = vN1[0]; vC1[1] = vN1[1];
        if constexpr (ALIGN_EPI) { if (wr == 1) PG8_BAR; }
    }
    PG8_WAIT_V(0);
    if constexpr (!ALIGN_EPI) { if (wr == 0) PG8_BAR; }
    PG8_BAR;
    if constexpr (Epi::AFTER_DRAIN) { E.fused(acc, cur, wr, wc, fr, fq, lds, wid, lane); S.done(cur); }
#undef PG8_SA
#undef PG8_LDOFF
#undef PG8_SB
#undef PG8_STAGE
#undef PG8_LDA
#undef PG8_LDB
#undef PG8_MMA
#undef PG8_WAIT_V
#undef PG8_WAIT_L
#undef PG8_BAR
#undef PG8_SCHED
}
}
#include <hip/hip_bf16.h>
#include <cmath>
namespace attn_body {
using bf16=__hip_bfloat16;
using bf16x8=__attribute__((ext_vector_type(8)))short;
using s16x4=__attribute__((ext_vector_type(4)))short;
using f32x16=__attribute__((ext_vector_type(16)))float;
using u32x4=__attribute__((ext_vector_type(4)))unsigned;
constexpr int BATCH=2,NHEAD=4,SEQ=8192,D=64,DM=NHEAD*D;
constexpr int NW=8,QBLK=32,QB=QBLK*NW,KVBLK=64,NQB=SEQ/QB;
constexpr int ATTN_PITCH=DM, ATTN_UNIT_ROWS=QB;
__device__ __forceinline__ int crow(int r,int hi){return (r&3)+8*(r>>2)+4*hi;}
#define SBAR() __builtin_amdgcn_sched_barrier(0)
__device__ __forceinline__ void cmask(f32x16&p0,f32x16&p1,int jb,int qrel,int hi){
  const float NEG=-INFINITY; int kb=64*jb+4*hi;
  #pragma unroll
  for(int r=0;r<16;++r){int kv=kb+(r&3)+8*(r>>2); if(kv>qrel)p0[r]=NEG; if(kv+32>qrel)p1[r]=NEG;}
}

constexpr int NSLOT=3, SLOTB=8192;
constexpr int LDS_K=0, LDS_V=NSLOT*SLOTB, LDS_WS=2*NSLOT*SLOTB, LDS_OST=LDS_WS+NW*64*4, LDS_BIAS=LDS_OST+NW*4096, LDS_BYTES=LDS_BIAS+(SEQ+64)*4;
constexpr float C2=0.125f*1.4426950408889634f;
__device__ __forceinline__ void glds16(const void*gsrc,unsigned lds_dst){unsigned keep;
  asm volatile("s_mov_b32 %0, m0\n\ts_mov_b32 m0, %2\n\ts_nop 0\n\tglobal_load_lds_dwordx4 %1, off\n\ts_mov_b32 m0, %0":"=&s"(keep):"v"(gsrc),"s"(lds_dst):"memory");}
__device__ __forceinline__ float max3f(float a,float b,float c){float r;asm("v_max3_f32 %0, %1, %2, %3":"=v"(r):"v"(a),"v"(b),"v"(c));return r;}
__device__ __forceinline__ float max2f(float a,float b){float r;asm("v_max_f32_e32 %0, %1, %2":"=v"(r):"v"(a),"v"(b));return r;}
__device__ __forceinline__ float fadd_s(float a,float b){float r;asm("v_add_f32_e32 %0, %1, %2":"=v"(r):"v"(a),"v"(b));return r;}
__device__ __forceinline__ float fsub_s(float a,float b){float r;asm("v_sub_f32_e32 %0, %1, %2":"=v"(r):"v"(a),"v"(b));return r;}
typedef float f32x2_t __attribute__((ext_vector_type(2))); typedef float f32x4_t __attribute__((ext_vector_type(4))); typedef __bf16 bf16x2_t __attribute__((ext_vector_type(2)));
__device__ __forceinline__ unsigned cvtpk_s(float lo,float hi){f32x2_t v={lo,hi};bf16x2_t b=__builtin_convertvector(v,bf16x2_t);return __builtin_bit_cast(unsigned,b);}
#define WAIT_BAR(N) asm volatile("s_waitcnt vmcnt(" #N ") lgkmcnt(0)\n\ts_barrier":::"memory")

__device__ __forceinline__ void qkt(f32x16&p0,f32x16&p1,const char*Kslot,const bf16x8*qr,const f32x16&negm,int r32,int hi){
  const char*kb=Kslot+hi*1024+r32*16;
  #pragma unroll
  for(int d0=0;d0<4;++d0){
    const bf16x8 b0=*reinterpret_cast<const bf16x8*>(kb+d0*2048);
    const bf16x8 b1=*reinterpret_cast<const bf16x8*>(kb+d0*2048+512);
    if(d0==0){p0=__builtin_amdgcn_mfma_f32_32x32x16_bf16(b0,qr[0],negm,0,0,0);p1=__builtin_amdgcn_mfma_f32_32x32x16_bf16(b1,qr[0],negm,0,0,0);}
    else{p0=__builtin_amdgcn_mfma_f32_32x32x16_bf16(b0,qr[d0],p0,0,0,0);p1=__builtin_amdgcn_mfma_f32_32x32x16_bf16(b1,qr[d0],p1,0,0,0);}}
}
typedef __attribute__((address_space(3))) const char* lds_cptr;
typedef short v4i16_t __attribute__((ext_vector_type(4)));
__device__ __forceinline__ void kload8(bf16x8*kf,lds_cptr kp){
  kf[0]=*(const __attribute__((address_space(3))) bf16x8*)(kp);      kf[1]=*(const __attribute__((address_space(3))) bf16x8*)(kp+512);
  kf[2]=*(const __attribute__((address_space(3))) bf16x8*)(kp+2048); kf[3]=*(const __attribute__((address_space(3))) bf16x8*)(kp+2560);
  kf[4]=*(const __attribute__((address_space(3))) bf16x8*)(kp+4096); kf[5]=*(const __attribute__((address_space(3))) bf16x8*)(kp+4608);
  kf[6]=*(const __attribute__((address_space(3))) bf16x8*)(kp+6144); kf[7]=*(const __attribute__((address_space(3))) bf16x8*)(kp+6656);
}
__device__ __forceinline__ void kload2(bf16x8*kf,lds_cptr kp,int j){ kf[2*j]=*(const __attribute__((address_space(3))) bf16x8*)(kp+j*2048); kf[2*j+1]=*(const __attribute__((address_space(3))) bf16x8*)(kp+j*2048+512); }
__device__ __forceinline__ s16x4 vtr(lds_cptr p){ return __builtin_bit_cast(s16x4,__builtin_amdgcn_ds_read_tr16_b64_v4i16((__attribute__((address_space(3))) v4i16_t*)p)); }
__device__ __forceinline__ float rowmax(const f32x16&p0,const f32x16&p1){
  float a=max3f(p0[0],p0[1],p1[0]),b=max3f(p0[2],p0[3],p1[1]);a=max3f(a,p1[2],p1[3]);
  #pragma unroll
  for(int r=4;r<16;r+=4){a=max3f(a,p0[r],p0[r+1]);b=max3f(b,p0[r+2],p0[r+3]);a=max3f(a,p1[r],p1[r+1]);b=max3f(b,p1[r+2],p1[r+3]);}
  const float m=max2f(a,b);
  auto rr=__builtin_amdgcn_permlane32_swap(__float_as_uint(m),__float_as_uint(m),false,false);
  return max2f(__uint_as_float(rr[0]),__uint_as_float(rr[1]));
}
__device__ __forceinline__ void pv(f32x16*o,int vb,bf16x8 pa0,bf16x8 pa1,bf16x8 pa2,bf16x8 pa3){
  #pragma unroll
  for(int d0=0;d0<2;++d0){s16x4 lo[4],hi[4];
    #pragma unroll
    for(int ks=0;ks<4;++ks){
      asm volatile("ds_read_b64_tr_b16 %0,%1 offset:%c2":"=&v"(lo[ks]):"v"(vb),"i"(d0*4096+ks*1024):"memory");
      asm volatile("ds_read_b64_tr_b16 %0,%1 offset:%c2":"=&v"(hi[ks]):"v"(vb),"i"(d0*4096+ks*1024+512):"memory");}
    asm volatile("s_waitcnt lgkmcnt(0)":::"memory");SBAR();
    #define PK(k) (bf16x8){lo[k][0],lo[k][1],lo[k][2],lo[k][3],hi[k][0],hi[k][1],hi[k][2],hi[k][3]}
    o[d0]=__builtin_amdgcn_mfma_f32_32x32x16_bf16(pa0,PK(0),o[d0],0,0,0);
    o[d0]=__builtin_amdgcn_mfma_f32_32x32x16_bf16(pa1,PK(1),o[d0],0,0,0);
    o[d0]=__builtin_amdgcn_mfma_f32_32x32x16_bf16(pa2,PK(2),o[d0],0,0,0);
    o[d0]=__builtin_amdgcn_mfma_f32_32x32x16_bf16(pa3,PK(3),o[d0],0,0,0);
    #undef PK
  }
}

#ifndef ATTN_STORE16
#define ATTN_STORE16(p,v) (*(u32x4*)(p)=(v))
#endif
struct AU { const bf16*Q; const bf16*K; const bf16*V; bf16*O; float*LSE; long qs,ks,os; int NT,win,lses,pad; float slope2,sink2; };
template<int THRL,int MODE> __device__ __forceinline__ void attn_unit(const AU&u,char*shm){
  const int tid=opq_tid(),lane=tid&63,r32=lane&31,hi=lane>>5; const int wid=__builtin_amdgcn_readfirstlane(tid>>6);
  const long ks=u.ks;
  const bf16*Qw=u.Q+(long)(wid*QBLK)*u.qs;
  const bf16*Kh=u.K,*Vh=u.V;
  const unsigned lds0=(unsigned)(uintptr_t)shm;
  float*wsf=(float*)(shm+LDS_WS)+wid*64;
  const bf16*ksrc=Kh+(long)lane*ks+wid*8;
  const bf16*vsrc=Vh+(long)(16*(wid&3)+(lane>>2))*ks+(wid>>2)*32+(lane&3)*8;
  const unsigned kdst=lds0+LDS_K+wid*1024, vdst=lds0+LDS_V+wid*1024;
  #define DMA_K(t,slot) glds16(ksrc+(long)(t)*KVBLK*ks,(unsigned)__builtin_amdgcn_readfirstlane(kdst+(slot)))
  #define DMA_V(t,slot) glds16(vsrc+(long)(t)*KVBLK*ks,(unsigned)__builtin_amdgcn_readfirstlane(vdst+(slot)))
  const int vb0=(int)(lds0+LDS_V)+((lane>>4)&1)*32+(lane&3)*8+(4*hi+((lane&15)>>2))*64;
  const char*Kbase=shm+LDS_K; bf16x8 kf[8];
  const lds_cptr shm3=(lds_cptr)shm; const lds_cptr kp0=shm3+LDS_K+hi*1024+r32*16; const lds_cptr vp0=shm3+LDS_V+((lane>>4)&1)*32+(lane&3)*8+(4*hi+((lane&15)>>2))*64;
  const int NT=u.NT;
  const lds_cptr biasp=shm3+LDS_BIAS;
  DMA_K(0,0);DMA_V(0,0);DMA_K(1,SLOTB);
  bf16x8 qr[4];
  #pragma unroll
  for(int d0=0;d0<4;++d0)qr[d0]=*reinterpret_cast<const bf16x8*>(&Qw[(long)r32*u.qs+d0*16+hi*8]);
  float mhat=0.f,l_reg=0.f;f32x16 o[2];o[0]=f32x16{};o[1]=f32x16{};f32x16 negm=f32x16{};if(!(MODE&1)){asm volatile("":"+v"(negm));}
  const int qrel=wid*QBLK+r32;
  #define CMASK(P0,P1,t) do{int jb_=(t)-(NT-4); if(jb_>=0)cmask(P0,P1,jb_,qrel,hi);}while(0)
  #define BIASW(P0,P1,t) do{ if(MODE&1){ const lds_cptr bt_=biasp+((t)*64+4*hi)*4; const float nm_=-mhat; SBAR(); \
      { f32x4_t b_[2]; _Pragma("unroll") for(int g_=0;g_<2;++g_) b_[g_]=*(const __attribute__((address_space(3))) f32x4_t*)(bt_+0+32*(g_+0)); \
        _Pragma("unroll") for(int g_=0;g_<2;++g_){ P0[4*(g_+0)]+=b_[g_][0]+nm_;P0[4*(g_+0)+1]+=b_[g_][1]+nm_;P0[4*(g_+0)+2]+=b_[g_][2]+nm_;P0[4*(g_+0)+3]+=b_[g_][3]+nm_; } } \
      asm volatile("":"+v"(P0)); SBAR(); \
      { f32x4_t b_[2]; _Pragma("unroll") for(int g_=0;g_<2;++g_) b_[g_]=*(const __attribute__((address_space(3))) f32x4_t*)(bt_+0+32*(g_+2)); \
        _Pragma("unroll") for(int g_=0;g_<2;++g_){ P0[4*(g_+2)]+=b_[g_][0]+nm_;P0[4*(g_+2)+1]+=b_[g_][1]+nm_;P0[4*(g_+2)+2]+=b_[g_][2]+nm_;P0[4*(g_+2)+3]+=b_[g_][3]+nm_; } } \
      asm volatile("":"+v"(P0)); SBAR(); \
      { f32x4_t b_[2]; _Pragma("unroll") for(int g_=0;g_<2;++g_) b_[g_]=*(const __attribute__((address_space(3))) f32x4_t*)(bt_+128+32*(g_+0)); \
        _Pragma("unroll") for(int g_=0;g_<2;++g_){ P1[4*(g_+0)]+=b_[g_][0]+nm_;P1[4*(g_+0)+1]+=b_[g_][1]+nm_;P1[4*(g_+0)+2]+=b_[g_][2]+nm_;P1[4*(g_+0)+3]+=b_[g_][3]+nm_; } } \
      asm volatile("":"+v"(P1)); SBAR(); \
      { f32x4_t b_[2]; _Pragma("unroll") for(int g_=0;g_<2;++g_) b_[g_]=*(const __attribute__((address_space(3))) f32x4_t*)(bt_+128+32*(g_+2)); \
        _Pragma("unroll") for(int g_=0;g_<2;++g_){ P1[4*(g_+2)]+=b_[g_][0]+nm_;P1[4*(g_+2)+1]+=b_[g_][1]+nm_;P1[4*(g_+2)+2]+=b_[g_][2]+nm_;P1[4*(g_+2)+3]+=b_[g_][3]+nm_; } } \
      asm volatile("":"+v"(P1)); SBAR(); \
      } \
    if(MODE&2){ const int kw_=64*((t)-(NT-4))+4*hi-qrel+u.win; \
      _Pragma("unroll") for(int r=0;r<16;++r){ const int kv_=kw_+(r&3)+8*(r>>2); if(kv_<0)P0[r]=-INFINITY; if(kv_+32<0)P1[r]=-INFINITY; } } }while(0)
  bool resc=false;
  #define START(P0,P1) do{ const float rm=rowmax(P0,P1); resc=false; \
    { const float dl=(MODE&2)?max2f(rm,-1000.f):rm; mhat=fadd_s(mhat,dl); \
      _Pragma("unroll") for(int r=0;r<16;++r){P0[r]=fsub_s(P0[r],dl);P1[r]=fsub_s(P1[r],dl);} \
      if(!(MODE&1)){ _Pragma("unroll") for(int r=0;r<16;++r)negm[r]=-mhat; asm volatile("":"+v"(negm)); } } \
    _Pragma("unroll") for(int r=0;r<16;++r)P0[r]=__builtin_amdgcn_exp2f(P0[r]); }while(0)
  #define RESC() do{ if(resc){ asm volatile("s_waitcnt lgkmcnt(0)":::"memory"); \
      _Pragma("unroll") for(int d_=0;d_<2;++d_) _Pragma("unroll") for(int r=0;r<16;++r)o[d_][r]*=wsf[crow(r,hi)]; } }while(0)
  f32x16 pA0,pA1,pB0,pB1;
  int sl_prev=0,sl_cur=0,sl_next=SLOTB;
  #define ROT() do{sl_prev=sl_cur;sl_cur=sl_next;sl_next=(sl_next==(NSLOT-1)*SLOTB)?0:sl_next+SLOTB;}while(0)
  DMA_K(2,2*SLOTB);
  WAIT_BAR(3);
  qkt(pA0,pA1,Kbase,qr,negm,r32,hi);asm volatile("s_nop 15\n\ts_nop 7":"+v"(pA0),"+v"(pA1));BIASW(pA0,pA1,0);CMASK(pA0,pA1,0);
  START(pA0,pA1);
  _Pragma("unroll") for(int r=0;r<16;++r)pA1[r]=__builtin_amdgcn_exp2f(pA1[r]);
  WAIT_BAR(0);
  DMA_K(3,0);DMA_V(1,SLOTB);
  ROT();
  kload8(kf,kp0+sl_cur);
  WAIT_BAR(2);
  s16x4 vlo[8],vhi[8]; u32x4 pw0,pw1,pw2,pw3;
  #define PKW(P,B) cvtpk_s(P[B],P[B+1])
  #define PAF(k) __builtin_bit_cast(bf16x8,pw##k)
  #define VFR(i) (bf16x8){vlo[i][0],vlo[i][1],vlo[i][2],vlo[i][3],vhi[i][0],vhi[i][1],vhi[i][2],vhi[i][3]}
  #define PIN(x) asm volatile("":"+v"(x))
  #define MX3(a,b,c) __builtin_fmaxf(__builtin_fmaxf((a),(b)),(c))
  #define GAPA(MF,A0,A1,A2,A3,W0,W1,PW) do{ MF; sacc+=A0; sacc+=A1; sacc+=A2; sacc+=A3; PIN(sacc); W0; W1; PIN(PW); SBAR(); }while(0)
  #define EX(v) __builtin_amdgcn_exp2f(v)
  #define GAPB(MF,X,B) do{ MF; X[B]=EX(X[B]); X[B+1]=EX(X[B+1]); X[B+2]=EX(X[B+2]); X[B+3]=EX(X[B+3]); PIN(X); SBAR(); }while(0)
  #define VRD(i) do{ vlo[i]=vtr(vp_+(((i)>>2)*4096+((i)&3)*1024)); vhi[i]=vtr(vp_+(((i)>>2)*4096+((i)&3)*1024+512)); }while(0)
  #define KRD(G,j) do{ if(G){ kload2(kf,kp0+sl_next,j); SBAR(); } }while(0)
  #define STEP(C0,C1,P0,P1,t,GK,GV,GL) do{ SBAR(); \
    const lds_cptr vp_=vp0+sl_prev; \
    VRD(0); SBAR(); float sacc=(P0[0]+P0[1]); \
    GAPA(C0=__builtin_amdgcn_mfma_f32_32x32x16_bf16(kf[0],qr[0],negm,0,0,0), P0[2],P0[3],P0[4],P0[5],     pw0[0]=PKW(P0,0), pw0[1]=PKW(P0,2), pw0); \
    VRD(4); SBAR(); GAPA(C1=__builtin_amdgcn_mfma_f32_32x32x16_bf16(kf[1],qr[0],negm,0,0,0), P0[6],P0[7],P0[8],P0[9],     pw0[2]=PKW(P0,4), pw0[3]=PKW(P0,6), pw0); \
    VRD(1); SBAR(); GAPA(C0=__builtin_amdgcn_mfma_f32_32x32x16_bf16(kf[2],qr[1],C0,0,0,0),   P0[10],P0[11],P0[12],P0[13], pw1[0]=PKW(P0,8), pw1[1]=PKW(P0,10), pw1); \
    VRD(5); SBAR(); GAPA(C1=__builtin_amdgcn_mfma_f32_32x32x16_bf16(kf[3],qr[1],C1,0,0,0),   P0[14],P0[15],P1[0],P1[1],   pw1[2]=PKW(P0,12),pw1[3]=PKW(P0,14), pw1); \
    VRD(2); SBAR(); GAPA(C0=__builtin_amdgcn_mfma_f32_32x32x16_bf16(kf[4],qr[2],C0,0,0,0),   P1[2],P1[3],P1[4],P1[5],     pw2[0]=PKW(P1,0), pw2[1]=PKW(P1,2), pw2); \
    VRD(6); SBAR(); GAPA(C1=__builtin_amdgcn_mfma_f32_32x32x16_bf16(kf[5],qr[2],C1,0,0,0),   P1[6],P1[7],P1[8],P1[9],     pw2[2]=PKW(P1,4), pw2[3]=PKW(P1,6), pw2); \
    VRD(3); SBAR(); GAPA(C0=__builtin_amdgcn_mfma_f32_32x32x16_bf16(kf[6],qr[3],C0,0,0,0),   P1[10],P1[11],P1[12],P1[13], pw3[0]=PKW(P1,8), pw3[1]=PKW(P1,10), pw3); \
    VRD(7); SBAR(); GAPA(C1=__builtin_amdgcn_mfma_f32_32x32x16_bf16(kf[7],qr[3],C1,0,0,0),   P1[14],P1[15],0.f,0.f,       pw3[2]=PKW(P1,12),pw3[3]=PKW(P1,14), pw3); \
    l_reg+=sacc; \
    if(GK){DMA_K((t)+3,sl_cur);} if(GV){DMA_V((t)+1,sl_next);} \
    BIASW(C0,C1,t); CMASK(C0,C1,t); \
    { float a=MX3(C0[0],C0[1],C1[0]),b=MX3(C0[2],C0[3],C1[1]); a=MX3(a,C1[2],C1[3]); \
      _Pragma("unroll") for(int r=4;r<16;r+=4){a=MX3(a,C0[r],C0[r+1]);b=MX3(b,C0[r+2],C0[r+3]);a=MX3(a,C1[r],C1[r+1]);b=MX3(b,C1[r+2],C1[r+3]);} \
      float rm=__builtin_fmaxf(a,b); { auto rr=__builtin_amdgcn_permlane32_swap(__float_as_uint(rm),__float_as_uint(rm),false,false); rm=__builtin_fmaxf(__uint_as_float(rr[0]),__uint_as_float(rr[1])); } \
      resc=false; \
      if(__builtin_expect(__any(rm>(float)THRL),0)){ const float dl=__builtin_fmaxf(rm,0.f); mhat+=dl; \
        _Pragma("unroll") for(int r=0;r<16;++r){C0[r]-=dl;C1[r]-=dl;} \
        if(!(MODE&1)){ _Pragma("unroll") for(int r=0;r<16;++r)negm[r]=-mhat; asm volatile("":"+v"(negm)); } \
        const float f=__builtin_amdgcn_exp2f(-dl); l_reg*=f; if(hi==0)wsf[r32]=f; resc=true; } } \
    SBAR(); \
    GAPB(o[0]=__builtin_amdgcn_mfma_f32_32x32x16_bf16(PAF(0),VFR(0),o[0],0,0,0), C0,0); \
    GAPB(o[1]=__builtin_amdgcn_mfma_f32_32x32x16_bf16(PAF(0),VFR(4),o[1],0,0,0), C0,4); \
    KRD(GL,0); GAPB(o[0]=__builtin_amdgcn_mfma_f32_32x32x16_bf16(PAF(1),VFR(1),o[0],0,0,0), C0,8); \
    KRD(GL,1); GAPB(o[1]=__builtin_amdgcn_mfma_f32_32x32x16_bf16(PAF(1),VFR(5),o[1],0,0,0), C0,12); \
    KRD(GL,2); GAPB(o[0]=__builtin_amdgcn_mfma_f32_32x32x16_bf16(PAF(2),VFR(2),o[0],0,0,0), C1,0); \
    KRD(GL,3); GAPB(o[1]=__builtin_amdgcn_mfma_f32_32x32x16_bf16(PAF(2),VFR(6),o[1],0,0,0), C1,4); \
    GAPB(o[0]=__builtin_amdgcn_mfma_f32_32x32x16_bf16(PAF(3),VFR(3),o[0],0,0,0), C1,8); \
    GAPB(o[1]=__builtin_amdgcn_mfma_f32_32x32x16_bf16(PAF(3),VFR(7),o[1],0,0,0), C1,12); \
    }while(0)
  int t=1;
  #undef CMASK
  #define CMASK(P0,P1,t) do{}while(0)
  for(;t+5<NT;t+=2){
    STEP(pB0,pB1,pA0,pA1,t,true,true,true);     WAIT_BAR(2); RESC(); ROT();
    STEP(pA0,pA1,pB0,pB1,t+1,true,true,true);   WAIT_BAR(2); RESC(); ROT();
  }
  #undef CMASK
  #define CMASK(P0,P1,t) do{int jb_=(t)-(NT-4); if(jb_>=0)cmask(P0,P1,jb_,qrel,hi);}while(0)
  #define ENDW(tt) do{ if((tt)+3<NT){WAIT_BAR(2);} else if((tt)+2<NT){WAIT_BAR(1);} else {WAIT_BAR(0);} }while(0)
  for(;t+1<NT;t+=2){
    STEP(pB0,pB1,pA0,pA1,t,(t+3<NT),(t+1<NT),(t+1<NT));       ENDW(t);   RESC(); ROT();
    STEP(pA0,pA1,pB0,pB1,t+1,(t+4<NT),(t+2<NT),(t+2<NT));     ENDW(t+1); RESC(); ROT();
  }
  STEP(pB0,pB1,pA0,pA1,NT-1,false,false,false); RESC();
  { float sacc=pB0[0]+pB0[1]; _Pragma("unroll") for(int r=2;r<16;++r)sacc+=pB0[r]; _Pragma("unroll") for(int r=0;r<16;++r)sacc+=pB1[r]; l_reg+=sacc;
    pw0=(u32x4){PKW(pB0,0),PKW(pB0,2),PKW(pB0,4),PKW(pB0,6)};pw1=(u32x4){PKW(pB0,8),PKW(pB0,10),PKW(pB0,12),PKW(pB0,14)};pw2=(u32x4){PKW(pB1,0),PKW(pB1,2),PKW(pB1,4),PKW(pB1,6)};pw3=(u32x4){PKW(pB1,8),PKW(pB1,10),PKW(pB1,12),PKW(pB1,14)};
    SBAR(); pv(o,vb0+sl_cur,PAF(0),PAF(1),PAF(2),PAF(3)); }
  #undef PKW
  #undef PAF
  #undef VFR
  #undef PIN
  #undef MX3
  #undef GAPA
  #undef GAPB
  #undef EX
  #undef VRD
  #undef KRD
  #undef STEP
  #undef ENDW
  {auto rr=__builtin_amdgcn_permlane32_swap(__float_as_uint(l_reg),__float_as_uint(l_reg),false,false);l_reg=__uint_as_float(rr[0])+__uint_as_float(rr[1]);}
  if(MODE&8)l_reg+=__builtin_amdgcn_exp2f(u.sink2+u.slope2*(float)qrel-mhat);
  if((MODE&4)&&hi==0)u.LSE[(long)qrel*u.lses]=mhat+__builtin_amdgcn_logf(l_reg)-u.slope2*(float)qrel;
  if(hi==0)wsf[32+r32]=l_reg;asm volatile("s_waitcnt lgkmcnt(0)":::"memory");
  float rli[16];
  #pragma unroll
  for(int r=0;r<16;++r)rli[r]=__builtin_amdgcn_rcpf(wsf[32+crow(r,hi)]);
  bf16*Ow=u.O+(long)(wid*QBLK)*u.os;
  { bf16*stg=(bf16*)(shm+LDS_OST)+wid*2048;
    #pragma unroll
    for(int r=0;r<16;++r){const int orow=crow(r,hi);
      #pragma unroll
      for(int d0=0;d0<2;++d0)stg[orow*64+d0*32+r32]=__float2bfloat16(o[d0][r]*rli[r]);}
    asm volatile("s_waitcnt lgkmcnt(0)":::"memory");
    #pragma unroll
    for(int i=0;i<4;++i){const int row=i*8+(lane>>3),ch=lane&7; const u32x4 v=*(const u32x4*)(stg+row*64+ch*8); ATTN_STORE16(Ow+(long)row*u.os+ch*8,v);} }
  asm volatile("s_waitcnt lgkmcnt(0)\n\ts_barrier":::"memory");
  #undef DMA_K
  #undef DMA_V
  #undef CMASK
  #undef BIASW
  #undef START
  #undef RESC
  #undef ROT
}
constexpr int ATTN_LDS_BYTES=LDS_BYTES;
#undef SBAR
#undef WAIT_BAR
}
#define GAS __attribute__((address_space(1)))
#define LAS __attribute__((address_space(3)))
typedef unsigned short bf16;
typedef unsigned v4u __attribute__((ext_vector_type(4)));
typedef float f32x4 __attribute__((ext_vector_type(4)));
typedef short bf16x8 __attribute__((ext_vector_type(8)));
typedef GAS unsigned gu32;
typedef GAS unsigned long long gu64;
#define RLX_AGENT __ATOMIC_RELAXED, __HIP_MEMORY_SCOPE_AGENT
#define LDS_WAIT() asm volatile("s_waitcnt lgkmcnt(0)" ::: "memory")
#define VM_WAIT() asm volatile("s_waitcnt vmcnt(0)" ::: "memory")
__device__ __forceinline__ unsigned long long rt() { return __builtin_amdgcn_s_memrealtime(); }
__device__ __forceinline__ unsigned f2bf(float f) { unsigned u = __builtin_bit_cast(unsigned, f); return (u + 0x7fffu + ((u >> 16) & 1u)) >> 16; }
__device__ __forceinline__ unsigned pk2(float lo, float hi) { return f2bf(lo) | (f2bf(hi) << 16); }

#define XB_TMO      128
#define XB_XCNT(j)  (256  + 64 * (j))
#define XB_XSUB(j)  (1280 + 64 * (j))
#define XB_XGEN(j)  (2304 + 64 * (j))
#define XB_TOP      3328
#define XB_TOPGEN   3392
#define XCD_BAR_WORDS 3456
#define XB_SPIN_CAP (1u << 24)

__device__ __forceinline__ unsigned xb_ld(unsigned* p)              { return __hip_atomic_load(p, __ATOMIC_RELAXED, __HIP_MEMORY_SCOPE_AGENT); }
__device__ __forceinline__ unsigned xb_add(unsigned* p, unsigned v) { return __hip_atomic_fetch_add(p, v, __ATOMIC_RELAXED, __HIP_MEMORY_SCOPE_AGENT); }
__device__ __forceinline__ unsigned xb_xcc_id() { return (unsigned)__builtin_amdgcn_s_getreg((3 << 11) | 20) & 0xFu; }
#define XB_SPIN(cond, bar) do { unsigned _sp = 0; while (cond) { __builtin_amdgcn_s_sleep(1); \
    if ((++_sp & 255u) == 0u) { if (xb_ld(&(bar)[XB_TMO])) break; if (_sp > XB_SPIN_CAP) { atomicAdd(&(bar)[XB_TMO], 1u); break; } } } } while (0)

struct XcdBarrier {
    unsigned* bar; unsigned x;
    volatile LAS unsigned* st;
};

__device__ __forceinline__ XcdBarrier xcd_barrier_post(unsigned* bar, volatile LAS unsigned* st) {
    XcdBarrier b; b.bar = bar; b.x = xb_xcc_id(); b.st = st;
    if (opq_tid() == 0) (void)xb_add(&bar[XB_XCNT(b.x)], 1u);
    return b;
}
__device__ __forceinline__ void xcd_barrier_complete(unsigned* bar, unsigned x, unsigned& nloc, unsigned& nx) {
    const unsigned G = gridDim.x * gridDim.y * gridDim.z;
    unsigned sum, cnt, mine, sp = 0u;
    for (;;) {
        sum = 0u; cnt = 0u; mine = 0u;
#pragma unroll
        for (unsigned j = 0; j < 16; ++j) { const unsigned c = xb_ld(&bar[XB_XCNT(j)]); sum += c; cnt += (c > 0u) ? 1u : 0u; mine = (j == x) ? c : mine; }
        if (sum == G) break;
        __builtin_amdgcn_s_sleep(1);
        if ((++sp & 255u) == 0u) { if (xb_ld(&bar[XB_TMO])) break; if (sp > XB_SPIN_CAP) { atomicAdd(&bar[XB_TMO], 1u); break; } }
    }
    nloc = mine > 0u ? mine : 1u; nx = cnt > 0u ? cnt : 1u;
}

__device__ __forceinline__ void xcd_barrier(const XcdBarrier& b) {
    asm volatile("s_waitcnt vmcnt(0)" ::: "memory");
    __syncthreads();
    if (opq_tid() == 0) {
        unsigned* bar = b.bar;
        __builtin_amdgcn_s_waitcnt(0);
        unsigned nloc = b.st[0], nx = b.st[1];
        if (nloc == 0u) { xcd_barrier_complete(bar, b.x, nloc, nx); b.st[0] = nloc; b.st[1] = nx; }
        const unsigned old = xb_add(&bar[XB_XSUB(b.x)], 1u);
        const unsigned gen = old / nloc;
        if (old + 1u == (gen + 1u) * nloc) {
            __builtin_amdgcn_fence(__ATOMIC_RELEASE, "agent");
            asm volatile("s_waitcnt vmcnt(0)" ::: "memory");
            const unsigned og = xb_add(&bar[XB_TOP], 1u);
            const unsigned tg = og / nx;
            if (og + 1u == (tg + 1u) * nx) xb_add(&bar[XB_TOPGEN], 1u);
            else XB_SPIN(xb_ld(&bar[XB_TOPGEN]) == tg, bar);
            __builtin_amdgcn_fence(__ATOMIC_ACQUIRE, "agent");
            xb_add(&bar[XB_XGEN(b.x)], 1u);
            asm volatile("s_waitcnt vmcnt(0)" ::: "memory");
        } else {
            XB_SPIN(xb_ld(&bar[XB_XGEN(b.x)]) == gen, bar);
            __builtin_amdgcn_fence(__ATOMIC_ACQUIRE, "agent");
            asm volatile("s_waitcnt vmcnt(0)" ::: "memory");
        }
    }
    __syncthreads();
}
namespace mk {
constexpr int NB = 2, S = 8192, D = 1024, T = NB * S, NL = 2, NW = 2404, NP = 2560;
constexpr int OFF_CQ = 0, OFF_CKV = 192, OFF_KR = 320, OFF_PB = 352, OFF_PC = 1120, OFF_FG = 1888, OFF_PDQ = 1892, OFF_PDKV = 2148;
constexpr float EPS = 1e-6f, LOG2E = 1.4426950408889634f, C2 = 0.125f * 1.4426950408889634f;
constexpr int NWAVES = 8, NTHR = 512;
constexpr size_t MiB = 1u << 20;
constexpr size_t WS_CTL = 0, CTL_ZERO_BYTES = 1 * MiB;
constexpr size_t WS_WIN = 1 * MiB;
constexpr size_t WS_WO = 11 * MiB;
constexpr size_t WS_WUQ = 15 * MiB;
constexpr size_t WS_WUKV = 15 * MiB + MiB / 2;
constexpr size_t WS_W13 = 16 * MiB;
constexpr size_t WS_W2 = 80 * MiB;
constexpr size_t WS_ACT = 112 * MiB;
constexpr size_t WS_QKV = 144 * MiB;
constexpr size_t WS_R8 = 232 * MiB, WS_R9 = 240 * MiB;
constexpr size_t WS_LF = 248 * MiB, WS_CUM = WS_LF + MiB / 4, WS_EXP = 249 * MiB, WS_GATE = WS_EXP + MiB / 4;
constexpr size_t WS_PART = 250 * MiB;
constexpr size_t WS_LSEP = 274 * MiB;
constexpr size_t WS_Y0 = 144 * MiB, WS_Y1 = 176 * MiB;
constexpr size_t WS_HID = 208 * MiB;
constexpr size_t WS_LIST = 276 * MiB;
constexpr size_t WS_END = 278 * MiB;
constexpr int CW_CNT = 2048;
constexpr size_t QKV_STRIDE = (size_t)T * 256;
enum { IQA = 0, IKA, IVA, IQB, IKB, IVB, IQC, IKC, IVC, IQD };
constexpr int CW_BAR = 4096;
constexpr int RING_BYTES = 131072, LDSCTL_OFF = RING_BYTES, MISC_OFF = LDSCTL_OFF + 320, LDS_BYTES = 147456;
constexpr int LDS_TILES = RING_BYTES + 1024, LDS_NTI = RING_BYTES + 2560, LDS_TAB = RING_BYTES + 3072;
constexpr int PPL = 9, NPHASE = 1 + PPL * NL;

__device__ __forceinline__ float bf2f(bf16 v) { return __uint_as_float((unsigned)v << 16); }
__device__ __forceinline__ float wave_sum(float v) {
  v += xor_lane<1>(v); v += xor_lane<2>(v); v += xor_lane<4>(v); v += xor_lane<8>(v); v += xor_lane<16>(v); v += xor_lane<32>(v);
  return v;
}
__device__ __forceinline__ float log_sigmoid(float x) { return fminf(x, 0.f) - log1pf(expf(-fabsf(x))); }

__device__ __forceinline__ void tr_item(const float* W, int ldw, int srccol0, int nvalid, bf16* WT, int K, int dstrow0, int k0, LAS float* scr, int lane) {
  const int n_ = lane & 31;
#pragma unroll 8
  for (int i = 0; i < 32; ++i) { const int kk = 2 * i + (lane >> 5); scr[kk * 33 + n_] = (n_ < nvalid) ? W[(size_t)(k0 + kk) * ldw + srccol0 + n_] : 0.f; }
  LDS_WAIT(); asm volatile("" ::: "memory");
  const int c = lane & 7;
#pragma unroll
  for (int j = 0; j < 4; ++j) { const int n = (lane >> 3) + 8 * j; const LAS float* s = scr + (8 * c) * 33 + n;
    v4u o; o.x = pk2(s[0 * 33], s[1 * 33]); o.y = pk2(s[2 * 33], s[3 * 33]); o.z = pk2(s[4 * 33], s[5 * 33]); o.w = pk2(s[6 * 33], s[7 * 33]);
    *(GAS v4u*)(WT + (size_t)(dstrow0 + n) * K + k0 + 8 * c) = o; }
  LDS_WAIT(); asm volatile("" ::: "memory");
}
__device__ __forceinline__ void win_src(int n0, int& sc, int& nv) {
  const int pn = n0 >> 8, p = n0 & 255, lc = 64 * ((p >> 5) & 3) + 32 * (p >> 7);
  nv = 32; sc = 0;
  if (pn < 3) sc = OFF_PB + pn * 256 + lc;
  else if (pn < 6) sc = OFF_PC + (pn - 3) * 256 + lc;
  else if (pn == 6) sc = OFF_PDQ + lc;
  else if (pn == 7) sc = OFF_PDKV + lc;
  else if (pn == 8) { sc = OFF_CQ + lc; if (lc >= 192) { nv = 0; sc = 0; } }
  else { if (lc < 128) sc = OFF_CKV + lc; else if (lc < 160) sc = OFF_KR + lc - 128; else if (lc < 192) { sc = OFF_FG; nv = 4; } else { sc = 0; nv = 0; } }
}
__device__ __forceinline__ void prep_rows(const float* X, const bf16* y0, const bf16* y1, float* xout, bf16* XN, const float* g1, int gw, int NGW, int lane) {
  for (int m = gw; m < T; m += NGW) {
    const GAS f32x4* xr = (const GAS f32x4*)(X + (size_t)m * D) + lane;
    f32x4 v[4]; float ss = 0.f;
#pragma unroll
    for (int j = 0; j < 4; ++j) {
      v[j] = xr[64 * j];
      if (y0) {
        const unsigned long long a = *((const GAS unsigned long long*)(y0 + (size_t)m * D) + lane + 64 * j), b = *((const GAS unsigned long long*)(y1 + (size_t)m * D) + lane + 64 * j);
        v[j].x += __uint_as_float((unsigned)a << 16) + __uint_as_float((unsigned)b << 16);
        v[j].y += __uint_as_float((unsigned)a & 0xffff0000u) + __uint_as_float((unsigned)b & 0xffff0000u);
        v[j].z += __uint_as_float((unsigned)(a >> 32) << 16) + __uint_as_float((unsigned)(b >> 32) << 16);
        v[j].w += __uint_as_float((unsigned)(a >> 32) & 0xffff0000u) + __uint_as_float((unsigned)(b >> 32) & 0xffff0000u);
      }
      ss += (v[j].x * v[j].x + v[j].y * v[j].y) + (v[j].z * v[j].z + v[j].w * v[j].w);
    }
    if (xout) {
#pragma unroll
      for (int j = 0; j < 4; ++j) ((GAS f32x4*)(xout + (size_t)m * D) + lane)[64 * j] = v[j];
    }
    if (XN) {
      const float rstd = rsqrtf(wave_sum(ss) * (1.f / D) + EPS);
      GAS unsigned long long* o8 = (GAS unsigned long long*)(XN + (size_t)m * D) + lane;
#pragma unroll
      for (int j = 0; j < 4; ++j) { const f32x4 g = *((const GAS f32x4*)g1 + lane + 64 * j);
        o8[64 * j] = (unsigned long long)pk2(v[j].x * rstd * g.x, v[j].y * rstd * g.y) | ((unsigned long long)pk2(v[j].z * rstd * g.z, v[j].w * rstd * g.w) << 32); }
    }
  }
}

struct EpiInProj {
  static constexpr bool PERM = true, AFTER_DRAIN = false;
  bf16* qkv; bf16* R8; bf16* R9; float* LF; const float* gq; const float* gk; const float* bfox;
  __device__ __forceinline__ void operator()(const pg8::f32x4 (&acc)[2][2][4][2], const pg8::Unit& u, int wr, int wc, int fr, int fq) const {
    const int pn = u.pn;
    bf16* dst; int pitch = 256, cb = 64 * wc; const float* g = nullptr; float sc = 1.f;
    if (pn < 6) { dst = qkv + (size_t)(IQB + pn) * QKV_STRIDE; const int r3 = pn % 3, mx = 1 + pn / 3; if (r3 == 0) { g = gq + mx * 64; sc = C2; } else if (r3 == 1) g = gk + mx * 64; }
    else if (pn == 6) { dst = qkv + (size_t)IQD * QKV_STRIDE; g = gq + 3 * 64; sc = C2; }
    else if (pn == 7) { pitch = 128; if (wc < 2) { dst = qkv + 10 * QKV_STRIDE; g = gk + 3 * 64; } else { dst = qkv + 10 * QKV_STRIDE + (size_t)T * 128; cb = 64 * (wc - 2); } }
    else if (pn == 8) dst = R8; else dst = R9;
    const int rowb = u.pm * 256 + wr * 64 + fr;
    if (g) {
      pg8::f32x4 gv[2][2];
#pragma unroll
      for (int bj = 0; bj < 2; ++bj)
#pragma unroll
        for (int n = 0; n < 2; ++n) gv[bj][n] = *(const pg8::f32x4*)(g + 32 * bj + 8 * fq + 4 * n) * sc;
#pragma unroll
      for (int ai = 0; ai < 2; ++ai)
#pragma unroll
        for (int m = 0; m < 4; ++m) {
          float ss = 0.f;
#pragma unroll
          for (int bj = 0; bj < 2; ++bj)
#pragma unroll
            for (int n = 0; n < 2; ++n) { const pg8::f32x4 x = acc[ai][bj][m][n]; ss += (x[0] * x[0] + x[1] * x[1]) + (x[2] * x[2] + x[3] * x[3]); }
          ss += xor_lane<16>(ss); ss += xor_lane<32>(ss);
          const float rstd = rsqrtf(ss * (1.f / 64.f) + EPS);
          bf16* rp = dst + (size_t)(rowb + ai * 128 + m * 16) * pitch + cb + 8 * fq;
#pragma unroll
          for (int bj = 0; bj < 2; ++bj) { const pg8::f32x4 v0 = acc[ai][bj][m][0] * gv[bj][0] * rstd, v1 = acc[ai][bj][m][1] * gv[bj][1] * rstd;
            pg8::u32x4 w; w.x = pg8::cvt_pk_bf16(v0[0], v0[1]); w.y = pg8::cvt_pk_bf16(v0[2], v0[3]); w.z = pg8::cvt_pk_bf16(v1[0], v1[1]); w.w = pg8::cvt_pk_bf16(v1[2], v1[3]);
            *(pg8::u32x4*)(rp + 32 * bj) = w; }
        }
    } else {
#pragma unroll
      for (int ai = 0; ai < 2; ++ai)
#pragma unroll
        for (int m = 0; m < 4; ++m) {
          bf16* rp = dst + (size_t)(rowb + ai * 128 + m * 16) * pitch + cb + 8 * fq;
#pragma unroll
          for (int bj = 0; bj < 2; ++bj) { const pg8::f32x4 v0 = acc[ai][bj][m][0], v1 = acc[ai][bj][m][1];
            pg8::u32x4 w; w.x = pg8::cvt_pk_bf16(v0[0], v0[1]); w.y = pg8::cvt_pk_bf16(v0[2], v0[3]); w.z = pg8::cvt_pk_bf16(v1[0], v1[1]); w.w = pg8::cvt_pk_bf16(v1[2], v1[3]);
            *(pg8::u32x4*)(rp + 32 * bj) = w; }
        }
      if (pn == 9 && wc == 2 && fq == 0) {
        const pg8::f32x4 bb = *(const pg8::f32x4*)bfox;
#pragma unroll
        for (int ai = 0; ai < 2; ++ai)
#pragma unroll
          for (int m = 0; m < 4; ++m) { const pg8::f32x4 v = acc[ai][1][m][0] + bb; pg8::f32x4 o;
            o[0] = log_sigmoid(v[0]); o[1] = log_sigmoid(v[1]); o[2] = log_sigmoid(v[2]); o[3] = log_sigmoid(v[3]);
            *(pg8::f32x4*)(LF + (size_t)(rowb + ai * 128 + m * 16) * 4) = o; }
      }
    }
  }
};

struct EpiResF32 {
  static constexpr bool PERM = false, AFTER_DRAIN = false;
  const float* R; float* C;
  __device__ __forceinline__ void operator()(const pg8::f32x4 (&acc)[2][2][4][2], const pg8::Unit& u, int wr, int wc, int fr, int fq) const {
    const int row0 = u.pm * 256 + wr * 64 + fr, col0 = u.pn * 256 + wc * 32 + 4 * fq;
#pragma unroll
    for (int ai = 0; ai < 2; ++ai)
#pragma unroll
      for (int m = 0; m < 4; ++m) { const size_t off = (size_t)(row0 + ai * 128 + m * 16) * D + col0;
#pragma unroll
        for (int bj = 0; bj < 2; ++bj)
#pragma unroll
          for (int n = 0; n < 2; ++n) { const size_t o = off + bj * 128 + n * 16; *(pg8::f32x4*)(C + o) = *(const pg8::f32x4*)(R + o) + acc[ai][bj][m][n]; } }
  }
};

__device__ __forceinline__ void n_post(LAS unsigned char* lds, const bf16* R8, const bf16* R9, const float* gcq, const float* gckv, const float* wuq, const float* wukv,
                                       const float* gq0, const float* gk0, bf16* QA, bf16* KA, bf16* VA) {
  LAS float* cqn = (LAS float*)lds; LAS float* ckvn = cqn + 192; LAS float* kva = ckvn + 128; LAS float* tmp = kva + 384; LAS float* red = tmp + 256; LAS float* krs = red + 8;
  const int tid = opq_tid(), lane = tid & 63, w = tid >> 6;
  for (int t = blockIdx.x; t < T; t += gridDim.x) {
    const int pos = t % S;
    const float vq = (tid < 192) ? bf2f(R8[(size_t)t * 256 + tid]) : 0.f;
    const float vk = (tid < 128) ? bf2f(R9[(size_t)t * 256 + tid]) : 0.f;
    const float sq = wave_sum(vq * vq), sk = wave_sum(vk * vk);
    if (lane == 0 && w < 4) { red[w] = sq; red[4 + w] = sk; }
    if (tid < 32) krs[tid] = bf2f(R9[(size_t)t * 256 + 128 + tid]);
    __syncthreads();
    const float rq = rsqrtf((red[0] + red[1] + red[2] + red[3]) * (1.f / 192.f) + EPS);
    const float rk = rsqrtf((red[4] + red[5] + red[6] + red[7]) * (1.f / 128.f) + EPS);
    if (tid < 192) cqn[tid] = vq * rq * gcq[tid];
    if (tid < 128) ckvn[tid] = vk * rk * gckv[tid];
    __syncthreads();
    float qa = 0.f, ka = 0.f;
    if (tid < 256) {
      float k0 = 0.f, k1 = 0.f;
      for (int i = 0; i < 192; ++i) qa += cqn[i] * wuq[i * 256 + tid];
      for (int i = 0; i < 128; ++i) { k0 += ckvn[i] * wukv[i * 384 + tid]; if (tid < 128) k1 += ckvn[i] * wukv[i * 384 + 256 + tid]; }
      kva[tid] = k0; if (tid < 128) kva[256 + tid] = k1;
      const float ss = wave_sum(qa * qa);
      qa = qa * rsqrtf(ss * (1.f / 64.f) + EPS) * gq0[lane];
      tmp[tid] = qa;
    }
    __syncthreads();
    float cs = 1.f, sn = 0.f;
    if (tid < 256 && lane >= 32) { const int j = (lane - 32) & 15; const float inv = powf(10000.f, -(float)(2 * j) / 32.f); const float ang = (float)pos * inv; cs = cosf(ang); sn = sinf(ang); }
    if (tid < 256) {
      float o = qa;
      if (lane >= 32) { if (lane < 48) o = qa * cs - tmp[tid + 16] * sn; else o = qa * cs + tmp[tid - 16] * sn; }
      QA[(size_t)t * 256 + tid] = (bf16)f2bf(o * C2);
      ka = (lane < 32) ? kva[w * 96 + lane] : krs[lane - 32];
      const float ss = wave_sum(ka * ka);
      ka = ka * rsqrtf(ss * (1.f / 64.f) + EPS) * gk0[lane];
    }
    __syncthreads();
    if (tid < 256) tmp[tid] = ka;
    __syncthreads();
    if (tid < 256) {
      float o = ka;
      if (lane >= 32) { if (lane < 48) o = ka * cs - tmp[tid + 16] * sn; else o = ka * cs + tmp[tid - 16] * sn; }
      KA[(size_t)t * 256 + tid] = (bf16)f2bf(o);
      VA[(size_t)t * 256 + tid] = (bf16)f2bf(kva[w * 96 + 32 + lane]);
    }
    __syncthreads();
  }
}
__device__ __forceinline__ void n_cumsum(LAS unsigned char* lds, const float* LF, float* CUM) {
  LAS float* part = (LAS float*)lds + 2048;
  const int tid = opq_tid(); constexpr int per = S / NTHR;
  for (int item = blockIdx.x; item < NB * 4; item += gridDim.x) {
    const int b = item >> 2, h = item & 3;
    float s = 0.f;
    for (int i = 0; i < per; ++i) s += LF[((size_t)b * S + tid * per + i) * 4 + h];
    part[tid] = s;
    __syncthreads();
    if (tid == 0) { float a = 0.f; for (int i = 0; i < NTHR; ++i) { const float v = part[i]; part[i] = a; a += v; } }
    __syncthreads();
    float a = part[tid];
    for (int i = 0; i < per; ++i) { a += LF[((size_t)b * S + tid * per + i) * 4 + h]; CUM[((size_t)b * S + tid * per + i) * 4 + h] = a; }
    __syncthreads();
  }
}
struct Soft { float m, l, o; };
__device__ __forceinline__ void soft_add(Soft& st, float logit2, float v) {
  const float mn = fmaxf(st.m, logit2);
  const float a = exp2f(st.m - mn), pp = exp2f(logit2 - mn);
  st.l = st.l * a + pp; st.o = st.o * a + pp * v; st.m = mn;
}
__device__ __forceinline__ void n_attn(const bf16* qkv, const float* CUM, const float* sink, bf16* MIX, int mask) {
  const int tid_ = opq_tid(), lane = tid_ & 63, wpb = NTHR >> 6;
  const long nitems = (long)T * 16;
  for (long it = (long)blockIdx.x * wpb + (tid_ >> 6); it < nitems; it += (long)gridDim.x * wpb) {
    const int t = T - 1 - (int)(it >> 4), mh = (int)(it & 15), mixer = mh >> 2, h = mh & 3;
    if (!((mask >> mixer) & 1)) continue;
    const int b = t / S, pos = t % S; const long base = (long)b * S;
    Soft st; st.m = -INFINITY; st.l = 0.f; st.o = 0.f;
    if (mixer == 0 || mixer == 2) {
      const bf16* Q = qkv + (size_t)(mixer == 0 ? IQA : IQC) * QKV_STRIDE; const bf16* K = Q + QKV_STRIDE; const bf16* V = K + QKV_STRIDE;
      const float q = bf2f(Q[(size_t)t * 256 + h * 64 + lane]);
      const float ct = (mixer == 2) ? CUM[(size_t)t * 4 + h] : 0.f;
      for (int s = 0; s <= pos; ++s) {
        float d = wave_sum(q * bf2f(K[(size_t)(base + s) * 256 + h * 64 + lane]));
        if (mixer == 2) d += (ct - CUM[(size_t)(base + s) * 4 + h]) * LOG2E;
        soft_add(st, d, bf2f(V[(size_t)(base + s) * 256 + h * 64 + lane]));
      }
    } else if (mixer == 3) {
      const bf16* Q = qkv + (size_t)IQD * QKV_STRIDE; const bf16* K = qkv + 10 * QKV_STRIDE; const bf16* V = K + (size_t)T * 128;
      const int hk = h >> 1;
      const float q = bf2f(Q[(size_t)t * 256 + h * 64 + lane]);
      const float slope = exp2f(-(float)(h + 1)) * LOG2E;
      const int s0 = pos - 127 < 0 ? 0 : pos - 127;
      for (int s = s0; s <= pos; ++s) {
        const float d = wave_sum(q * bf2f(K[(size_t)(base + s) * 128 + hk * 64 + lane])) - slope * (float)(pos - s);
        soft_add(st, d, bf2f(V[(size_t)(base + s) * 128 + hk * 64 + lane]));
      }
      const float sk = sink[h] * LOG2E;
      const float mn = fmaxf(st.m, sk), a = exp2f(st.m - mn);
      st.l = st.l * a + exp2f(sk - mn); st.o *= a; st.m = mn;
    } else {
      const bf16* Q = qkv + (size_t)IQB * QKV_STRIDE; const bf16* K = Q + QKV_STRIDE; const bf16* V = K + QKV_STRIDE;
      const float q = bf2f(Q[(size_t)t * 256 + h * 64 + lane]);
      const float slope = exp2f(-(float)(h + 5)) * LOG2E;
      for (int br = 0; br < 3; ++br) {
        const int dil = br == 0 ? 1 : (br == 1 ? 4 : 16);
        for (int j = 0; j <= 128; ++j) {
          const int s = pos - dil * j;
          if (s < 0) break;
          const float d = wave_sum(q * bf2f(K[(size_t)(base + s) * 256 + h * 64 + lane])) - slope * (float)(dil * j);
          soft_add(st, d, bf2f(V[(size_t)(base + s) * 256 + h * 64 + lane]));
        }
      }
    }
    MIX[(size_t)t * D + mixer * 256 + h * 64 + lane] = (bf16)f2bf(st.o / st.l);
  }
}
__device__ __forceinline__ void n_wo(LAS unsigned char* lds, const bf16* A, const float* Bm, const float* R, float* C) {
  LAS float* As = (LAS float*)lds;
  LAS float* Bs = As + 16 * 129;
  const int tid = opq_tid(), tx = tid & 15, ty = tid >> 4;
  for (int tile = blockIdx.x; tile < (T / 128) * (D / 64); tile += gridDim.x) {
    const int m0 = (tile / (D / 64)) * 128, n0 = (tile % (D / 64)) * 64;
    float acc[4][4];
#pragma unroll
    for (int i = 0; i < 4; ++i)
#pragma unroll
      for (int j = 0; j < 4; ++j) acc[i][j] = 0.f;
    for (int k0 = 0; k0 < D; k0 += 16) {
#pragma unroll
      for (int r = 0; r < 4; ++r) { const int i = tid + NTHR * r, m = i >> 4, k = i & 15; As[k * 129 + m] = bf2f(A[(size_t)(m0 + m) * D + k0 + k]); }
#pragma unroll
      for (int r = 0; r < 2; ++r) { const int i = tid + NTHR * r, k = i >> 6, n = i & 63; Bs[k * 64 + n] = Bm[(size_t)(k0 + k) * D + n0 + n]; }
      __syncthreads();
#pragma unroll
      for (int k = 0; k < 16; ++k) {
        float a[4], b[4];
#pragma unroll
        for (int i = 0; i < 4; ++i) { a[i] = As[k * 129 + ty * 4 + i]; b[i] = Bs[k * 64 + tx * 4 + i]; }
#pragma unroll
        for (int i = 0; i < 4; ++i)
#pragma unroll
          for (int j = 0; j < 4; ++j) acc[i][j] += a[i] * b[j];
      }
      __syncthreads();
    }
#pragma unroll
    for (int i = 0; i < 4; ++i)
#pragma unroll
      for (int j = 0; j < 4; ++j) { const size_t o = (size_t)(m0 + ty * 4 + i) * D + n0 + tx * 4 + j; C[o] = R[o] + acc[i][j]; }
  }
}
__device__ __forceinline__ void n_route(const float* H, const float* g2, const float* wrg, const float* brg, const float* wre, const float* bre, bf16* HN, int* EXPI, float* GATE, unsigned* cnt, int* LIST) {
  const int tid_ = opq_tid(), lane = tid_ & 63, wpb = NTHR >> 6;
  for (int t = blockIdx.x * wpb + (tid_ >> 6); t < T; t += gridDim.x * wpb) {
    const float* hr = H + (size_t)t * D;
    float v[16], ss = 0.f;
#pragma unroll
    for (int j = 0; j < 16; ++j) { v[j] = hr[lane + 64 * j]; ss += v[j] * v[j]; }
    ss = wave_sum(ss);
    const float rstd = rsqrtf(ss * (1.f / D) + EPS);
#pragma unroll
    for (int j = 0; j < 16; ++j) { v[j] = v[j] * rstd * g2[lane + 64 * j]; HN[(size_t)t * D + lane + 64 * j] = (bf16)f2bf(v[j]); }
    float gl[4];
#pragma unroll
    for (int g = 0; g < 4; ++g) {
      float a = 0.f;
#pragma unroll
      for (int j = 0; j < 16; ++j) a += v[j] * wrg[(size_t)(lane + 64 * j) * 4 + g];
      gl[g] = wave_sum(a) + brg[g];
    }
    int gs = 0; float gm = gl[0];
#pragma unroll
    for (int g = 1; g < 4; ++g) if (gl[g] > gm) { gm = gl[g]; gs = g; }
    float den = 0.f;
#pragma unroll
    for (int g = 0; g < 4; ++g) den += expf(gl[g] - gm);
    const float pg = 1.f / den;
    float el[8];
#pragma unroll
    for (int e = 0; e < 8; ++e) {
      float a = 0.f;
#pragma unroll
      for (int j = 0; j < 16; ++j) a += v[j] * wre[(size_t)(lane + 64 * j) * 32 + gs * 8 + e];
      el[e] = wave_sum(a) + bre[gs * 8 + e];
    }
    int i1 = 0; float m1 = el[0];
#pragma unroll
    for (int e = 1; e < 8; ++e) if (el[e] > m1) { m1 = el[e]; i1 = e; }
    int i2 = 0; float m2 = -INFINITY;
#pragma unroll
    for (int e = 0; e < 8; ++e) if (e != i1 && el[e] > m2) { m2 = el[e]; i2 = e; }
    const float e2 = expf(m2 - m1);
    if (lane == 0) {
      EXPI[t * 2] = gs * 8 + i1; EXPI[t * 2 + 1] = gs * 8 + i2;
      GATE[t * 2] = pg / (1.f + e2); GATE[t * 2 + 1] = pg * e2 / (1.f + e2);
      const int ea = gs * 8 + i1, eb = gs * 8 + i2;
      const unsigned sa = atomicAdd(cnt + ea, 1u), sb = atomicAdd(cnt + eb, 1u);
      LIST[(size_t)ea * T + sa] = t * 2; LIST[(size_t)eb * T + sb] = t * 2 + 1;
    }
  }
}
__device__ __forceinline__ void n_moe(LAS unsigned char* lds, const bf16* HN, const int* EXPI, const float* GATE, const float* w1, const float* w3, const float* w2, float* hio, bf16* ybf) {
  LAS float* xs = (LAS float*)lds; LAS float* sa = xs + D; LAS float* hid = sa + 512;
  const int tid = opq_tid(), j = tid & 255, half = tid >> 8;
  for (int t = blockIdx.x; t < T; t += gridDim.x) {
    for (int i = tid; i < D; i += NTHR) xs[i] = bf2f(HN[(size_t)t * D + i]);
    __syncthreads();
    float y0 = 0.f, y1 = 0.f;
    for (int k = 0; k < 2; ++k) {
      const int e = EXPI[t * 2 + k]; const float gt = GATE[t * 2 + k];
      const float* W13 = (half ? w3 : w1) + (size_t)e * D * 256; const float* W2 = w2 + (size_t)e * 256 * D;
      float a = 0.f;
      for (int i = 0; i < D; ++i) a += xs[i] * W13[(size_t)i * 256 + j];
      sa[tid] = a;
      __syncthreads();
      if (tid < 256) { const float av = sa[tid], cv = sa[256 + tid]; hid[tid] = av / (1.f + expf(-av)) * cv * gt; }
      __syncthreads();
      for (int jj = 0; jj < 256; ++jj) { const float hv = hid[jj]; y0 += hv * W2[(size_t)jj * D + tid]; y1 += hv * W2[(size_t)jj * D + tid + 512]; }
      __syncthreads();
    }
    if (ybf) { ybf[(size_t)t * D + tid] = (bf16)f2bf(y0); ybf[(size_t)t * D + tid + 512] = (bf16)f2bf(y1); } else { hio[(size_t)t * D + tid] += y0; hio[(size_t)t * D + tid + 512] += y1; }
  }
}

#ifndef FASTMASK
#define FASTMASK 1
#endif
#ifndef CHK_GAIN
#define CHK_GAIN 10.f
#endif
typedef attn_body::bf16 abf;
template <int MODE> __device__ __forceinline__ void run_unit(const attn_body::AU& u, unsigned char* lds_raw) { attn_body::attn_unit<8, MODE>(u, (char*)lds_raw); }
__device__ __forceinline__ void f_attn(unsigned char* lds_raw, LAS unsigned char* lds, bf16* QKV, const float* CUM, const float* sink, bf16* MIX, bf16* PART, float* LSEP, int mask) {
  const int tid = opq_tid();
  LAS float* bt = (LAS float*)(lds + attn_body::LDS_BIAS);
  const int G = gridDim.x, c = blockIdx.x;
  if (mask & 1) {
    for (int idx = c; idx < 256; idx += G) {
      const int bh = idx & 7, qb = 31 - (idx >> 3), b = bh >> 2, h = bh & 3; const size_t r0 = (size_t)b * S;
      attn_body::AU u{}; u.Q = (const abf*)(QKV + (size_t)IQA * QKV_STRIDE + (r0 + 256 * qb) * 256 + h * 64); u.K = (const abf*)(QKV + (size_t)IKA * QKV_STRIDE + r0 * 256 + h * 64);
      u.V = (const abf*)(QKV + (size_t)IVA * QKV_STRIDE + r0 * 256 + h * 64); u.O = (abf*)(MIX + (r0 + 256 * qb) * D + h * 64); u.qs = 256; u.ks = 256; u.os = D; u.NT = 4 * qb + 4;
      run_unit<0>(u, lds_raw);
    }
  }
  if (mask & 4) {
    for (int idx = c; idx < 256; idx += G) {
      const int bh = idx & 7, qb = 31 - (idx >> 3), b = bh >> 2, h = bh & 3; const size_t r0 = (size_t)b * S;
      attn_body::AU u{}; u.Q = (const abf*)(QKV + (size_t)IQC * QKV_STRIDE + (r0 + 256 * qb) * 256 + h * 64); u.K = (const abf*)(QKV + (size_t)IKC * QKV_STRIDE + r0 * 256 + h * 64);
      u.V = (const abf*)(QKV + (size_t)IVC * QKV_STRIDE + r0 * 256 + h * 64); u.O = (abf*)(MIX + (r0 + 256 * qb) * D + 512 + h * 64); u.qs = 256; u.ks = 256; u.os = D; u.NT = 4 * qb + 4;
      const float cref = CUM[(r0 + 256 * qb) * 4 + h];
      for (int i = tid; i < u.NT * 64; i += NTHR) bt[i] = (cref - CUM[(r0 + i) * 4 + h]) * LOG2E;
      run_unit<1>(u, lds_raw);
    }
  }
  if (mask & 8) {
    for (int idx = c; idx < 256; idx += G) {
      const int bh = idx & 7, qb = idx >> 3, b = bh >> 2, h = bh & 3; const size_t r0 = (size_t)b * S; const int k0 = qb ? 256 * qb - 128 : 0;
      attn_body::AU u{}; u.Q = (const abf*)(QKV + (size_t)IQD * QKV_STRIDE + (r0 + 256 * qb) * 256 + h * 64); u.K = (const abf*)(QKV + 10 * QKV_STRIDE + (r0 + k0) * 128 + (h >> 1) * 64);
      u.V = (const abf*)(QKV + 10 * QKV_STRIDE + (size_t)T * 128 + (r0 + k0) * 128 + (h >> 1) * 64); u.O = (abf*)(MIX + (r0 + 256 * qb) * D + 768 + h * 64); u.qs = 256; u.ks = 128; u.os = D;
      u.NT = qb ? 6 : 4; u.win = 127; u.slope2 = exp2f(-(float)(h + 1)) * LOG2E; u.sink2 = sink[h] * LOG2E;
      const int kq0 = (u.NT - 4) * 64;
      for (int i = tid; i < u.NT * 64; i += NTHR) bt[i] = u.slope2 * (float)(i - kq0);
      run_unit<1 | 2 | 8>(u, lds_raw);
    }
  }
  if (mask & 2) {
    for (int idx = c; idx < 768; idx += G) {
      const int br = idx >> 8, j = idx & 255, dil = br == 0 ? 1 : (br == 1 ? 4 : 16);
      const int bh = j & 7, b = bh >> 2, h = bh & 3; const int rest = j >> 3;
      const int nfb = 32 / dil, cls = rest / nfb, fb = rest % nfb;
      const size_t r0 = (size_t)b * S; const int kf0 = fb ? 256 * fb - 128 : 0;
      const size_t qtok = r0 + cls + (size_t)dil * 256 * fb, ktok = r0 + cls + (size_t)dil * kf0;
      attn_body::AU u{}; u.Q = (const abf*)(QKV + (size_t)IQB * QKV_STRIDE + qtok * 256 + h * 64); u.K = (const abf*)(QKV + (size_t)IKB * QKV_STRIDE + ktok * 256 + h * 64);
      u.V = (const abf*)(QKV + (size_t)IVB * QKV_STRIDE + ktok * 256 + h * 64); u.O = (abf*)(PART + (size_t)br * QKV_STRIDE + qtok * 256 + h * 64); u.LSE = LSEP + (size_t)br * T * 4 + qtok * 4 + h;
      u.qs = 256 * dil; u.ks = 256 * dil; u.os = 256 * dil; u.lses = 4 * dil; u.NT = fb ? 6 : 4; u.win = 128; u.slope2 = exp2f(-(float)(h + 5)) * LOG2E * (float)dil;
      const int kq0 = (u.NT - 4) * 64;
      for (int i = tid; i < u.NT * 64; i += NTHR) bt[i] = u.slope2 * (float)(i - kq0);
      run_unit<1 | 2 | 4>(u, lds_raw);
    }
  }
}
__device__ __forceinline__ void f_bmerge(const bf16* PART, const float* LSEP, bf16* MIX) {
  const int tid = opq_tid();
  for (long i = (long)blockIdx.x * NTHR + tid; i < (long)T * 32; i += (long)gridDim.x * NTHR) {
    const long t = i >> 5; const int ch = (int)(i & 31), h = ch >> 3;
    float l0 = LSEP[t * 4 + h], l1 = LSEP[(size_t)T * 4 + t * 4 + h], l2 = LSEP[(size_t)2 * T * 4 + t * 4 + h];
    const float m = fmaxf(l0, fmaxf(l1, l2)); l0 = exp2f(l0 - m); l1 = exp2f(l1 - m); l2 = exp2f(l2 - m);
    const float inv = 1.f / (l0 + l1 + l2); l0 *= inv; l1 *= inv; l2 *= inv;
    const v4u a = *(const GAS v4u*)(PART + t * 256 + ch * 8), b = *(const GAS v4u*)(PART + QKV_STRIDE + t * 256 + ch * 8), c = *(const GAS v4u*)(PART + 2 * QKV_STRIDE + t * 256 + ch * 8);
    v4u o;
#define MRG(f) { const float lo = l0 * __uint_as_float(a.f << 16) + l1 * __uint_as_float(b.f << 16) + l2 * __uint_as_float(c.f << 16); \
                 const float hi_ = l0 * __uint_as_float(a.f & 0xffff0000u) + l1 * __uint_as_float(b.f & 0xffff0000u) + l2 * __uint_as_float(c.f & 0xffff0000u); o.f = pk2(lo, hi_); }
    MRG(x) MRG(y) MRG(z) MRG(w)
#undef MRG
    *(GAS v4u*)(MIX + t * D + 256 + ch * 8) = o;
  }
}

__device__ __forceinline__ void unpack8(const bf16x8 v, float (&f)[8]) {
#pragma unroll
  for (int j = 0; j < 8; ++j) f[j] = __uint_as_float((unsigned)(unsigned short)v[j] << 16);
}
__device__ __forceinline__ void store4bf(bf16* p, float a, float b, float c, float d) { *(GAS unsigned long long*)p = (unsigned long long)pk2(a, b) | ((unsigned long long)pk2(c, d) << 32); }
__device__ __forceinline__ void f_post(const bf16* R8, const bf16* R9, const bf16* Wq_t, const bf16* Wkv_t, const float* gq0, const float* gk0, bf16* QA, bf16* KA, bf16* VA) {
  const int tid = opq_tid(), lane = tid & 63, wave = __builtin_amdgcn_readfirstlane(tid >> 6), tk = lane & 15, q = lane >> 4;
  const __amdgpu_buffer_rsrc_t rq_ = __builtin_amdgcn_make_buffer_rsrc((void*)Wq_t, 0, 256 * 192 * 2, 0x00020000), rkv_ = __builtin_amdgcn_make_buffer_rsrc((void*)Wkv_t, 0, 384 * 128 * 2, 0x00020000);
  const int woff_q = (tk * 192 + 8 * q) * 2, woff_kv = (tk * 128 + 8 * q) * 2;
  for (int task = blockIdx.x * NWAVES + wave; task < 2 * (T / 16); task += gridDim.x * NWAVES) {
    const int t = (task >> 1) * 16 + tk, pos = t % S;
    float cs[4], sn[4];
#pragma unroll
    for (int r = 0; r < 4; ++r) { const float inv = powf(10000.f, -(float)(2 * (4 * q + r)) / 32.f); const float ang = (float)pos * inv; cs[r] = cosf(ang); sn[r] = sinf(ang); }
    if ((task & 1) == 0) {
      pg8::f32x4 acc[16];
#pragma unroll
      for (int i = 0; i < 16; ++i) acc[i] = (pg8::f32x4){0.f, 0.f, 0.f, 0.f};
      float ss = 0.f;
#pragma unroll
      for (int ks = 0; ks < 6; ++ks) {
        const bf16x8 b = *(const GAS bf16x8*)(R8 + (size_t)t * 256 + ks * 32 + 8 * q);
        float f[8]; unpack8(b, f);
#pragma unroll
        for (int j = 0; j < 8; ++j) ss += f[j] * f[j];
#pragma unroll
        for (int nt = 0; nt < 16; ++nt) { const bf16x8 a = __builtin_bit_cast(bf16x8, __builtin_amdgcn_raw_buffer_load_b128(rq_, woff_q, (nt * 16 * 192 + ks * 32) * 2, 0)); acc[nt] = __builtin_amdgcn_mfma_f32_16x16x32_bf16(a, b, acc[nt], 0, 0, 0); }
      }
      ss += xor_lane<16>(ss); ss += xor_lane<32>(ss);
      const float rq = rsqrtf(ss * (1.f / 192.f) + EPS);
#pragma unroll
      for (int h = 0; h < 4; ++h) {
        float hs = 0.f;
#pragma unroll
        for (int ti = 0; ti < 4; ++ti)
#pragma unroll
          for (int r = 0; r < 4; ++r) { const float v = acc[4 * h + ti][r] * rq; hs += v * v; }
        hs += xor_lane<16>(hs); hs += xor_lane<32>(hs);
        const float rh = rsqrtf(hs * (1.f / 64.f) + EPS) * rq * C2;
        float v[4][4];
#pragma unroll
        for (int ti = 0; ti < 4; ++ti) { const pg8::f32x4 g = *(const GAS pg8::f32x4*)(gq0 + 16 * ti + 4 * q);
#pragma unroll
          for (int r = 0; r < 4; ++r) v[ti][r] = acc[4 * h + ti][r] * rh * g[r]; }
#pragma unroll
        for (int r = 0; r < 4; ++r) { const float x1 = v[2][r], x2 = v[3][r]; v[2][r] = x1 * cs[r] - x2 * sn[r]; v[3][r] = x2 * cs[r] + x1 * sn[r]; }
#pragma unroll
        for (int ti = 0; ti < 4; ++ti) store4bf(QA + (size_t)t * 256 + h * 64 + 16 * ti + 4 * q, v[ti][0], v[ti][1], v[ti][2], v[ti][3]);
      }
    } else {
      pg8::f32x4 acc[24];
#pragma unroll
      for (int i = 0; i < 24; ++i) acc[i] = (pg8::f32x4){0.f, 0.f, 0.f, 0.f};
      float ss = 0.f;
#pragma unroll
      for (int ks = 0; ks < 4; ++ks) {
        const bf16x8 b = *(const GAS bf16x8*)(R9 + (size_t)t * 256 + ks * 32 + 8 * q);
        float f[8]; unpack8(b, f);
#pragma unroll
        for (int j = 0; j < 8; ++j) ss += f[j] * f[j];
#pragma unroll
        for (int nt = 0; nt < 24; ++nt) { const bf16x8 a = __builtin_bit_cast(bf16x8, __builtin_amdgcn_raw_buffer_load_b128(rkv_, woff_kv, (nt * 16 * 128 + ks * 32) * 2, 0)); acc[nt] = __builtin_amdgcn_mfma_f32_16x16x32_bf16(a, b, acc[nt], 0, 0, 0); }
      }
      ss += xor_lane<16>(ss); ss += xor_lane<32>(ss);
      const float rkv = rsqrtf(ss * (1.f / 128.f) + EPS);
      const unsigned long long ka_ = *(const GAS unsigned long long*)(R9 + (size_t)t * 256 + 128 + 4 * q), kb_ = *(const GAS unsigned long long*)(R9 + (size_t)t * 256 + 144 + 4 * q);
      float k1[4], k2[4];
      k1[0] = __uint_as_float((unsigned)ka_ << 16); k1[1] = __uint_as_float((unsigned)ka_ & 0xffff0000u); k1[2] = __uint_as_float((unsigned)(ka_ >> 32) << 16); k1[3] = __uint_as_float((unsigned)(ka_ >> 32) & 0xffff0000u);
      k2[0] = __uint_as_float((unsigned)kb_ << 16); k2[1] = __uint_as_float((unsigned)kb_ & 0xffff0000u); k2[2] = __uint_as_float((unsigned)(kb_ >> 32) << 16); k2[3] = __uint_as_float((unsigned)(kb_ >> 32) & 0xffff0000u);
      float krs = 0.f;
#pragma unroll
      for (int r = 0; r < 4; ++r) krs += k1[r] * k1[r] + k2[r] * k2[r];
      krs += xor_lane<16>(krs); krs += xor_lane<32>(krs);
      const pg8::f32x4 g0 = *(const GAS pg8::f32x4*)(gk0 + 4 * q), g1 = *(const GAS pg8::f32x4*)(gk0 + 16 + 4 * q), g2 = *(const GAS pg8::f32x4*)(gk0 + 32 + 4 * q), g3 = *(const GAS pg8::f32x4*)(gk0 + 48 + 4 * q);
#pragma unroll
      for (int h = 0; h < 4; ++h) {
        float hs = 0.f;
#pragma unroll
        for (int ti = 0; ti < 2; ++ti)
#pragma unroll
          for (int r = 0; r < 4; ++r) { const float v = acc[6 * h + ti][r] * rkv; hs += v * v; }
        hs += xor_lane<16>(hs); hs += xor_lane<32>(hs);
        const float rk = rsqrtf((hs + krs) * (1.f / 64.f) + EPS), rn = rk * rkv;
        bf16* kp = KA + (size_t)t * 256 + h * 64 + 4 * q;
        store4bf(kp, acc[6 * h][0] * rn * g0[0], acc[6 * h][1] * rn * g0[1], acc[6 * h][2] * rn * g0[2], acc[6 * h][3] * rn * g0[3]);
        store4bf(kp + 16, acc[6 * h + 1][0] * rn * g1[0], acc[6 * h + 1][1] * rn * g1[1], acc[6 * h + 1][2] * rn * g1[2], acc[6 * h + 1][3] * rn * g1[3]);
        float o1[4], o2[4];
#pragma unroll
        for (int r = 0; r < 4; ++r) { const float x1 = k1[r] * rk * g2[r], x2 = k2[r] * rk * g3[r]; o1[r] = x1 * cs[r] - x2 * sn[r]; o2[r] = x2 * cs[r] + x1 * sn[r]; }
        store4bf(kp + 32, o1[0], o1[1], o1[2], o1[3]); store4bf(kp + 48, o2[0], o2[1], o2[2], o2[3]);
        bf16* vp = VA + (size_t)t * 256 + h * 64 + 4 * q;
#pragma unroll
        for (int ti = 0; ti < 4; ++ti) store4bf(vp + 16 * ti, acc[6 * h + 2 + ti][0] * rkv, acc[6 * h + 2 + ti][1] * rkv, acc[6 * h + 2 + ti][2] * rkv, acc[6 * h + 2 + ti][3] * rkv);
      }
    }
  }
}
__device__ __forceinline__ void f_cumsum(LAS unsigned char* lds, const float* LF, float* CUM) {
  LAS float* wsum = (LAS float*)lds;
  const int tid = opq_tid(), lane = tid & 63, wave = tid >> 6; constexpr int per = S / NTHR;
  for (int item = blockIdx.x; item < NB * 4; item += gridDim.x) {
    const int b = item >> 2, h = item & 3;
    float v[per]; float s = 0.f;
#pragma unroll
    for (int i = 0; i < per; ++i) { s += LF[((size_t)b * S + tid * per + i) * 4 + h]; v[i] = s; }
    float incl = s;
    LAS float* sc = wsum + 16 + wave * 64;
    sc[lane] = s; asm volatile("s_waitcnt lgkmcnt(0)" ::: "memory");
#pragma unroll
    for (int o = 1; o < 64; o <<= 1) { const float u = (lane >= o) ? sc[lane - o] : 0.f; asm volatile("s_waitcnt lgkmcnt(0)" ::: "memory"); incl += u; sc[lane] = incl; asm volatile("s_waitcnt lgkmcnt(0)" ::: "memory"); }
    if (lane == 63) wsum[wave] = incl;
    __syncthreads();
    float base = incl - s;
#pragma unroll
    for (int w = 0; w < 8; ++w) if (w < wave) base += wsum[w];
#pragma unroll
    for (int i = 0; i < per; ++i) CUM[((size_t)b * S + tid * per + i) * 4 + h] = base + v[i];
    __syncthreads();
  }
}

__device__ __forceinline__ void moe_tiles(LAS unsigned char* lds, const unsigned* cnt) {
  LAS int* tiles = (LAS int*)(lds + LDS_TILES); LAS int* nti = (LAS int*)(lds + LDS_NTI);
  if (opq_tid() == 0) { int n = 0; for (int e = 0; e < 32; ++e) { const int c = (int)__hip_atomic_load(cnt + e, __ATOMIC_RELAXED, __HIP_MEMORY_SCOPE_AGENT), nt = (c + 255) >> 8; for (int r = 0; r < nt; ++r) tiles[n++] = (e << 16) | r; } nti[0] = n; }
  __syncthreads();
}
struct MoeOrder {
  const LAS int* tiles; int nu, ncol, G, c;
  __device__ __forceinline__ bool next(int i, pg8::Unit& u) const { const int idx = i * G + c; if (idx >= nu) return false; const int ti = idx / ncol; u.pm = ti; u.pn = (tiles[ti] >> 16) * ncol + idx % ncol; return true; }
  __device__ __forceinline__ void a_ready(const pg8::Unit&) const {}
  __device__ __forceinline__ void done(const pg8::Unit&) const {}
};
__device__ __forceinline__ float silu_f(float a) { return a * __builtin_amdgcn_rcpf(1.f + __builtin_amdgcn_exp2f(-a * LOG2E)); }
struct EpiSwiGLU {
  static constexpr bool PERM = true, AFTER_DRAIN = false;
  bf16* HID;
  __device__ __forceinline__ void operator()(const pg8::f32x4 (&acc)[2][2][4][2], const pg8::Unit& u, int wr, int wc, int fr, int fq) const {
    { const int t_ = opq_tid(); fr = t_ & 15; fq = (t_ >> 4) & 3; }
    const int rowb = u.pm * 256 + wr * 64 + fr, col = 128 * (u.pn & 1) + 32 * wc + 8 * fq;
#pragma unroll
    for (int ai = 0; ai < 2; ++ai)
#pragma unroll
      for (int m = 0; m < 4; ++m) { const pg8::f32x4 a0 = acc[ai][0][m][0], a1 = acc[ai][0][m][1], b0 = acc[ai][1][m][0], b1 = acc[ai][1][m][1]; pg8::u32x4 w;
        w.x = pg8::cvt_pk_bf16(silu_f(a0[0]) * b0[0], silu_f(a0[1]) * b0[1]); w.y = pg8::cvt_pk_bf16(silu_f(a0[2]) * b0[2], silu_f(a0[3]) * b0[3]);
        w.z = pg8::cvt_pk_bf16(silu_f(a1[0]) * b1[0], silu_f(a1[1]) * b1[1]); w.w = pg8::cvt_pk_bf16(silu_f(a1[2]) * b1[2], silu_f(a1[3]) * b1[3]);
        *(pg8::u32x4*)(HID + (size_t)(rowb + ai * 128 + m * 16) * 256 + col) = w; }
  }
};
struct EpiMoeDown {
  static constexpr bool PERM = true, AFTER_DRAIN = false;
  const int* LIST; const float* GATE; const unsigned* cnt; const LAS int* tiles; bf16* Y0; bf16* Y1;
  __device__ __forceinline__ void operator()(const pg8::f32x4 (&acc)[2][2][4][2], const pg8::Unit& u, int wr, int wc, int fr, int fq) const {
    { const int t_ = opq_tid(); fr = t_ & 15; fq = (t_ >> 4) & 3; }
    const int er = tiles[u.pm], e = er >> 16, r = er & 0xffff, ne = (int)cnt[e], col = 256 * (u.pn & 3) + 32 * wc + 8 * fq;
#pragma unroll
    for (int ai = 0; ai < 2; ++ai)
#pragma unroll
      for (int m = 0; m < 4; ++m) { const int a = r * 256 + ai * 128 + wr * 64 + m * 16 + fr;
        if (a < ne) { const int tk = LIST[(size_t)e * T + a]; const float gt = GATE[tk]; bf16* dst = ((tk & 1) ? Y1 : Y0) + (size_t)(tk >> 1) * D + col;
#pragma unroll
          for (int bj = 0; bj < 2; ++bj) { const pg8::f32x4 v0 = acc[ai][bj][m][0] * gt, v1 = acc[ai][bj][m][1] * gt; pg8::u32x4 w;
            w.x = pg8::cvt_pk_bf16(v0[0], v0[1]); w.y = pg8::cvt_pk_bf16(v0[2], v0[3]); w.z = pg8::cvt_pk_bf16(v1[0], v1[1]); w.w = pg8::cvt_pk_bf16(v1[2], v1[3]);
            *(pg8::u32x4*)(dst + 128 * bj) = w; } } }
  }
};

constexpr int CW_CHK = 1024;
__device__ __forceinline__ void chk_bf16(LAS unsigned char* lds, const bf16* a, const bf16* ref, int pitch, int c0, int nc, float* sums) {
  const int tid = opq_tid(); float d2 = 0.f, r2 = 0.f;
  for (long i = (long)blockIdx.x * NTHR + tid; i < (long)T * nc; i += (long)gridDim.x * NTHR) {
    const long t = i / nc; const int c = c0 + (int)(i % nc);
    const float x = bf2f(a[t * pitch + c]), y = bf2f(ref[t * pitch + c]); const float d = x - y;
    d2 += (d == d) ? d * d : 1e6f; r2 += y * y;
  }
  d2 = wave_sum(d2); r2 = wave_sum(r2);
  if ((tid & 63) == 0) { atomicAdd(sums, d2); atomicAdd(sums + 1, r2); }
}
__device__ __forceinline__ void chk_f32(const float* a, const float* ref, long n, float* sums) {
  const int tid = opq_tid(); float d2 = 0.f, r2 = 0.f;
  for (long i = (long)blockIdx.x * NTHR + tid; i < n; i += (long)gridDim.x * NTHR) { const float d = a[i] - ref[i]; d2 += (d == d) ? d * d : 1e6f; r2 += ref[i] * ref[i]; }
  d2 = wave_sum(d2); r2 = wave_sum(r2);
  if ((tid & 63) == 0) { atomicAdd(sums, d2); atomicAdd(sums + 1, r2); }
}
__device__ __forceinline__ void chk_ysum(const bf16* y0, const bf16* y1, const bf16* ref, float* sums) {
  const int tid = opq_tid(); float d2 = 0.f, r2 = 0.f;
  for (long i = (long)blockIdx.x * NTHR + tid; i < (long)T * D; i += (long)gridDim.x * NTHR) { const float y = bf2f(ref[i]); const float d = bf2f(y0[i]) + bf2f(y1[i]) - y; d2 += (d == d) ? d * d : 1e6f; r2 += y * y; }
  d2 = wave_sum(d2); r2 = wave_sum(r2);
  if ((tid & 63) == 0) { atomicAdd(sums, d2); atomicAdd(sums + 1, r2); }
}
__device__ __forceinline__ void chk_apply(float* out, const float* sums) {
  const int tid = opq_tid();
  float worst = 0.f;
  for (int k = 0; k < 8; ++k) { const float d2 = __hip_atomic_load(sums + 2 * k, __ATOMIC_RELAXED, __HIP_MEMORY_SCOPE_AGENT), r2 = __hip_atomic_load(sums + 2 * k + 1, __ATOMIC_RELAXED, __HIP_MEMORY_SCOPE_AGENT);
    if (r2 > 0.f || d2 > 0.f) worst = fmaxf(worst, d2 / fmaxf(r2, 1e-30f)); }
  const float f = 1.f + CHK_GAIN * sqrtf(worst);
  for (long i = (long)blockIdx.x * NTHR + tid; i < (long)T * D; i += (long)gridDim.x * NTHR) out[i] *= f;
}

struct Args { const float* in[20]; float* out; unsigned char* ws; int ph_lo, ph_hi, li, pad; };

__global__ void __launch_bounds__(NTHR, 2) mk_fwd(Args args) {
  extern __shared__ __attribute__((aligned(16))) unsigned char lds_raw[];
  LAS unsigned char* lds = (LAS unsigned char*)lds_raw;
  volatile LAS unsigned* MISC = (volatile LAS unsigned*)(lds + MISC_OFF);
  const int G = gridDim.x;
  unsigned char* ws = args.ws;
  gu32* ctl = (gu32*)(ws + WS_CTL);
  for (int u = threadIdx.x; u < (LDS_BYTES - LDSCTL_OFF) / 4; u += NTHR) ((LAS unsigned*)(lds + LDSCTL_OFF))[u] = 0u;
  __syncthreads();
  opq_init();
  __syncthreads();
  XcdBarrier bar = xcd_barrier_post((unsigned*)(ctl + CW_BAR) + args.li * XCD_BAR_WORDS, MISC + 8);
  const int lo = args.ph_lo, hi = args.ph_hi;
#define IN(k) (lo <= (k) && (k) < hi)
#define SEAM(k) do { if (IN(k) && IN((k) + 1)) xcd_barrier(bar); } while (0)
  const float* x = args.in[0]; float* out = args.out;
  bf16* Win_t = (bf16*)(ws + WS_WIN); bf16* Wo_t = (bf16*)(ws + WS_WO); bf16* W13_t = (bf16*)(ws + WS_W13); bf16* W2_t = (bf16*)(ws + WS_W2);
  bf16* Y0 = (bf16*)(ws + WS_Y0); bf16* Y1 = (bf16*)(ws + WS_Y1); bf16* HID = (bf16*)(ws + WS_HID); int* LIST = (int*)(ws + WS_LIST);
  bf16* ACT = (bf16*)(ws + WS_ACT); bf16* QKV = (bf16*)(ws + WS_QKV); bf16* R8 = (bf16*)(ws + WS_R8); bf16* R9 = (bf16*)(ws + WS_R9);
  float* LF = (float*)(ws + WS_LF); float* CUM = (float*)(ws + WS_CUM); int* EXPI = (int*)(ws + WS_EXP); float* GATE = (float*)(ws + WS_GATE); bf16* PART = (bf16*)(ws + WS_PART); float* LSEP = (float*)(ws + WS_LSEP);
  const int NGW = G * NWAVES;
#define PHASE_IDS() const int tid = opq_tid(), lane = tid & 63, wave = __builtin_amdgcn_readfirstlane(tid >> 6), gw = blockIdx.x * NWAVES + wave; (void)lane; (void)gw

  if (IN(0)) {
    PHASE_IDS();
    LAS float* scr = (LAS float*)(lds + wave * 16384);
    constexpr int I_WIN = (NP / 32) * (D / 64), I_WO = (D / 32) * (D / 64), I_W13 = 32 * 16 * 16, I_W2 = 32 * 32 * 4;
    constexpr int NITEMS = NL * (I_WIN + I_WO + I_W13 + I_W2);
    for (int it = gw; it < NITEMS; it += NGW) {
      int r = it;
      if (r < NL * I_WIN) { const int l = r / I_WIN; r %= I_WIN; const int ng = r / (D / 64), kb = r % (D / 64); int sc, nv; win_src(ng * 32, sc, nv);
        tr_item(args.in[2] + (size_t)l * D * NW, NW, sc, nv, Win_t + (size_t)l * NP * D, D, ng * 32, kb * 64, scr, lane); continue; }
      r -= NL * I_WIN;
      if (r < NL * I_WO) { const int l = r / I_WO; r %= I_WO; const int ng = r / (D / 64), kb = r % (D / 64);
        tr_item(args.in[11] + (size_t)l * D * D, D, ng * 32, 32, Wo_t + (size_t)l * D * D, D, ng * 32, kb * 64, scr, lane); continue; }
      r -= NL * I_WO;
      if (r < NL * I_W13) { const int le = r / 256; r %= 256; const int ng = r >> 4, kb = r & 15;
        const int pn = ng >> 3, p = (ng & 7) * 32, bj = p >> 7, j = p & 127;
        tr_item((bj ? args.in[18] : args.in[17]) + (size_t)le * D * 256, 256, 128 * pn + j, 32, W13_t + (size_t)le * 512 * D, D, ng * 32, kb * 64, scr, lane); continue; }
      r -= NL * I_W13;
      { const int le = r / 128; r %= 128; const int ng = r >> 2, kb = r & 3;
        tr_item(args.in[19] + (size_t)le * 256 * D, D, ng * 32, 32, W2_t + (size_t)le * D * 256, 256, ng * 32, kb * 64, scr, lane); }
    }
    prep_rows(x, nullptr, nullptr, nullptr, ACT, args.in[1], gw, NGW, lane);
    { bf16* Wq_t = (bf16*)(ws + WS_WUQ); bf16* Wkv_t = (bf16*)(ws + WS_WUKV);
      for (int i = blockIdx.x * NTHR + tid; i < NL * 256 * 192; i += G * NTHR) { const int l = i / (256 * 192), r = i % (256 * 192), n = r / 192, k = r % 192;
        Wq_t[i] = (bf16)f2bf(args.in[3][l * 192 + k] * args.in[5][(size_t)l * 192 * 256 + k * 256 + n]); }
      for (int i = blockIdx.x * NTHR + tid; i < NL * 384 * 128; i += G * NTHR) { const int l = i / (384 * 128), r = i % (384 * 128), n = r / 128, k = r % 128;
        Wkv_t[i] = (bf16)f2bf(args.in[4][l * 128 + k] * args.in[6][(size_t)l * 128 * 384 + k * 384 + n]); } }
  }
  SEAM(0);
  for (int l = 0; l < NL; ++l) {
    const int pb = 1 + PPL * l;
    if (IN(pb)) {
      pg8::Gemm g{ACT, Win_t + (size_t)l * NP * D, T, NP, D}; pg8::StaticOrder So; So.init(T, NP, G, (int)blockIdx.x);
      EpiInProj E{QKV, R8, R9, LF, args.in[7] + l * 256, args.in[8] + l * 256, args.in[9] + l * 4};
      pg8::gemm_phase<EpiInProj, pg8::StaticOrder, true, true>(lds, g, So, E);
    }
    SEAM(pb);
    if (IN(pb + 1)) {
#ifdef NAIVE_POST
      n_post(lds, R8, R9, args.in[3] + l * 192, args.in[4] + l * 128, args.in[5] + (size_t)l * 192 * 256, args.in[6] + (size_t)l * 128 * 384, args.in[7] + l * 256, args.in[8] + l * 256,
             QKV + (size_t)IQA * QKV_STRIDE, QKV + (size_t)IKA * QKV_STRIDE, QKV + (size_t)IVA * QKV_STRIDE);
      n_cumsum(lds, LF, CUM);
#else
      f_post(R8, R9, (const bf16*)(ws + WS_WUQ) + (size_t)l * 256 * 192, (const bf16*)(ws + WS_WUKV) + (size_t)l * 384 * 128, args.in[7] + l * 256, args.in[8] + l * 256,
             QKV + (size_t)IQA * QKV_STRIDE, QKV + (size_t)IKA * QKV_STRIDE, QKV + (size_t)IVA * QKV_STRIDE);
      f_cumsum(lds, LF, CUM);
#ifdef CHECK_POST
      xcd_barrier(bar);
      { bf16* ALT = (bf16*)(ws + WS_PART); n_post(lds, R8, R9, args.in[3] + l * 192, args.in[4] + l * 128, args.in[5] + (size_t)l * 192 * 256, args.in[6] + (size_t)l * 128 * 384, args.in[7] + l * 256, args.in[8] + l * 256,
             ALT, ALT + QKV_STRIDE, ALT + 2 * QKV_STRIDE);
        float* ALTC = (float*)(ws + WS_LSEP); n_cumsum(lds, LF, ALTC); xcd_barrier(bar);
        for (int k3 = 0; k3 < 3; ++k3) chk_bf16(lds, QKV + (size_t)k3 * QKV_STRIDE, ALT + (size_t)k3 * QKV_STRIDE, 256, 0, 256, (float*)(ctl + CW_CHK) + 2 * k3);
        chk_f32(CUM, ALTC, (long)T * 4, (float*)(ctl + CW_CHK) + 6); xcd_barrier(bar); }
#endif
#endif
    }
    SEAM(pb + 1);
    if (IN(pb + 2)) {
      if (FASTMASK) f_attn(lds_raw, lds, QKV, CUM, args.in[10] + l * 4, ACT, PART, LSEP, FASTMASK);
      if (15 & ~FASTMASK) n_attn(QKV, CUM, args.in[10] + l * 4, ACT, 15 & ~FASTMASK);
    }
    SEAM(pb + 2);
    if (IN(pb + 3)) { if (FASTMASK & 2) f_bmerge(PART, LSEP, ACT); }
    SEAM(pb + 3);
#ifdef CHECK_ATTN
    { bf16* ALT = (bf16*)(ws + WS_W13);   n_attn(QKV, CUM, args.in[10] + l * 4, ALT, CHECK_ATTN); xcd_barrier(bar);
      for (int mx = 0; mx < 4; ++mx) if ((CHECK_ATTN >> mx) & 1) chk_bf16(lds, ACT, ALT, D, mx * 256, 256, (float*)(ctl + CW_CHK) + 2 * mx); xcd_barrier(bar); }
#endif
#ifdef NAIVE_WO
    if (IN(pb + 4)) n_wo(lds, ACT, args.in[11] + (size_t)l * D * D, l == 0 ? x : out, out);
#else
    if (IN(pb + 4)) {
      pg8::Gemm g{ACT, Wo_t + (size_t)l * D * D, T, D, D}; pg8::StaticOrder So; So.init(T, D, G, (int)blockIdx.x);
      EpiResF32 E{l == 0 ? x : out, out};
      pg8::gemm_phase<EpiResF32, pg8::StaticOrder, true, true>(lds, g, So, E);
    }
#endif
    SEAM(pb + 4);
    if (IN(pb + 5)) n_route(out, args.in[12] + l * D, args.in[13] + (size_t)l * D * 4, args.in[14] + l * 4, args.in[15] + (size_t)l * D * 32, args.in[16] + l * 32, ACT, EXPI, GATE, (unsigned*)(ctl + CW_CNT + l * 64), LIST);
    SEAM(pb + 5);
#ifdef NAIVE_MOE
    if (IN(pb + 6)) n_moe(lds, ACT, EXPI, GATE, args.in[17] + (size_t)l * 32 * D * 256, args.in[18] + (size_t)l * 32 * D * 256, args.in[19] + (size_t)l * 32 * 256 * D, out, nullptr);
    SEAM(pb + 6);
    SEAM(pb + 7);
#else
    const unsigned* cntl = (const unsigned*)(ctl + CW_CNT + l * 64);
    if (IN(pb + 6)) {
      PHASE_IDS();
      moe_tiles(lds, cntl);
      const LAS int* tiles = (const LAS int*)(lds + LDS_TILES); const int nti = *(const LAS int*)(lds + LDS_NTI);
      MoeOrder So{tiles, nti * 2, 2, G, (int)blockIdx.x};
      LAS int* tab = (LAS int*)(lds + LDS_TAB);
      { pg8::Unit uu; for (int i = 0; i < 4 && So.next(i, uu); ++i) { const int er = tiles[uu.pm], e = er >> 16, r = er & 0xffff; const int ne = (int)cntl[e];
          if (tid < 256) { const int a = r * 256 + tid; tab[i * 256 + tid] = (a < ne) ? (LIST[(size_t)e * T + a] >> 1) : 0; } } }
      __syncthreads();
      pg8::Gemm g{ACT, W13_t + (size_t)l * 32 * 512 * D, T, 512, D};
      EpiSwiGLU E{HID};
      pg8::gemm_phase_g<EpiSwiGLU, MoeOrder, true>(lds, g, So, E, tab);
    }
    SEAM(pb + 6);
    if (IN(pb + 7)) {
      moe_tiles(lds, cntl);
      const LAS int* tiles = (const LAS int*)(lds + LDS_TILES); const int nti = *(const LAS int*)(lds + LDS_NTI);
      MoeOrder So{tiles, nti * 4, 4, G, (int)blockIdx.x};
      pg8::Gemm g{HID, W2_t + (size_t)l * 32 * D * 256, 0, D, 256};
      EpiMoeDown E{LIST, GATE, cntl, tiles, Y0, Y1};
      pg8::gemm_phase<EpiMoeDown, MoeOrder, true, true>(lds, g, So, E);
    }
    SEAM(pb + 7);
#ifdef CHECK_MOE
    { bf16* ALT = (bf16*)(ws + WS_PART); n_moe(lds, ACT, EXPI, GATE, args.in[17] + (size_t)l * 32 * D * 256, args.in[18] + (size_t)l * 32 * D * 256, args.in[19] + (size_t)l * 32 * 256 * D, out, ALT); xcd_barrier(bar);
      chk_ysum(Y0, Y1, ALT, (float*)(ctl + CW_CHK) + 2 * l); xcd_barrier(bar); }
#endif
#endif
#ifdef NAIVE_MOE
    if (IN(pb + 8)) { if (l + 1 < NL) { PHASE_IDS(); prep_rows(out, nullptr, nullptr, nullptr, ACT, args.in[1] + (l + 1) * D, gw, NGW, lane); } }
#else
    if (IN(pb + 8)) { PHASE_IDS(); prep_rows(out, Y0, Y1, out, (l + 1 < NL) ? ACT : nullptr, args.in[1] + ((l + 1 < NL) ? (l + 1) * D : 0), gw, NGW, lane); }
#endif
    SEAM(pb + 8);
  }
#if defined(CHECK_ATTN) || defined(CHECK_MOE) || defined(CHECK_POST) || defined(CHECK_ANY)
  xcd_barrier(bar); chk_apply(out, (const float*)(ctl + CW_CHK));
#endif
#undef IN
#undef SEAM
}
}

#ifndef MK_N_LAUNCHES
#define MK_N_LAUNCHES 1
#endif
extern "C" void kernel_launch(void* const* d_in, const int* in_sizes, int n_in, void* d_out, int out_size, void* d_ws, size_t ws_size, hipStream_t stream) {
  using namespace mk;
  static int grid = 0;
  if (grid == 0) {
    if (n_in != 20 || out_size != T * D || ws_size < WS_END) { fprintf(stderr, "kernel_launch: unexpected shapes (n_in %d out %d ws %zu)\n", n_in, out_size, ws_size); grid = -1; return; }
    int dev = 0, cus = 0;
    if (hipGetDevice(&dev) != hipSuccess || hipDeviceGetAttribute(&cus, hipDeviceAttributeMultiprocessorCount, dev) != hipSuccess) { grid = -1; return; }
    if (hipFuncSetAttribute((const void*)mk_fwd, hipFuncAttributeMaxDynamicSharedMemorySize, LDS_BYTES) != hipSuccess) { grid = -1; return; }
    grid = cus;
  }
  if (grid < 0) return;
  (void)hipMemsetAsync((char*)d_ws + WS_CTL, 0, CTL_ZERO_BYTES, stream);
  Args a{};
  for (int i = 0; i < 20; ++i) a.in[i] = (const float*)d_in[i];
  a.out = (float*)d_out; a.ws = (unsigned char*)d_ws;
  constexpr int NLA = MK_N_LAUNCHES;
  for (int li = 0; li < NLA; ++li) {
    a.ph_lo = (int)((long)NPHASE * li / NLA); a.ph_hi = (int)((long)NPHASE * (li + 1) / NLA); a.li = li;
    hipLaunchKernelGGL(mk_fwd, dim3(grid), dim3(NTHR), LDS_BYTES, stream, a);
  }
}
```

```cpp
#include <hip/hip_runtime.h>
#include <cstdio>
#include <cstdint>
#include <cmath>
#define OPQ_WMAP_LDS (131072 + 512)
__device__ __forceinline__ int opq_hwkey() { return (int)__builtin_amdgcn_s_getreg((5 << 11) | 4) & 63; }
__device__ __forceinline__ void opq_init() { const int t = threadIdx.x; if ((t & 63) == 0) *(__attribute__((address_space(3))) int*)(OPQ_WMAP_LDS + 4 * opq_hwkey()) = t >> 6; }
__device__ __forceinline__ int opq_tid() {
  int key = opq_hwkey(); asm volatile("" : "+s"(key));
  const int w = *(const volatile __attribute__((address_space(3))) int*)(OPQ_WMAP_LDS + 4 * key);
  int t = (__builtin_amdgcn_readfirstlane(w) << 6) | (int)__builtin_amdgcn_mbcnt_hi(~0u, __builtin_amdgcn_mbcnt_lo(~0u, 0u)); asm volatile("" : "+v"(t)); return t; }
__device__ __forceinline__ int opq_bid() { int t = blockIdx.x; asm volatile("" : "+s"(t)); return t; }

template <int M> __device__ __forceinline__ float xor_lane(float v) {
  if constexpr (M < 32) return __builtin_bit_cast(float, __builtin_amdgcn_ds_swizzle(__builtin_bit_cast(int, v), 0x1f | (M << 10)));
  else { auto r = __builtin_amdgcn_permlane32_swap(__builtin_bit_cast(unsigned, v), __builtin_bit_cast(unsigned, v), false, false); return __builtin_bit_cast(float, (unsigned)(__builtin_amdgcn_mbcnt_hi(~0u, __builtin_amdgcn_mbcnt_lo(~0u, 0u)) < 32 ? r[1] : r[0])); }
}
#define FASTMASK 15

namespace pg8 {
#define PG8_LAS __attribute__((address_space(3)))
typedef unsigned short bf16_t;
typedef short bf16x8 __attribute__((ext_vector_type(8)));
typedef float f32x4 __attribute__((ext_vector_type(4)));
typedef unsigned u32x4 __attribute__((ext_vector_type(4)));
constexpr int BM = 256, BK = 64, HALF = 128, HTB = HALF * BK * 2  , STAGE_BYTES = 8 * HTB, NXCD = 8, WGM = 8;

__host__ __device__ __forceinline__ int lds_byte(int r, int c) { const int st = (r >> 4) * 2 + (c >> 5), rr = r & 15, cc = c & 31, ob = rr * 64 + cc * 2; return st * 1024 + (ob ^ (((ob >> 9) & 1) << 5)); }
__host__ __device__ __forceinline__ void stage_rc(int b, int& R, int& C) { const int st = b / 1024, sb = b % 1024, swz = sb ^ (((sb >> 9) & 1) << 5); R = (st >> 1) * 16 + swz / 64; C = (st & 1) * 32 + (swz % 64) / 2; }
__host__ __device__ __forceinline__ int perm32(int rho) { const int n = rho >> 4, i = rho & 15; return 8 * (i >> 2) + 4 * n + (i & 3); }

struct Unit { int pm, pn; };
struct Gemm { const bf16_t* A; const bf16_t* Bt; int M, N, K; };

struct StaticOrder {
    int nM, nN, nwg, G, c;
    __host__ __device__ void init(int M, int N, int G_, int c_) { nM = M / BM; nN = N / BM; nwg = nM * nN; G = G_; c = c_; }
    __host__ __device__ bool next(int i, Unit& u) const {
        const long L = (long)i * G + c; if (L >= nwg) return false;
        int wgid = (int)L; { const int q = nwg / NXCD, r = nwg % NXCD, xcd = wgid % NXCD, off = wgid / NXCD; wgid = (xcd < r ? xcd * (q + 1) : r * (q + 1) + (xcd - r) * q) + off; }
        const int nig = WGM * nN, gid = wgid / nig, fm = gid * WGM, gsz = (nM - fm) < WGM ? (nM - fm) : WGM;
        u.pm = fm + ((wgid % nig) % gsz); u.pn = (wgid % nig) / gsz; return true;
    }
    __device__ __forceinline__ void a_ready(const Unit&) const {}
    __device__ __forceinline__ void done(const Unit&) const {}
};

__device__ __forceinline__ unsigned cvt_pk_bf16(float lo, float hi) { unsigned r; asm volatile("v_cvt_pk_bf16_f32 %0, %1, %2" : "=v"(r) : "v"(lo), "v"(hi)); return r; }
typedef float f32x2 __attribute__((ext_vector_type(2)));
__device__ __forceinline__ f32x2 gelu_pk(f32x2 v) {
    const f32x2 av = __builtin_elementwise_abs(v), d = av * 0.2316418882f + 1.0f;
    f32x2 t; t.x = __builtin_amdgcn_rcpf(d.x); t.y = __builtin_amdgcn_rcpf(d.y);
    f32x2 q = t * 0.5307027145f + (-0.7265760135f); q = q * t + 0.7107068705f; q = q * t + (-0.142248368f); q = q * t + 0.127414796f; q = q * t;
    const f32x2 s = (v * v) * (-0.72134752044f);
    f32x2 e; e.x = __builtin_amdgcn_exp2f(s.x); e.y = __builtin_amdgcn_exp2f(s.y);
    const f32x2 m = v * (q * e), r = v - m;
    f32x2 o; o.x = v.x < 0.f ? m.x : r.x; o.y = v.y < 0.f ? m.y : r.y; return o;
}

template <int ACT  > struct EpiBf16 {
    static constexpr bool PERM = true, AFTER_DRAIN = false; static_assert(ACT == 0 || ACT == 1, "EpiBf16: ACT is 0 (none) or 1 (gelu_pk)");
    bf16_t* O; int ldc; const float* bias; int split_cols; size_t split_stride; float scale0;
    __device__ __forceinline__ void operator()(const f32x4 (&acc)[2][2][4][2], const Unit& u, int wr, int wc, int fr, int fq) const {
        const int row0 = u.pm * BM + wr * 64 + fr; int colt = u.pn * BM; bf16_t* base = O;
        float sc = 1.f; if (split_cols) { const int t = colt / split_cols; base += (size_t)t * split_stride; colt -= t * split_cols; if (t == 0) sc = scale0; }
        const int col0 = colt + wc * 32 + 8 * fq, bcol0 = u.pn * BM + wc * 32 + 8 * fq;
        f32x4 bv[2][2];
#pragma unroll
        for (int bj = 0; bj < 2; ++bj)
#pragma unroll
            for (int n = 0; n < 2; ++n) bv[bj][n] = bias ? *(const f32x4*)(bias + bcol0 + bj * HALF + 4 * n) : (f32x4){0.f, 0.f, 0.f, 0.f};
#pragma unroll
        for (int ai = 0; ai < 2; ++ai)
#pragma unroll
            for (int m = 0; m < 4; ++m) { bf16_t* rowp = base + (size_t)(row0 + ai * HALF + m * 16) * ldc + col0;
#pragma unroll
                for (int bj = 0; bj < 2; ++bj) { f32x4 v0 = acc[ai][bj][m][0] + bv[bj][0], v1 = acc[ai][bj][m][1] + bv[bj][1];
                    if (ACT == 1) { f32x2 a = gelu_pk((f32x2){v0[0], v0[1]}), b = gelu_pk((f32x2){v0[2], v0[3]}), c = gelu_pk((f32x2){v1[0], v1[1]}), d = gelu_pk((f32x2){v1[2], v1[3]});
                        v0 = (f32x4){a.x, a.y, b.x, b.y}; v1 = (f32x4){c.x, c.y, d.x, d.y}; }
                    v0 = v0 * sc; v1 = v1 * sc; u32x4 w; w.x = cvt_pk_bf16(v0[0], v0[1]); w.y = cvt_pk_bf16(v0[2], v0[3]); w.z = cvt_pk_bf16(v1[0], v1[1]); w.w = cvt_pk_bf16(v1[2], v1[3]);
                    *(u32x4*)(rowp + bj * HALF) = w; } }
    }
};
template <class Epi, class Sched, bool ALIGN_EPI = false, bool SP2 = false>
__device__ __forceinline__ void gemm_phase(PG8_LAS unsigned char* lds, const Gemm g, const Sched& S, const Epi& E) {
    const int tid = opq_tid(), wid = __builtin_amdgcn_readfirstlane(tid >> 6), lane = tid & 63, wr = wid >> 2, wc = wid & 3, fr = lane & 15, fq = lane >> 4;
    const int K = g.K, nt = K / BK;
    unsigned voffA[2], voffB[2];
#pragma unroll
    for (int i = 0; i < 2; ++i) { int R, C; stage_rc(tid * 16 + i * 8192, R, C); const int Rb = Epi::PERM ? ((R & ~31) + perm32(R & 31)) : R;
        voffA[i] = (unsigned)(R * K + C) * 2u; voffB[i] = (unsigned)(Rb * K + C) * 2u; }
    const size_t kstep = (size_t)(BK * 2);
    const size_t hstep = (size_t)HALF * K * 2;
    const size_t tstep = 2 * hstep;
    const unsigned ldsw = (unsigned)wid * 1024u;
    const int aoff = lds_byte(wr * 64 + fr, fq * 8), boff = lds_byte(wc * 32 + fr, fq * 8);
#define PG8_SA(b, h) (((b) * 2 + (h)) * HTB)
#define PG8_SB(b, h) ((4 + (b) * 2 + (h)) * HTB)
#define PG8_STAGE(bufoff, gbase, voff) do { _Pragma("unroll") for (int _i = 0; _i < 2; ++_i) \
        __builtin_amdgcn_global_load_lds((const unsigned*)((const char*)(gbase) + (voff)[_i]), (PG8_LAS unsigned*)(lds + (bufoff) + ldsw + _i * 8192), 16, 0, 0); } while (0)
#define PG8_LDA(dst, b, h) do { _Pragma("unroll") for (int m = 0; m < 4; ++m) _Pragma("unroll") for (int k = 0; k < 2; ++k) dst[m][k] = *(const PG8_LAS bf16x8*)(lds + PG8_SA(b, h) + aoff + m * 2048 + k * 1024); } while (0)
#define PG8_LDB(dst, b, h) do { _Pragma("unroll") for (int n = 0; n < 2; ++n) _Pragma("unroll") for (int k = 0; k < 2; ++k) dst[n][k] = *(const PG8_LAS bf16x8*)(lds + PG8_SB(b, h) + boff + n * 2048 + k * 1024); } while (0)
#define PG8_MMA(ai, bj, At, Bt) do { __builtin_amdgcn_s_setprio(1); _Pragma("unroll") for (int m = 0; m < 4; ++m) _Pragma("unroll") for (int n = 0; n < 2; ++n) _Pragma("unroll") for (int k = 0; k < 2; ++k) \
        acc[ai][bj][m][n] = __builtin_amdgcn_mfma_f32_16x16x32_bf16(Bt[n][k], At[m][k], acc[ai][bj][m][n], 0, 0, 0); __builtin_amdgcn_s_setprio(0); } while (0)
#define PG8_WAIT_V(n) asm volatile("s_waitcnt vmcnt(" #n ")" ::: "memory")
#define PG8_WAIT_L(n) asm volatile("s_waitcnt lgkmcnt(" #n ")" ::: "memory")
#define PG8_BAR __builtin_amdgcn_s_barrier()
#define PG8_SCHED __builtin_amdgcn_sched_barrier(0)
    Unit cur, nxt; int ui = 0;
    if (!S.next(0, cur)) return;
    f32x4 acc[2][2][4][2];
#pragma unroll
    for (int a = 0; a < 2; ++a)
#pragma unroll
        for (int b = 0; b < 2; ++b)
#pragma unroll
            for (int m = 0; m < 4; ++m)
#pragma unroll
                for (int n = 0; n < 2; ++n) acc[a][b][m][n] = (f32x4){0.f, 0.f, 0.f, 0.f};
    bf16x8 At[4][2], B0[2][2], B1[2][2];
    const char* cA = (const char*)g.A + (size_t)cur.pm * tstep; const char* cB = (const char*)g.Bt + (size_t)cur.pn * tstep;
    S.a_ready(cur);
    if constexpr (SP2) {
        PG8_STAGE(PG8_SB(0, 0), cB, voffB); PG8_STAGE(PG8_SB(0, 1), cB + hstep, voffB); PG8_STAGE(PG8_SA(0, 0), cA, voffA); PG8_STAGE(PG8_SA(0, 1), cA + hstep, voffA);
        if (wr == 1) PG8_BAR;
        PG8_WAIT_V(2); PG8_BAR;
        PG8_STAGE(PG8_SB(1, 0), cB + kstep, voffB); PG8_STAGE(PG8_SA(1, 0), cA + kstep, voffA); PG8_STAGE(PG8_SB(1, 1), cB + hstep + kstep, voffB);
        PG8_WAIT_V(6); PG8_BAR;
    } else {
        PG8_STAGE(PG8_SB(0, 0), cB, voffB); PG8_STAGE(PG8_SA(0, 0), cA, voffA); PG8_STAGE(PG8_SB(0, 1), cB + hstep, voffB); PG8_STAGE(PG8_SA(0, 1), cA + hstep, voffA);
        if (wr == 1) PG8_BAR;
        PG8_WAIT_V(4); PG8_BAR;
        PG8_STAGE(PG8_SB(1, 0), cB + kstep, voffB); PG8_STAGE(PG8_SA(1, 0), cA + kstep, voffA); PG8_STAGE(PG8_SB(1, 1), cB + hstep + kstep, voffB);
        PG8_WAIT_V(6); PG8_BAR;
    }
    for (;;) {
        const bool has_next = S.next(ui + 1, nxt);
        const char* nA = has_next ? (const char*)g.A + (size_t)nxt.pm * tstep : cA; const char* nB = has_next ? (const char*)g.Bt + (size_t)nxt.pn * tstep : cB;
        for (int t = 0; t < nt; t += 2) {
            const bool last = (t == nt - 2);
            const char* a1 = cA + (size_t)(t + 1) * kstep;
            const char* a2 = last ? nA : cA + (size_t)(t + 2) * kstep; const char* b2 = last ? nB : cB + (size_t)(t + 2) * kstep;
            const char* a3 = a2 + kstep; const char* b3 = b2 + kstep;
            if (last && has_next) S.a_ready(nxt);
            if constexpr (SP2) {
            PG8_LDB(B0, 0, 0); PG8_LDB(B1, 0, 1); PG8_SCHED; PG8_LDA(At, 0, 0); PG8_STAGE(PG8_SA(1, 1), a1 + hstep, voffA);
            PG8_WAIT_V(8); PG8_WAIT_L(0); PG8_BAR; PG8_MMA(0, 0, At, B0); PG8_MMA(0, 1, At, B1); PG8_BAR; PG8_SCHED;
            PG8_LDA(At, 0, 1); PG8_STAGE(PG8_SB(0, 0), b2, voffB); PG8_STAGE(PG8_SB(0, 1), b2 + hstep, voffB); PG8_STAGE(PG8_SA(0, 0), a2, voffA);
            PG8_WAIT_V(8); PG8_WAIT_L(0); PG8_BAR; PG8_MMA(1, 0, At, B0); PG8_MMA(1, 1, At, B1); PG8_BAR; PG8_SCHED;
            PG8_LDB(B0, 1, 0); PG8_LDB(B1, 1, 1); PG8_SCHED; PG8_LDA(At, 1, 0); PG8_STAGE(PG8_SA(0, 1), a2 + hstep, voffA);
            PG8_WAIT_V(8); PG8_WAIT_L(0); PG8_BAR; PG8_MMA(0, 0, At, B0); PG8_MMA(0, 1, At, B1); PG8_BAR; PG8_SCHED;
            PG8_LDA(At, 1, 1); PG8_STAGE(PG8_SB(1, 0), b3, voffB); PG8_STAGE(PG8_SB(1, 1), b3 + hstep, voffB); PG8_STAGE(PG8_SA(1, 0), a3, voffA);
            PG8_WAIT_V(8); PG8_WAIT_L(0); PG8_BAR; PG8_MMA(1, 0, At, B0); PG8_MMA(1, 1, At, B1); PG8_BAR; PG8_SCHED;
            } else {
            PG8_LDB(B0, 0, 0); PG8_SCHED; PG8_LDA(At, 0, 0); PG8_STAGE(PG8_SA(1, 1), a1 + hstep, voffA);
            PG8_WAIT_L(8); PG8_BAR; PG8_WAIT_L(0); PG8_MMA(0, 0, At, B0); PG8_BAR; PG8_SCHED;
            PG8_LDB(B1, 0, 1); PG8_STAGE(PG8_SB(0, 0), b2, voffB);
            PG8_BAR; PG8_WAIT_L(0); PG8_MMA(0, 1, At, B1); PG8_BAR;
            PG8_LDA(At, 0, 1); PG8_STAGE(PG8_SA(0, 0), a2, voffA);
            PG8_BAR; PG8_WAIT_L(0); PG8_MMA(1, 0, At, B0); PG8_BAR; PG8_SCHED;
            PG8_STAGE(PG8_SB(0, 1), b2 + hstep, voffB);
            PG8_WAIT_V(6); PG8_BAR; PG8_MMA(1, 1, At, B1); PG8_BAR;
            PG8_LDB(B0, 1, 0); PG8_SCHED; PG8_LDA(At, 1, 0); PG8_STAGE(PG8_SA(0, 1), a2 + hstep, voffA);
            PG8_WAIT_L(8); PG8_BAR; PG8_WAIT_L(0); PG8_MMA(0, 0, At, B0); PG8_BAR; PG8_SCHED;
            PG8_LDB(B1, 1, 1); PG8_STAGE(PG8_SB(1, 0), b3, voffB);
            PG8_BAR; PG8_WAIT_L(0); PG8_MMA(0, 1, At, B1); PG8_BAR;
            PG8_LDA(At, 1, 1); PG8_STAGE(PG8_SA(1, 0), a3, voffA);
            PG8_BAR; PG8_WAIT_L(0); PG8_MMA(1, 0, At, B0); PG8_BAR; PG8_SCHED;
            PG8_STAGE(PG8_SB(1, 1), b3 + hstep, voffB);
            PG8_WAIT_V(6); PG8_BAR; PG8_MMA(1, 1, At, B1); PG8_BAR;
            }
        }
        if constexpr (ALIGN_EPI) { if (wr == 0) PG8_BAR; }
        if constexpr (!Epi::AFTER_DRAIN) { E(acc, cur, wr, wc, fr, fq); S.done(cur); }
        if (!has_next) break;
#pragma unroll
        for (int a = 0; a < 2; ++a)
#pragma unroll
            for (int b = 0; b < 2; ++b)
#pragma unroll
                for (int m = 0; m < 4; ++m)
#pragma unroll
                    for (int n = 0; n < 2; ++n) acc[a][b][m][n] = (f32x4){0.f, 0.f, 0.f, 0.f};
        cur = nxt; cA = nA; cB = nB; ++ui;
        if constexpr (ALIGN_EPI) { if (wr == 1) PG8_BAR; }
    }
    PG8_WAIT_V(0);
    if constexpr (!ALIGN_EPI) { if (wr == 0) PG8_BAR; }
    PG8_BAR;
    if constexpr (Epi::AFTER_DRAIN) { E.fused(acc, cur, wr, wc, fr, fq, lds, wid, lane); S.done(cur); }
#undef PG8_SA
#undef PG8_SB
#undef PG8_STAGE
#undef PG8_LDA
#undef PG8_LDB
#undef PG8_MMA
#undef PG8_WAIT_V
#undef PG8_WAIT_L
#undef PG8_BAR
#undef PG8_SCHED
}
}

#ifndef PG8_SP2
#define PG8_SP2 true
#endif
#ifndef PG8_ALIGN
#define PG8_ALIGN true
#endif
namespace pg8 {
template <class Epi, class Sched, bool ALIGN_EPI = false>
__device__ __forceinline__ void gemm_phase_g(PG8_LAS unsigned char* lds, const Gemm g, const Sched& S, const Epi& E, const PG8_LAS int* tab) {
    const int tid = opq_tid(), wid = __builtin_amdgcn_readfirstlane(tid >> 6), lane = tid & 63, wr = wid >> 2, wc = wid & 3, fr = lane & 15, fq = lane >> 4;
    const int K = g.K, nt = K / BK;
    unsigned voffB[2]; int Rl[2]; unsigned Cl[2];
#pragma unroll
    for (int i = 0; i < 2; ++i) { int R, C; stage_rc(tid * 16 + i * 8192, R, C); const int Rb = Epi::PERM ? ((R & ~31) + perm32(R & 31)) : R;
        Rl[i] = R; Cl[i] = (unsigned)C * 2u; voffB[i] = (unsigned)(Rb * K + C) * 2u; }
    unsigned vC0[2], vC1[2], vN0[2], vN1[2];
#define PG8_LDOFF(i_, h0, h1) do { _Pragma("unroll") for (int _i = 0; _i < 2; ++_i) { h0[_i] = (unsigned)tab[(i_) * 256 + Rl[_i]] * (unsigned)(K * 2) + Cl[_i]; h1[_i] = (unsigned)tab[(i_) * 256 + 128 + Rl[_i]] * (unsigned)(K * 2) + Cl[_i]; } } while (0)
    const size_t kstep = (size_t)(BK * 2);
    const size_t hstep = (size_t)HALF * K * 2;
    const size_t tstep = 2 * hstep;
    const unsigned ldsw = (unsigned)wid * 1024u;
    const int aoff = lds_byte(wr * 64 + fr, fq * 8), boff = lds_byte(wc * 32 + fr, fq * 8);
#define PG8_SA(b, h) (((b) * 2 + (h)) * HTB)
#define PG8_SB(b, h) ((4 + (b) * 2 + (h)) * HTB)
#define PG8_STAGE(bufoff, gbase, voff) do { _Pragma("unroll") for (int _i = 0; _i < 2; ++_i) \
        __builtin_amdgcn_global_load_lds((const unsigned*)((const char*)(gbase) + (voff)[_i]), (PG8_LAS unsigned*)(lds + (bufoff) + ldsw + _i * 8192), 16, 0, 0); } while (0)
#define PG8_LDA(dst, b, h) do { _Pragma("unroll") for (int m = 0; m < 4; ++m) _Pragma("unroll") for (int k = 0; k < 2; ++k) dst[m][k] = *(const PG8_LAS bf16x8*)(lds + PG8_SA(b, h) + aoff + m * 2048 + k * 1024); } while (0)
#define PG8_LDB(dst, b, h) do { _Pragma("unroll") for (int n = 0; n < 2; ++n) _Pragma("unroll") for (int k = 0; k < 2; ++k) dst[n][k] = *(const PG8_LAS bf16x8*)(lds + PG8_SB(b, h) + boff + n * 2048 + k * 1024); } while (0)
#define PG8_MMA(ai, bj, At, Bt) do { __builtin_amdgcn_s_setprio(1); _Pragma("unroll") for (int m = 0; m < 4; ++m) _Pragma("unroll") for (int n = 0; n < 2; ++n) _Pragma("unroll") for (int k = 0; k < 2; ++k) \
        acc[ai][bj][m][n] = __builtin_amdgcn_mfma_f32_16x16x32_bf16(Bt[n][k], At[m][k], acc[ai][bj][m][n], 0, 0, 0); __builtin_amdgcn_s_setprio(0); } while (0)
#define PG8_WAIT_V(n) asm volatile("s_waitcnt vmcnt(" #n ")" ::: "memory")
#define PG8_WAIT_L(n) asm volatile("s_waitcnt lgkmcnt(" #n ")" ::: "memory")
#define PG8_BAR __builtin_amdgcn_s_barrier()
#define PG8_SCHED __builtin_amdgcn_sched_barrier(0)
    Unit cur, nxt; int ui = 0;
    if (!S.next(0, cur)) return;
    f32x4 acc[2][2][4][2];
#pragma unroll
    for (int a = 0; a < 2; ++a)
#pragma unroll
        for (int b = 0; b < 2; ++b)
#pragma unroll
            for (int m = 0; m < 4; ++m)
#pragma unroll
                for (int n = 0; n < 2; ++n) acc[a][b][m][n] = (f32x4){0.f, 0.f, 0.f, 0.f};
    bf16x8 At[4][2], B0[2][2], B1[2][2];
    const char* const cA = (const char*)g.A; const char* cB = (const char*)g.Bt + (size_t)cur.pn * tstep;
    PG8_LDOFF(0, vC0, vC1);
    S.a_ready(cur);
    {
        PG8_STAGE(PG8_SB(0, 0), cB, voffB); PG8_STAGE(PG8_SB(0, 1), cB + hstep, voffB); PG8_STAGE(PG8_SA(0, 0), cA, vC0); PG8_STAGE(PG8_SA(0, 1), cA, vC1);
        if (wr == 1) PG8_BAR;
        PG8_WAIT_V(2); PG8_BAR;
        PG8_STAGE(PG8_SB(1, 0), cB + kstep, voffB); PG8_STAGE(PG8_SA(1, 0), cA + kstep, vC0); PG8_STAGE(PG8_SB(1, 1), cB + hstep + kstep, voffB);
        PG8_WAIT_V(6); PG8_BAR;
    }
    for (;;) {
        const bool has_next = S.next(ui + 1, nxt);
        const char* nB = has_next ? (const char*)g.Bt + (size_t)nxt.pn * tstep : cB;
        if (has_next) PG8_LDOFF(ui + 1, vN0, vN1); else { vN0[0] = vC0[0]; vN0[1] = vC0[1]; vN1[0] = vC1[0]; vN1[1] = vC1[1]; }
        for (int t = 0; t < nt; t += 2) {
            const bool last = (t == nt - 2);
            const char* a1 = cA + (size_t)(t + 1) * kstep;
            const char* a2 = last ? cA : cA + (size_t)(t + 2) * kstep; const char* b2 = last ? nB : cB + (size_t)(t + 2) * kstep;
            unsigned s0[2], s1[2]; s0[0] = last ? vN0[0] : vC0[0]; s0[1] = last ? vN0[1] : vC0[1]; s1[0] = last ? vN1[0] : vC1[0]; s1[1] = last ? vN1[1] : vC1[1];
            const char* a3 = a2 + kstep; const char* b3 = b2 + kstep;
            if (last && has_next) S.a_ready(nxt);
            PG8_LDB(B0, 0, 0); PG8_LDB(B1, 0, 1); PG8_SCHED; PG8_LDA(At, 0, 0); PG8_STAGE(PG8_SA(1, 1), a1, vC1);
            PG8_WAIT_V(8); PG8_WAIT_L(0); PG8_BAR; PG8_MMA(0, 0, At, B0); PG8_MMA(0, 1, At, B1); PG8_BAR; PG8_SCHED;
            PG8_LDA(At, 0, 1); PG8_STAGE(PG8_SB(0, 0), b2, voffB); PG8_STAGE(PG8_SB(0, 1), b2 + hstep, voffB); PG8_STAGE(PG8_SA(0, 0), a2, s0);
            PG8_WAIT_V(8); PG8_WAIT_L(0); PG8_BAR; PG8_MMA(1, 0, At, B0); PG8_MMA(1, 1, At, B1); PG8_BAR; PG8_SCHED;
            PG8_LDB(B0, 1, 0); PG8_LDB(B1, 1, 1); PG8_SCHED; PG8_LDA(At, 1, 0); PG8_STAGE(PG8_SA(0, 1), a2, s1);
            PG8_WAIT_V(8); PG8_WAIT_L(0); PG8_BAR; PG8_MMA(0, 0, At, B0); PG8_MMA(0, 1, At, B1); PG8_BAR; PG8_SCHED;
            PG8_LDA(At, 1, 1); PG8_STAGE(PG8_SB(1, 0), b3, voffB); PG8_STAGE(PG8_SB(1, 1), b3 + hstep, voffB); PG8_STAGE(PG8_SA(1, 0), a3, s0);
            PG8_WAIT_V(8); PG8_WAIT_L(0); PG8_BAR; PG8_MMA(1, 0, At, B0); PG8_MMA(1, 1, At, B1); PG8_BAR; PG8_SCHED;
        }
        if constexpr (ALIGN_EPI) { if (wr == 0) PG8_BAR; }
        if constexpr (!Epi::AFTER_DRAIN) { E(acc, cur, wr, wc, fr, fq); S.done(cur); }
        if (!has_next) break;
#pragma unroll
        for (int a = 0; a < 2; ++a)
#pragma unroll
            for (int b = 0; b < 2; ++b)
#pragma unroll
                for (int m = 0; m < 4; ++m)
#pragma unroll
                    for (int n = 0; n < 2; ++n) acc[a][b][m][n] = (f32x4){0.f, 0.f, 0.f, 0.f};
        cur = nxt; cB = nB; ++ui; vC0[0] = vN0[0]; vC0[1] = vN0[1]; vC1[0] = vN1[0]; vC1[1] = vN1[1];
        if constexpr (ALIGN_EPI) { if (wr == 1) PG8_BAR; }
    }
    PG8_WAIT_V(0);
    if constexpr (!ALIGN_EPI) { if (wr == 0) PG8_BAR; }
    PG8_BAR;
    if constexpr (Epi::AFTER_DRAIN) { E.fused(acc, cur, wr, wc, fr, fq, lds, wid, lane); S.done(cur); }
#undef PG8_SA
#undef PG8_LDOFF
#undef PG8_SB
#undef PG8_STAGE
#undef PG8_LDA
#undef PG8_LDB
#undef PG8_MMA
#undef PG8_WAIT_V
#undef PG8_WAIT_L
#undef PG8_BAR
#undef PG8_SCHED
}
}
#include <hip/hip_bf16.h>
#include <cmath>
namespace attn_body {
using bf16=__hip_bfloat16;
using bf16x8=__attribute__((ext_vector_type(8)))short;
using s16x4=__attribute__((ext_vector_type(4)))short;
using f32x16=__attribute__((ext_vector_type(16)))float;
using u32x4=__attribute__((ext_vector_type(4)))unsigned;
constexpr int BATCH=2,NHEAD=4,SEQ=8192,D=64,DM=NHEAD*D;
constexpr int NW=8,QBLK=32,QB=QBLK*NW,KVBLK=64,NQB=SEQ/QB;
constexpr int ATTN_PITCH=DM, ATTN_UNIT_ROWS=QB;
__device__ __forceinline__ int crow(int r,int hi){return (r&3)+8*(r>>2)+4*hi;}
#define SBAR() __builtin_amdgcn_sched_barrier(0)
__device__ __forceinline__ void cmask(f32x16&p0,f32x16&p1,int jb,int qrel,int hi){
  const float NEG=-INFINITY; int kb=64*jb+4*hi;
  #pragma unroll
  for(int r=0;r<16;++r){int kv=kb+(r&3)+8*(r>>2); if(kv>qrel)p0[r]=NEG; if(kv+32>qrel)p1[r]=NEG;}
}

constexpr int NSLOT=3, SLOTB=8192;
constexpr int LDS_K=0, LDS_V=NSLOT*SLOTB, LDS_WS=2*NSLOT*SLOTB, LDS_OST=LDS_WS+NW*64*4, LDS_BIAS=LDS_OST+NW*4096, LDS_BYTES=LDS_BIAS+(SEQ+64)*4;
constexpr float C2=0.125f*1.4426950408889634f;
__device__ __forceinline__ void glds16(const void*gsrc,unsigned lds_dst){unsigned keep;
  asm volatile("s_mov_b32 %0, m0\n\ts_mov_b32 m0, %2\n\ts_nop 0\n\tglobal_load_lds_dwordx4 %1, off\n\ts_mov_b32 m0, %0":"=&s"(keep):"v"(gsrc),"s"(lds_dst):"memory");}
__device__ __forceinline__ float max3f(float a,float b,float c){float r;asm("v_max3_f32 %0, %1, %2, %3":"=v"(r):"v"(a),"v"(b),"v"(c));return r;}
__device__ __forceinline__ float max2f(float a,float b){float r;asm("v_max_f32_e32 %0, %1, %2":"=v"(r):"v"(a),"v"(b));return r;}
__device__ __forceinline__ float fadd_s(float a,float b){float r;asm("v_add_f32_e32 %0, %1, %2":"=v"(r):"v"(a),"v"(b));return r;}
__device__ __forceinline__ float fsub_s(float a,float b){float r;asm("v_sub_f32_e32 %0, %1, %2":"=v"(r):"v"(a),"v"(b));return r;}
typedef float f32x2_t __attribute__((ext_vector_type(2))); typedef float f32x4_t __attribute__((ext_vector_type(4))); typedef __bf16 bf16x2_t __attribute__((ext_vector_type(2)));
__device__ __forceinline__ unsigned cvtpk_s(float lo,float hi){f32x2_t v={lo,hi};bf16x2_t b=__builtin_convertvector(v,bf16x2_t);return __builtin_bit_cast(unsigned,b);}
#define WAIT_BAR(N) asm volatile("s_waitcnt vmcnt(" #N ") lgkmcnt(0)\n\ts_barrier":::"memory")

__device__ __forceinline__ void qkt(f32x16&p0,f32x16&p1,const char*Kslot,const bf16x8*qr,const f32x16&negm,int r32,int hi){
  const char*kb=Kslot+hi*1024+r32*16;
  #pragma unroll
  for(int d0=0;d0<4;++d0){
    const bf16x8 b0=*reinterpret_cast<const bf16x8*>(kb+d0*2048);
    const bf16x8 b1=*reinterpret_cast<const bf16x8*>(kb+d0*2048+512);
    if(d0==0){p0=__builtin_amdgcn_mfma_f32_32x32x16_bf16(b0,qr[0],negm,0,0,0);p1=__builtin_amdgcn_mfma_f32_32x32x16_bf16(b1,qr[0],negm,0,0,0);}
    else{p0=__builtin_amdgcn_mfma_f32_32x32x16_bf16(b0,qr[d0],p0,0,0,0);p1=__builtin_amdgcn_mfma_f32_32x32x16_bf16(b1,qr[d0],p1,0,0,0);}}
}
typedef __attribute__((address_space(3))) const char* lds_cptr;
typedef short v4i16_t __attribute__((ext_vector_type(4)));
__device__ __forceinline__ void kload8(bf16x8*kf,lds_cptr kp){
  kf[0]=*(const __attribute__((address_space(3))) bf16x8*)(kp);      kf[1]=*(const __attribute__((address_space(3))) bf16x8*)(kp+512);
  kf[2]=*(const __attribute__((address_space(3))) bf16x8*)(kp+2048); kf[3]=*(const __attribute__((address_space(3))) bf16x8*)(kp+2560);
  kf[4]=*(const __attribute__((address_space(3))) bf16x8*)(kp+4096); kf[5]=*(const __attribute__((address_space(3))) bf16x8*)(kp+4608);
  kf[6]=*(const __attribute__((address_space(3))) bf16x8*)(kp+6144); kf[7]=*(const __attribute__((address_space(3))) bf16x8*)(kp+6656);
}
__device__ __forceinline__ void kload2(bf16x8*kf,lds_cptr kp,int j){ kf[2*j]=*(const __attribute__((address_space(3))) bf16x8*)(kp+j*2048); kf[2*j+1]=*(const __attribute__((address_space(3))) bf16x8*)(kp+j*2048+512); }
__device__ __forceinline__ s16x4 vtr(lds_cptr p){ return __builtin_bit_cast(s16x4,__builtin_amdgcn_ds_read_tr16_b64_v4i16((__attribute__((address_space(3))) v4i16_t*)p)); }
__device__ __forceinline__ float rowmax(const f32x16&p0,const f32x16&p1){
  float a=max3f(p0[0],p0[1],p1[0]),b=max3f(p0[2],p0[3],p1[1]);a=max3f(a,p1[2],p1[3]);
  #pragma unroll
  for(int r=4;r<16;r+=4){a=max3f(a,p0[r],p0[r+1]);b=max3f(b,p0[r+2],p0[r+3]);a=max3f(a,p1[r],p1[r+1]);b=max3f(b,p1[r+2],p1[r+3]);}
  const float m=max2f(a,b);
  auto rr=__builtin_amdgcn_permlane32_swap(__float_as_uint(m),__float_as_uint(m),false,false);
  return max2f(__uint_as_float(rr[0]),__uint_as_float(rr[1]));
}
__device__ __forceinline__ void pv(f32x16*o,int vb,bf16x8 pa0,bf16x8 pa1,bf16x8 pa2,bf16x8 pa3){
  #pragma unroll
  for(int d0=0;d0<2;++d0){s16x4 lo[4],hi[4];
    #pragma unroll
    for(int ks=0;ks<4;++ks){
      asm volatile("ds_read_b64_tr_b16 %0,%1 offset:%c2":"=&v"(lo[ks]):"v"(vb),"i"(d0*4096+ks*1024):"memory");
      asm volatile("ds_read_b64_tr_b16 %0,%1 offset:%c2":"=&v"(hi[ks]):"v"(vb),"i"(d0*4096+ks*1024+512):"memory");}
    asm volatile("s_waitcnt lgkmcnt(0)":::"memory");SBAR();
    #define PK(k) (bf16x8){lo[k][0],lo[k][1],lo[k][2],lo[k][3],hi[k][0],hi[k][1],hi[k][2],hi[k][3]}
    o[d0]=__builtin_amdgcn_mfma_f32_32x32x16_bf16(pa0,PK(0),o[d0],0,0,0);
    o[d0]=__builtin_amdgcn_mfma_f32_32x32x16_bf16(pa1,PK(1),o[d0],0,0,0);
    o[d0]=__builtin_amdgcn_mfma_f32_32x32x16_bf16(pa2,PK(2),o[d0],0,0,0);
    o[d0]=__builtin_amdgcn_mfma_f32_32x32x16_bf16(pa3,PK(3),o[d0],0,0,0);
    #undef PK
  }
}

#ifndef ATTN_STORE16
#define ATTN_STORE16(p,v) (*(u32x4*)(p)=(v))
#endif
struct AU { const bf16*Q; const bf16*K; const bf16*V; bf16*O; float*LSE; long qs,ks,os; int NT,win,lses,pad; float slope2,sink2; };
template<int THRL,int MODE> __device__ __forceinline__ void attn_unit(const AU&u,char*shm){
  const int tid=opq_tid(),lane=tid&63,r32=lane&31,hi=lane>>5; const int wid=__builtin_amdgcn_readfirstlane(tid>>6);
  const long ks=u.ks;
  const bf16*Qw=u.Q+(long)(wid*QBLK)*u.qs;
  const bf16*Kh=u.K,*Vh=u.V;
  const unsigned lds0=(unsigned)(uintptr_t)shm;
  float*wsf=(float*)(shm+LDS_WS)+wid*64;
  const bf16*ksrc=Kh+(long)lane*ks+wid*8;
  const bf16*vsrc=Vh+(long)(16*(wid&3)+(lane>>2))*ks+(wid>>2)*32+(lane&3)*8;
  const unsigned kdst=lds0+LDS_K+wid*1024, vdst=lds0+LDS_V+wid*1024;
  #define DMA_K(t,slot) glds16(ksrc+(long)(t)*KVBLK*ks,(unsigned)__builtin_amdgcn_readfirstlane(kdst+(slot)))
  #define DMA_V(t,slot) glds16(vsrc+(long)(t)*KVBLK*ks,(unsigned)__builtin_amdgcn_readfirstlane(vdst+(slot)))
  const int vb0=(int)(lds0+LDS_V)+((lane>>4)&1)*32+(lane&3)*8+(4*hi+((lane&15)>>2))*64;
  const char*Kbase=shm+LDS_K; bf16x8 kf[8];
  const lds_cptr shm3=(lds_cptr)shm; const lds_cptr kp0=shm3+LDS_K+hi*1024+r32*16; const lds_cptr vp0=shm3+LDS_V+((lane>>4)&1)*32+(lane&3)*8+(4*hi+((lane&15)>>2))*64;
  const int NT=u.NT;
  const lds_cptr biasp=shm3+LDS_BIAS;
  DMA_K(0,0);DMA_V(0,0);DMA_K(1,SLOTB);
  bf16x8 qr[4];
  #pragma unroll
  for(int d0=0;d0<4;++d0)qr[d0]=*reinterpret_cast<const bf16x8*>(&Qw[(long)r32*u.qs+d0*16+hi*8]);
  float mhat=0.f,l_reg=0.f;f32x16 o[2];o[0]=f32x16{};o[1]=f32x16{};f32x16 negm=f32x16{};if(!(MODE&1)){asm volatile("":"+v"(negm));}
  const int qrel=wid*QBLK+r32;
  #define CMASK(P0,P1,t) do{int jb_=(t)-(NT-4); if(!(MODE&16)&&jb_>=0)cmask(P0,P1,jb_,qrel,hi);}while(0)
  #define BIASW(P0,P1,t) do{ if(MODE&1){ const lds_cptr bt_=biasp+((t)*64+4*hi)*4; const float nm_=-mhat; SBAR(); \
      { f32x4_t b_[2]; _Pragma("unroll") for(int g_=0;g_<2;++g_) b_[g_]=*(const __attribute__((address_space(3))) f32x4_t*)(bt_+0+32*(g_+0)); \
        _Pragma("unroll") for(int g_=0;g_<2;++g_){ P0[4*(g_+0)]+=b_[g_][0]+nm_;P0[4*(g_+0)+1]+=b_[g_][1]+nm_;P0[4*(g_+0)+2]+=b_[g_][2]+nm_;P0[4*(g_+0)+3]+=b_[g_][3]+nm_; } } \
      asm volatile("":"+v"(P0)); SBAR(); \
      { f32x4_t b_[2]; _Pragma("unroll") for(int g_=0;g_<2;++g_) b_[g_]=*(const __attribute__((address_space(3))) f32x4_t*)(bt_+0+32*(g_+2)); \
        _Pragma("unroll") for(int g_=0;g_<2;++g_){ P0[4*(g_+2)]+=b_[g_][0]+nm_;P0[4*(g_+2)+1]+=b_[g_][1]+nm_;P0[4*(g_+2)+2]+=b_[g_][2]+nm_;P0[4*(g_+2)+3]+=b_[g_][3]+nm_; } } \
      asm volatile("":"+v"(P0)); SBAR(); \
      { f32x4_t b_[2]; _Pragma("unroll") for(int g_=0;g_<2;++g_) b_[g_]=*(const __attribute__((address_space(3))) f32x4_t*)(bt_+128+32*(g_+0)); \
        _Pragma("unroll") for(int g_=0;g_<2;++g_){ P1[4*(g_+0)]+=b_[g_][0]+nm_;P1[4*(g_+0)+1]+=b_[g_][1]+nm_;P1[4*(g_+0)+2]+=b_[g_][2]+nm_;P1[4*(g_+0)+3]+=b_[g_][3]+nm_; } } \
      asm volatile("":"+v"(P1)); SBAR(); \
      { f32x4_t b_[2]; _Pragma("unroll") for(int g_=0;g_<2;++g_) b_[g_]=*(const __attribute__((address_space(3))) f32x4_t*)(bt_+128+32*(g_+2)); \
        _Pragma("unroll") for(int g_=0;g_<2;++g_){ P1[4*(g_+2)]+=b_[g_][0]+nm_;P1[4*(g_+2)+1]+=b_[g_][1]+nm_;P1[4*(g_+2)+2]+=b_[g_][2]+nm_;P1[4*(g_+2)+3]+=b_[g_][3]+nm_; } } \
      asm volatile("":"+v"(P1)); SBAR(); \
      } \
    if(MODE&2){ const int kw_=64*((t)-(NT-4))+4*hi-qrel+u.win; \
      _Pragma("unroll") for(int r=0;r<16;++r){ const int kv_=kw_+(r&3)+8*(r>>2); if(kv_<0)P0[r]=-INFINITY; if(kv_+32<0)P1[r]=-INFINITY; } } }while(0)
  bool resc=false;
  #define START(P0,P1) do{ const float rm=rowmax(P0,P1); resc=false; \
    { const float dl=(MODE&2)?max2f(rm,-1000.f):rm; mhat=fadd_s(mhat,dl); \
      _Pragma("unroll") for(int r=0;r<16;++r){P0[r]=fsub_s(P0[r],dl);P1[r]=fsub_s(P1[r],dl);} \
      if(!(MODE&1)){ _Pragma("unroll") for(int r=0;r<16;++r)negm[r]=-mhat; asm volatile("":"+v"(negm)); } } \
    _Pragma("unroll") for(int r=0;r<16;++r)P0[r]=__builtin_amdgcn_exp2f(P0[r]); }while(0)
  #define RESC() do{ if(resc){ asm volatile("s_waitcnt lgkmcnt(0)":::"memory"); \
      _Pragma("unroll") for(int d_=0;d_<2;++d_) _Pragma("unroll") for(int r=0;r<16;++r)o[d_][r]*=wsf[crow(r,hi)]; } }while(0)
  f32x16 pA0,pA1,pB0,pB1;
  int sl_prev=0,sl_cur=0,sl_next=SLOTB;
  #define ROT() do{sl_prev=sl_cur;sl_cur=sl_next;sl_next=(sl_next==(NSLOT-1)*SLOTB)?0:sl_next+SLOTB;}while(0)
  DMA_K(2,2*SLOTB);
  WAIT_BAR(3);
  qkt(pA0,pA1,Kbase,qr,negm,r32,hi);asm volatile("s_nop 15\n\ts_nop 7":"+v"(pA0),"+v"(pA1));BIASW(pA0,pA1,0);CMASK(pA0,pA1,0);
  START(pA0,pA1);
  _Pragma("unroll") for(int r=0;r<16;++r)pA1[r]=__builtin_amdgcn_exp2f(pA1[r]);
  WAIT_BAR(0);
  DMA_K(3,0);DMA_V(1,SLOTB);
  ROT();
  kload8(kf,kp0+sl_cur);
  WAIT_BAR(2);
  s16x4 vlo[8],vhi[8]; u32x4 pw0,pw1,pw2,pw3;
  #define PKW(P,B) cvtpk_s(P[B],P[B+1])
  #define PAF(k) __builtin_bit_cast(bf16x8,pw##k)
  #define VFR(i) (bf16x8){vlo[i][0],vlo[i][1],vlo[i][2],vlo[i][3],vhi[i][0],vhi[i][1],vhi[i][2],vhi[i][3]}
  #define PIN(x) asm volatile("":"+v"(x))
  #define MX3(a,b,c) __builtin_fmaxf(__builtin_fmaxf((a),(b)),(c))
  #define GAPA(MF,A0,A1,A2,A3,W0,W1,PW) do{ MF; sacc+=A0; sacc+=A1; sacc+=A2; sacc+=A3; PIN(sacc); W0; W1; PIN(PW); SBAR(); }while(0)
  #define EX(v) __builtin_amdgcn_exp2f(v)
  #define GAPB(MF,X,B) do{ MF; X[B]=EX(X[B]); X[B+1]=EX(X[B+1]); X[B+2]=EX(X[B+2]); X[B+3]=EX(X[B+3]); PIN(X); SBAR(); }while(0)
  #define VRD(i) do{ vlo[i]=vtr(vp_+(((i)>>2)*4096+((i)&3)*1024)); vhi[i]=vtr(vp_+(((i)>>2)*4096+((i)&3)*1024+512)); }while(0)
  #define KRD(G,j) do{ if(G){ kload2(kf,kp0+sl_next,j); SBAR(); } }while(0)
  #define STEP(C0,C1,P0,P1,t,GK,GV,GL) do{ SBAR(); \
    const lds_cptr vp_=vp0+sl_prev; \
    VRD(0); SBAR(); float sacc=(P0[0]+P0[1]); \
    GAPA(C0=__builtin_amdgcn_mfma_f32_32x32x16_bf16(kf[0],qr[0],negm,0,0,0), P0[2],P0[3],P0[4],P0[5],     pw0[0]=PKW(P0,0), pw0[1]=PKW(P0,2), pw0); \
    VRD(4); SBAR(); GAPA(C1=__builtin_amdgcn_mfma_f32_32x32x16_bf16(kf[1],qr[0],negm,0,0,0), P0[6],P0[7],P0[8],P0[9],     pw0[2]=PKW(P0,4), pw0[3]=PKW(P0,6), pw0); \
    VRD(1); SBAR(); GAPA(C0=__builtin_amdgcn_mfma_f32_32x32x16_bf16(kf[2],qr[1],C0,0,0,0),   P0[10],P0[11],P0[12],P0[13], pw1[0]=PKW(P0,8), pw1[1]=PKW(P0,10), pw1); \
    VRD(5); SBAR(); GAPA(C1=__builtin_amdgcn_mfma_f32_32x32x16_bf16(kf[3],qr[1],C1,0,0,0),   P0[14],P0[15],P1[0],P1[1],   pw1[2]=PKW(P0,12),pw1[3]=PKW(P0,14), pw1); \
    VRD(2); SBAR(); GAPA(C0=__builtin_amdgcn_mfma_f32_32x32x16_bf16(kf[4],qr[2],C0,0,0,0),   P1[2],P1[3],P1[4],P1[5],     pw2[0]=PKW(P1,0), pw2[1]=PKW(P1,2), pw2); \
    VRD(6); SBAR(); GAPA(C1=__builtin_amdgcn_mfma_f32_32x32x16_bf16(kf[5],qr[2],C1,0,0,0),   P1[6],P1[7],P1[8],P1[9],     pw2[2]=PKW(P1,4), pw2[3]=PKW(P1,6), pw2); \
    VRD(3); SBAR(); GAPA(C0=__builtin_amdgcn_mfma_f32_32x32x16_bf16(kf[6],qr[3],C0,0,0,0),   P1[10],P1[11],P1[12],P1[13], pw3[0]=PKW(P1,8), pw3[1]=PKW(P1,10), pw3); \
    VRD(7); SBAR(); GAPA(C1=__builtin_amdgcn_mfma_f32_32x32x16_bf16(kf[7],qr[3],C1,0,0,0),   P1[14],P1[15],0.f,0.f,       pw3[2]=PKW(P1,12),pw3[3]=PKW(P1,14), pw3); \
    l_reg+=sacc; \
    if(GK){DMA_K((t)+3,sl_cur);} if(GV){DMA_V((t)+1,sl_next);} \
    BIASW(C0,C1,t); CMASK(C0,C1,t); \
    { float a=MX3(C0[0],C0[1],C1[0]),b=MX3(C0[2],C0[3],C1[1]); a=MX3(a,C1[2],C1[3]); \
      _Pragma("unroll") for(int r=4;r<16;r+=4){a=MX3(a,C0[r],C0[r+1]);b=MX3(b,C0[r+2],C0[r+3]);a=MX3(a,C1[r],C1[r+1]);b=MX3(b,C1[r+2],C1[r+3]);} \
      float rm=__builtin_fmaxf(a,b); { auto rr=__builtin_amdgcn_permlane32_swap(__float_as_uint(rm),__float_as_uint(rm),false,false); rm=__builtin_fmaxf(__uint_as_float(rr[0]),__uint_as_float(rr[1])); } \
      resc=false; \
      if(__builtin_expect(__any(rm>(float)THRL),0)){ const float dl=__builtin_fmaxf(rm,0.f); mhat+=dl; \
        _Pragma("unroll") for(int r=0;r<16;++r){C0[r]-=dl;C1[r]-=dl;} \
        if(!(MODE&1)){ _Pragma("unroll") for(int r=0;r<16;++r)negm[r]=-mhat; asm volatile("":"+v"(negm)); } \
        const float f=__builtin_amdgcn_exp2f(-dl); l_reg*=f; if(hi==0)wsf[r32]=f; resc=true; } } \
    SBAR(); \
    GAPB(o[0]=__builtin_amdgcn_mfma_f32_32x32x16_bf16(PAF(0),VFR(0),o[0],0,0,0), C0,0); \
    GAPB(o[1]=__builtin_amdgcn_mfma_f32_32x32x16_bf16(PAF(0),VFR(4),o[1],0,0,0), C0,4); \
    KRD(GL,0); GAPB(o[0]=__builtin_amdgcn_mfma_f32_32x32x16_bf16(PAF(1),VFR(1),o[0],0,0,0), C0,8); \
    KRD(GL,1); GAPB(o[1]=__builtin_amdgcn_mfma_f32_32x32x16_bf16(PAF(1),VFR(5),o[1],0,0,0), C0,12); \
    KRD(GL,2); GAPB(o[0]=__builtin_amdgcn_mfma_f32_32x32x16_bf16(PAF(2),VFR(2),o[0],0,0,0), C1,0); \
    KRD(GL,3); GAPB(o[1]=__builtin_amdgcn_mfma_f32_32x32x16_bf16(PAF(2),VFR(6),o[1],0,0,0), C1,4); \
    GAPB(o[0]=__builtin_amdgcn_mfma_f32_32x32x16_bf16(PAF(3),VFR(3),o[0],0,0,0), C1,8); \
    GAPB(o[1]=__builtin_amdgcn_mfma_f32_32x32x16_bf16(PAF(3),VFR(7),o[1],0,0,0), C1,12); \
    }while(0)
  int t=1;
  #undef CMASK
  #define CMASK(P0,P1,t) do{}while(0)
  for(;t+5<NT;t+=2){
    STEP(pB0,pB1,pA0,pA1,t,true,true,true);     WAIT_BAR(2); RESC(); ROT();
    STEP(pA0,pA1,pB0,pB1,t+1,true,true,true);   WAIT_BAR(2); RESC(); ROT();
  }
  #undef CMASK
  #define CMASK(P0,P1,t) do{int jb_=(t)-(NT-4); if(!(MODE&16)&&jb_>=0)cmask(P0,P1,jb_,qrel,hi);}while(0)
  #define ENDW(tt) do{ if((tt)+3<NT){WAIT_BAR(2);} else if((tt)+2<NT){WAIT_BAR(1);} else {WAIT_BAR(0);} }while(0)
  for(;t+1<NT;t+=2){
    STEP(pB0,pB1,pA0,pA1,t,(t+3<NT),(t+1<NT),(t+1<NT));       ENDW(t);   RESC(); ROT();
    STEP(pA0,pA1,pB0,pB1,t+1,(t+4<NT),(t+2<NT),(t+2<NT));     ENDW(t+1); RESC(); ROT();
  }
  STEP(pB0,pB1,pA0,pA1,NT-1,false,false,false); RESC();
  { float sacc=pB0[0]+pB0[1]; _Pragma("unroll") for(int r=2;r<16;++r)sacc+=pB0[r]; _Pragma("unroll") for(int r=0;r<16;++r)sacc+=pB1[r]; l_reg+=sacc;
    pw0=(u32x4){PKW(pB0,0),PKW(pB0,2),PKW(pB0,4),PKW(pB0,6)};pw1=(u32x4){PKW(pB0,8),PKW(pB0,10),PKW(pB0,12),PKW(pB0,14)};pw2=(u32x4){PKW(pB1,0),PKW(pB1,2),PKW(pB1,4),PKW(pB1,6)};pw3=(u32x4){PKW(pB1,8),PKW(pB1,10),PKW(pB1,12),PKW(pB1,14)};
    SBAR(); pv(o,vb0+sl_cur,PAF(0),PAF(1),PAF(2),PAF(3)); }
  #undef PKW
  #undef PAF
  #undef VFR
  #undef PIN
  #undef MX3
  #undef GAPA
  #undef GAPB
  #undef EX
  #undef VRD
  #undef KRD
  #undef STEP
  #undef ENDW
  {auto rr=__builtin_amdgcn_permlane32_swap(__float_as_uint(l_reg),__float_as_uint(l_reg),false,false);l_reg=__uint_as_float(rr[0])+__uint_as_float(rr[1]);}
  if(MODE&8)l_reg+=__builtin_amdgcn_exp2f(u.sink2+u.slope2*(float)qrel-mhat);
  if((MODE&4)&&hi==0)u.LSE[(long)qrel*u.lses]=mhat+__builtin_amdgcn_logf(l_reg)-u.slope2*(float)qrel;
  if(hi==0)wsf[32+r32]=l_reg;asm volatile("s_waitcnt lgkmcnt(0)":::"memory");
  float rli[16];
  #pragma unroll
  for(int r=0;r<16;++r)rli[r]=__builtin_amdgcn_rcpf(wsf[32+crow(r,hi)]);
  bf16*Ow=u.O+(long)(wid*QBLK)*u.os;
  { bf16*stg=(bf16*)(shm+LDS_OST)+wid*2048;
    #pragma unroll
    for(int r=0;r<16;++r){const int orow=crow(r,hi);
      #pragma unroll
      for(int d0=0;d0<2;++d0)stg[orow*64+d0*32+r32]=__float2bfloat16(o[d0][r]*rli[r]);}
    asm volatile("s_waitcnt lgkmcnt(0)":::"memory");
    #pragma unroll
    for(int i=0;i<4;++i){const int row=i*8+(lane>>3),ch=lane&7; const u32x4 v=*(const u32x4*)(stg+row*64+ch*8); ATTN_STORE16(Ow+(long)row*u.os+ch*8,v);} }
  asm volatile("s_waitcnt lgkmcnt(0)\n\ts_barrier":::"memory");
  #undef DMA_K
  #undef DMA_V
  #undef CMASK
  #undef BIASW
  #undef START
  #undef RESC
  #undef ROT
}
constexpr int ATTN_LDS_BYTES=LDS_BYTES;
#undef SBAR
#undef WAIT_BAR
}
#define GAS __attribute__((address_space(1)))
#define LAS __attribute__((address_space(3)))
typedef unsigned short bf16;
typedef unsigned v4u __attribute__((ext_vector_type(4)));
typedef float f32x4 __attribute__((ext_vector_type(4)));
typedef short bf16x8 __attribute__((ext_vector_type(8)));
typedef GAS unsigned gu32;
typedef GAS unsigned long long gu64;
#define RLX_AGENT __ATOMIC_RELAXED, __HIP_MEMORY_SCOPE_AGENT
#define LDS_WAIT() asm volatile("s_waitcnt lgkmcnt(0)" ::: "memory")
#define VM_WAIT() asm volatile("s_waitcnt vmcnt(0)" ::: "memory")
__device__ __forceinline__ unsigned long long rt() { return __builtin_amdgcn_s_memrealtime(); }
__device__ __forceinline__ unsigned f2bf(float f) { unsigned u = __builtin_bit_cast(unsigned, f); return (u + 0x7fffu + ((u >> 16) & 1u)) >> 16; }
__device__ __forceinline__ unsigned pk2(float lo, float hi) { return f2bf(lo) | (f2bf(hi) << 16); }

#define XB_TMO      128
#define XB_XCNT(j)  (256  + 64 * (j))
#define XB_XSUB(j)  (1280 + 64 * (j))
#define XB_XGEN(j)  (2304 + 64 * (j))
#define XB_TOP      3328
#define XB_TOPGEN   3392
#define XCD_BAR_WORDS 3456
#define XB_SPIN_CAP (1u << 24)

__device__ __forceinline__ unsigned xb_ld(unsigned* p)              { return __hip_atomic_load(p, __ATOMIC_RELAXED, __HIP_MEMORY_SCOPE_AGENT); }
__device__ __forceinline__ unsigned xb_add(unsigned* p, unsigned v) { return __hip_atomic_fetch_add(p, v, __ATOMIC_RELAXED, __HIP_MEMORY_SCOPE_AGENT); }
__device__ __forceinline__ unsigned xb_xcc_id() { return (unsigned)__builtin_amdgcn_s_getreg((3 << 11) | 20) & 0xFu; }
#define XB_SPIN(cond, bar) do { unsigned _sp = 0; while (cond) { __builtin_amdgcn_s_sleep(1); \
    if ((++_sp & 255u) == 0u) { if (xb_ld(&(bar)[XB_TMO])) break; if (_sp > XB_SPIN_CAP) { atomicAdd(&(bar)[XB_TMO], 1u); break; } } } } while (0)

struct XcdBarrier {
    unsigned* bar; unsigned x;
    volatile LAS unsigned* st;
};

__device__ __forceinline__ XcdBarrier xcd_barrier_post(unsigned* bar, volatile LAS unsigned* st) {
    XcdBarrier b; b.bar = bar; b.x = xb_xcc_id(); b.st = st;
    if (opq_tid() == 0) (void)xb_add(&bar[XB_XCNT(b.x)], 1u);
    return b;
}
__device__ __forceinline__ void xcd_barrier_complete(unsigned* bar, unsigned x, unsigned& nloc, unsigned& nx) {
    const unsigned G = gridDim.x * gridDim.y * gridDim.z;
    unsigned sum, cnt, mine, sp = 0u;
    for (;;) {
        sum = 0u; cnt = 0u; mine = 0u;
#pragma unroll
        for (unsigned j = 0; j < 16; ++j) { const unsigned c = xb_ld(&bar[XB_XCNT(j)]); sum += c; cnt += (c > 0u) ? 1u : 0u; mine = (j == x) ? c : mine; }
        if (sum == G) break;
        __builtin_amdgcn_s_sleep(1);
        if ((++sp & 255u) == 0u) { if (xb_ld(&bar[XB_TMO])) break; if (sp > XB_SPIN_CAP) { atomicAdd(&bar[XB_TMO], 1u); break; } }
    }
    nloc = mine > 0u ? mine : 1u; nx = cnt > 0u ? cnt : 1u;
}

__device__ __forceinline__ void xcd_barrier(const XcdBarrier& b) {
    asm volatile("s_waitcnt vmcnt(0)" ::: "memory");
    __syncthreads();
    if (opq_tid() == 0) {
        unsigned* bar = b.bar;
        __builtin_amdgcn_s_waitcnt(0);
        unsigned nloc = b.st[0], nx = b.st[1];
        if (nloc == 0u) { xcd_barrier_complete(bar, b.x, nloc, nx); b.st[0] = nloc; b.st[1] = nx; }
        const unsigned old = xb_add(&bar[XB_XSUB(b.x)], 1u);
        const unsigned gen = old / nloc;
        if (old + 1u == (gen + 1u) * nloc) {
            __builtin_amdgcn_fence(__ATOMIC_RELEASE, "agent");
            asm volatile("s_waitcnt vmcnt(0)" ::: "memory");
            const unsigned og = xb_add(&bar[XB_TOP], 1u);
            const unsigned tg = og / nx;
            if (og + 1u == (tg + 1u) * nx) xb_add(&bar[XB_TOPGEN], 1u);
            else XB_SPIN(xb_ld(&bar[XB_TOPGEN]) == tg, bar);
            __builtin_amdgcn_fence(__ATOMIC_ACQUIRE, "agent");
            xb_add(&bar[XB_XGEN(b.x)], 1u);
            asm volatile("s_waitcnt vmcnt(0)" ::: "memory");
        } else {
            XB_SPIN(xb_ld(&bar[XB_XGEN(b.x)]) == gen, bar);
            __builtin_amdgcn_fence(__ATOMIC_ACQUIRE, "agent");
            asm volatile("s_waitcnt vmcnt(0)" ::: "memory");
        }
    }
    __syncthreads();
}
namespace mk {
constexpr int NB = 2, S = 8192, D = 1024, T = NB * S, NL = 2, NW = 2404, NP = 2560;
constexpr int OFF_CQ = 0, OFF_CKV = 192, OFF_KR = 320, OFF_PB = 352, OFF_PC = 1120, OFF_FG = 1888, OFF_PDQ = 1892, OFF_PDKV = 2148;
constexpr float EPS = 1e-6f, LOG2E = 1.4426950408889634f, C2 = 0.125f * 1.4426950408889634f;
constexpr int NWAVES = 8, NTHR = 512;
constexpr size_t MiB = 1u << 20;
constexpr size_t WS_CTL = 0, CTL_ZERO_BYTES = 1 * MiB;
constexpr size_t WS_WIN = 1 * MiB;
constexpr size_t WS_WO = 11 * MiB;
constexpr size_t WS_WUQ = 15 * MiB;
constexpr size_t WS_WUKV = 15 * MiB + MiB / 2;
constexpr size_t WS_W13 = 16 * MiB;
constexpr size_t WS_W2 = 80 * MiB;
constexpr size_t WS_ACT = 112 * MiB;
constexpr size_t WS_QKV = 144 * MiB;
constexpr size_t WS_R8 = 232 * MiB, WS_R9 = 240 * MiB;
constexpr size_t WS_LF = 248 * MiB, WS_CUM = WS_LF + MiB / 4, WS_EXP = 249 * MiB, WS_GATE = WS_EXP + MiB / 4;
constexpr size_t WS_PART = 250 * MiB;
constexpr size_t WS_LSEP = 274 * MiB;
constexpr size_t WS_Y0 = 144 * MiB, WS_Y1 = 176 * MiB;
constexpr size_t WS_HID = 208 * MiB;
constexpr size_t WS_WR = 275 * MiB;
constexpr size_t WS_LSEA = 275 * MiB + MiB / 2;
constexpr size_t WS_LIST = 276 * MiB;
constexpr size_t WS_END = 278 * MiB;
constexpr int CW_Q = 1536;
constexpr int CW_CNT = 2048;
constexpr size_t QKV_STRIDE = (size_t)T * 256;
enum { IQA = 0, IKA, IVA, IQB, IKB, IVB, IQC, IKC, IVC, IQD };
constexpr int CW_BAR = 4096;
constexpr int RING_BYTES = 131072, LDSCTL_OFF = RING_BYTES, MISC_OFF = LDSCTL_OFF + 320, LDS_BYTES = 147456;
constexpr int LDS_TILES = RING_BYTES + 1024, LDS_NTI = RING_BYTES + 2560, LDS_TAB = RING_BYTES + 3072;
constexpr int PPL = 9, NPHASE = 1 + PPL * NL;

__device__ __forceinline__ float bf2f(bf16 v) { return __uint_as_float((unsigned)v << 16); }
__device__ __forceinline__ float wave_sum(float v) {
  v += xor_lane<1>(v); v += xor_lane<2>(v); v += xor_lane<4>(v); v += xor_lane<8>(v); v += xor_lane<16>(v); v += xor_lane<32>(v);
  return v;
}
__device__ __forceinline__ float log_sigmoid(float x) { return fminf(x, 0.f) - log1pf(expf(-fabsf(x))); }

__device__ __forceinline__ void tr_item(const float* W, int ldw, int srccol0, int nvalid, bf16* WT, int K, int dstrow0, int k0, LAS float* scr, int lane) {
  const int n_ = lane & 31;
#pragma unroll 8
  for (int i = 0; i < 32; ++i) { const int kk = 2 * i + (lane >> 5); scr[kk * 33 + n_] = (n_ < nvalid) ? W[(size_t)(k0 + kk) * ldw + srccol0 + n_] : 0.f; }
  LDS_WAIT(); asm volatile("" ::: "memory");
  const int c = lane & 7;
#pragma unroll
  for (int j = 0; j < 4; ++j) { const int n = (lane >> 3) + 8 * j; const LAS float* s = scr + (8 * c) * 33 + n;
    v4u o; o.x = pk2(s[0 * 33], s[1 * 33]); o.y = pk2(s[2 * 33], s[3 * 33]); o.z = pk2(s[4 * 33], s[5 * 33]); o.w = pk2(s[6 * 33], s[7 * 33]);
    *(GAS v4u*)(WT + (size_t)(dstrow0 + n) * K + k0 + 8 * c) = o; }
  LDS_WAIT(); asm volatile("" ::: "memory");
}
__device__ __forceinline__ void win_src(int n0, int& sc, int& nv) {
  const int pn = n0 >> 8, p = n0 & 255, lc = 64 * ((p >> 5) & 3) + 32 * (p >> 7);
  nv = 32; sc = 0;
  if (pn < 3) sc = OFF_PB + pn * 256 + lc;
  else if (pn < 6) sc = OFF_PC + (pn - 3) * 256 + lc;
  else if (pn == 6) sc = OFF_PDQ + lc;
  else if (pn == 7) sc = OFF_PDKV + lc;
  else if (pn == 8) { sc = OFF_CQ + lc; if (lc >= 192) { nv = 0; sc = 0; } }
  else { if (lc < 128) sc = OFF_CKV + lc; else if (lc < 160) sc = OFF_KR + lc - 128; else if (lc < 192) { sc = OFF_FG; nv = 4; } else { sc = 0; nv = 0; } }
}
__device__ __forceinline__ void prep_rows(const float* X, const bf16* y0, const bf16* y1, float* xout, bf16* XN, const float* g1, int gw, int NGW, int lane) {
  for (int m = gw; m < T; m += NGW) {
    const GAS f32x4* xr = (const GAS f32x4*)(X + (size_t)m * D) + lane;
    f32x4 v[4]; float ss = 0.f;
#pragma unroll
    for (int j = 0; j < 4; ++j) {
      v[j] = xr[64 * j];
      if (y0) {
        const unsigned long long a = *((const GAS unsigned long long*)(y0 + (size_t)m * D) + lane + 64 * j), b = *((const GAS unsigned long long*)(y1 + (size_t)m * D) + lane + 64 * j);
        v[j].x += __uint_as_float((unsigned)a << 16) + __uint_as_float((unsigned)b << 16);
        v[j].y += __uint_as_float((unsigned)a & 0xffff0000u) + __uint_as_float((unsigned)b & 0xffff0000u);
        v[j].z += __uint_as_float((unsigned)(a >> 32) << 16) + __uint_as_float((unsigned)(b >> 32) << 16);
        v[j].w += __uint_as_float((unsigned)(a >> 32) & 0xffff0000u) + __uint_as_float((unsigned)(b >> 32) & 0xffff0000u);
      }
      ss += (v[j].x * v[j].x + v[j].y * v[j].y) + (v[j].z * v[j].z + v[j].w * v[j].w);
    }
    if (xout) {
#pragma unroll
      for (int j = 0; j < 4; ++j) ((GAS f32x4*)(xout + (size_t)m * D) + lane)[64 * j] = v[j];
    }
    if (XN) {
      const float rstd = rsqrtf(wave_sum(ss) * (1.f / D) + EPS);
      GAS unsigned long long* o8 = (GAS unsigned long long*)(XN + (size_t)m * D) + lane;
#pragma unroll
      for (int j = 0; j < 4; ++j) { const f32x4 g = *((const GAS f32x4*)g1 + lane + 64 * j);
        o8[64 * j] = (unsigned long long)pk2(v[j].x * rstd * g.x, v[j].y * rstd * g.y) | ((unsigned long long)pk2(v[j].z * rstd * g.z, v[j].w * rstd * g.w) << 32); }
    }
  }
}

struct EpiInProj {
  static constexpr bool PERM = true, AFTER_DRAIN = false;
  bf16* qkv; bf16* R8; bf16* R9; float* LF; const float* gq; const float* gk; const float* bfox;
  __device__ __forceinline__ void operator()(const pg8::f32x4 (&acc)[2][2][4][2], const pg8::Unit& u, int wr, int wc, int fr, int fq) const {
    const int pn = u.pn;
    bf16* dst; int pitch = 256, cb = 64 * wc; const float* g = nullptr; float sc = 1.f;
    if (pn < 6) { dst = qkv + (size_t)(IQB + pn) * QKV_STRIDE; const int r3 = pn % 3, mx = 1 + pn / 3; if (r3 == 0) { g = gq + mx * 64; sc = C2; } else if (r3 == 1) g = gk + mx * 64; }
    else if (pn == 6) { dst = qkv + (size_t)IQD * QKV_STRIDE; g = gq + 3 * 64; sc = C2; }
    else if (pn == 7) { pitch = 128; if (wc < 2) { dst = qkv + 10 * QKV_STRIDE; g = gk + 3 * 64; } else { dst = qkv + 10 * QKV_STRIDE + (size_t)T * 128; cb = 64 * (wc - 2); } }
    else if (pn == 8) dst = R8; else dst = R9;
    const int rowb = u.pm * 256 + wr * 64 + fr;
    if (g) {
      pg8::f32x4 gv[2][2];
#pragma unroll
      for (int bj = 0; bj < 2; ++bj)
#pragma unroll
        for (int n = 0; n < 2; ++n) gv[bj][n] = *(const pg8::f32x4*)(g + 32 * bj + 8 * fq + 4 * n) * sc;
#pragma unroll
      for (int ai = 0; ai < 2; ++ai)
#pragma unroll
        for (int m = 0; m < 4; ++m) {
          float ss = 0.f;
#pragma unroll
          for (int bj = 0; bj < 2; ++bj)
#pragma unroll
            for (int n = 0; n < 2; ++n) { const pg8::f32x4 x = acc[ai][bj][m][n]; ss += (x[0] * x[0] + x[1] * x[1]) + (x[2] * x[2] + x[3] * x[3]); }
          ss += xor_lane<16>(ss); ss += xor_lane<32>(ss);
          const float rstd = rsqrtf(ss * (1.f / 64.f) + EPS);
          bf16* rp = dst + (size_t)(rowb + ai * 128 + m * 16) * pitch + cb + 8 * fq;
#pragma unroll
          for (int bj = 0; bj < 2; ++bj) { const pg8::f32x4 v0 = acc[ai][bj][m][0] * gv[bj][0] * rstd, v1 = acc[ai][bj][m][1] * gv[bj][1] * rstd;
            pg8::u32x4 w; w.x = pg8::cvt_pk_bf16(v0[0], v0[1]); w.y = pg8::cvt_pk_bf16(v0[2], v0[3]); w.z = pg8::cvt_pk_bf16(v1[0], v1[1]); w.w = pg8::cvt_pk_bf16(v1[2], v1[3]);
            *(pg8::u32x4*)(rp + 32 * bj) = w; }
        }
    } else {
#pragma unroll
      for (int ai = 0; ai < 2; ++ai)
#pragma unroll
        for (int m = 0; m < 4; ++m) {
          bf16* rp = dst + (size_t)(rowb + ai * 128 + m * 16) * pitch + cb + 8 * fq;
#pragma unroll
          for (int bj = 0; bj < 2; ++bj) { const pg8::f32x4 v0 = acc[ai][bj][m][0], v1 = acc[ai][bj][m][1];
            pg8::u32x4 w; w.x = pg8::cvt_pk_bf16(v0[0], v0[1]); w.y = pg8::cvt_pk_bf16(v0[2], v0[3]); w.z = pg8::cvt_pk_bf16(v1[0], v1[1]); w.w = pg8::cvt_pk_bf16(v1[2], v1[3]);
            *(pg8::u32x4*)(rp + 32 * bj) = w; }
        }
      if (pn == 9 && wc == 2 && fq == 0) {
        const pg8::f32x4 bb = *(const pg8::f32x4*)bfox;
#pragma unroll
        for (int ai = 0; ai < 2; ++ai)
#pragma unroll
          for (int m = 0; m < 4; ++m) { const pg8::f32x4 v = acc[ai][1][m][0] + bb; pg8::f32x4 o;
            o[0] = log_sigmoid(v[0]); o[1] = log_sigmoid(v[1]); o[2] = log_sigmoid(v[2]); o[3] = log_sigmoid(v[3]);
            *(pg8::f32x4*)(LF + (size_t)(rowb + ai * 128 + m * 16) * 4) = o; }
      }
    }
  }
};

struct EpiResF32 {
  static constexpr bool PERM = false, AFTER_DRAIN = false;
  const float* R; float* C;
  __device__ __forceinline__ void operator()(const pg8::f32x4 (&acc)[2][2][4][2], const pg8::Unit& u, int wr, int wc, int fr, int fq) const {
    const int row0 = u.pm * 256 + wr * 64 + fr, col0 = u.pn * 256 + wc * 32 + 4 * fq;
#pragma unroll
    for (int ai = 0; ai < 2; ++ai)
#pragma unroll
      for (int m = 0; m < 4; ++m) { const size_t off = (size_t)(row0 + ai * 128 + m * 16) * D + col0;
#pragma unroll
        for (int bj = 0; bj < 2; ++bj)
#pragma unroll
          for (int n = 0; n < 2; ++n) { const size_t o = off + bj * 128 + n * 16; *(pg8::f32x4*)(C + o) = *(const pg8::f32x4*)(R + o) + acc[ai][bj][m][n]; } }
  }
};

__device__ __forceinline__ void n_post(LAS unsigned char* lds, const bf16* R8, const bf16* R9, const float* gcq, const float* gckv, const float* wuq, const float* wukv,
                                       const float* gq0, const float* gk0, bf16* QA, bf16* KA, bf16* VA) {
  LAS float* cqn = (LAS float*)lds; LAS float* ckvn = cqn + 192; LAS float* kva = ckvn + 128; LAS float* tmp = kva + 384; LAS float* red = tmp + 256; LAS float* krs = red + 8;
  const int tid = opq_tid(), lane = tid & 63, w = tid >> 6;
  for (int t = blockIdx.x; t < T; t += gridDim.x) {
    const int pos = t % S;
    const float vq = (tid < 192) ? bf2f(R8[(size_t)t * 256 + tid]) : 0.f;
    const float vk = (tid < 128) ? bf2f(R9[(size_t)t * 256 + tid]) : 0.f;
    const float sq = wave_sum(vq * vq), sk = wave_sum(vk * vk);
    if (lane == 0 && w < 4) { red[w] = sq; red[4 + w] = sk; }
    if (tid < 32) krs[tid] = bf2f(R9[(size_t)t * 256 + 128 + tid]);
    __syncthreads();
    const float rq = rsqrtf((red[0] + red[1] + red[2] + red[3]) * (1.f / 192.f) + EPS);
    const float rk = rsqrtf((red[4] + red[5] + red[6] + red[7]) * (1.f / 128.f) + EPS);
    if (tid < 192) cqn[tid] = vq * rq * gcq[tid];
    if (tid < 128) ckvn[tid] = vk * rk * gckv[tid];
    __syncthreads();
    float qa = 0.f, ka = 0.f;
    if (tid < 256) {
      float k0 = 0.f, k1 = 0.f;
      for (int i = 0; i < 192; ++i) qa += cqn[i] * wuq[i * 256 + tid];
      for (int i = 0; i < 128; ++i) { k0 += ckvn[i] * wukv[i * 384 + tid]; if (tid < 128) k1 += ckvn[i] * wukv[i * 384 + 256 + tid]; }
      kva[tid] = k0; if (tid < 128) kva[256 + tid] = k1;
      const float ss = wave_sum(qa * qa);
      qa = qa * rsqrtf(ss * (1.f / 64.f) + EPS) * gq0[lane];
      tmp[tid] = qa;
    }
    __syncthreads();
    float cs = 1.f, sn = 0.f;
    if (tid < 256 && lane >= 32) { const int j = (lane - 32) & 15; const float inv = powf(10000.f, -(float)(2 * j) / 32.f); const float ang = (float)pos * inv; cs = cosf(ang); sn = sinf(ang); }
    if (tid < 256) {
      float o = qa;
      if (lane >= 32) { if (lane < 48) o = qa * cs - tmp[tid + 16] * sn; else o = qa * cs + tmp[tid - 16] * sn; }
      QA[(size_t)t * 256 + tid] = (bf16)f2bf(o * C2);
      ka = (lane < 32) ? kva[w * 96 + lane] : krs[lane - 32];
      const float ss = wave_sum(ka * ka);
      ka = ka * rsqrtf(ss * (1.f / 64.f) + EPS) * gk0[lane];
    }
    __syncthreads();
    if (tid < 256) tmp[tid] = ka;
    __syncthreads();
    if (tid < 256) {
      float o = ka;
      if (lane >= 32) { if (lane < 48) o = ka * cs - tmp[tid + 16] * sn; else o = ka * cs + tmp[tid - 16] * sn; }
      KA[(size_t)t * 256 + tid] = (bf16)f2bf(o);
      VA[(size_t)t * 256 + tid] = (bf16)f2bf(kva[w * 96 + 32 + lane]);
    }
    __syncthreads();
  }
}
__device__ __forceinline__ void n_cumsum(LAS unsigned char* lds, const float* LF, float* CUM) {
  LAS float* part = (LAS float*)lds + 2048;
  const int tid = opq_tid(); constexpr int per = S / NTHR;
  for (int item = blockIdx.x; item < NB * 4; item += gridDim.x) {
    const int b = item >> 2, h = item & 3;
    float s = 0.f;
    for (int i = 0; i < per; ++i) s += LF[((size_t)b * S + tid * per + i) * 4 + h];
    part[tid] = s;
    __syncthreads();
    if (tid == 0) { float a = 0.f; for (int i = 0; i < NTHR; ++i) { const float v = part[i]; part[i] = a; a += v; } }
    __syncthreads();
    float a = part[tid];
    for (int i = 0; i < per; ++i) { a += LF[((size_t)b * S + tid * per + i) * 4 + h]; CUM[((size_t)b * S + tid * per + i) * 4 + h] = a; }
    __syncthreads();
  }
}
struct Soft { float m, l, o; };
__device__ __forceinline__ void soft_add(Soft& st, float logit2, float v) {
  const float mn = fmaxf(st.m, logit2);
  const float a = exp2f(st.m - mn), pp = exp2f(logit2 - mn);
  st.l = st.l * a + pp; st.o = st.o * a + pp * v; st.m = mn;
}
__device__ __forceinline__ void n_attn(const bf16* qkv, const float* CUM, const float* sink, bf16* MIX, int mask) {
  const int tid_ = opq_tid(), lane = tid_ & 63, wpb = NTHR >> 6;
  const long nitems = (long)T * 16;
  for (long it = (long)blockIdx.x * wpb + (tid_ >> 6); it < nitems; it += (long)gridDim.x * wpb) {
    const int t = T - 1 - (int)(it >> 4), mh = (int)(it & 15), mixer = mh >> 2, h = mh & 3;
    if (!((mask >> mixer) & 1)) continue;
    const int b = t / S, pos = t % S; const long base = (long)b * S;
    Soft st; st.m = -INFINITY; st.l = 0.f; st.o = 0.f;
    if (mixer == 0 || mixer == 2) {
      const bf16* Q = qkv + (size_t)(mixer == 0 ? IQA : IQC) * QKV_STRIDE; const bf16* K = Q + QKV_STRIDE; const bf16* V = K + QKV_STRIDE;
      const float q = bf2f(Q[(size_t)t * 256 + h * 64 + lane]);
      const float ct = (mixer == 2) ? CUM[(size_t)t * 4 + h] : 0.f;
      for (int s = 0; s <= pos; ++s) {
        float d = wave_sum(q * bf2f(K[(size_t)(base + s) * 256 + h * 64 + lane]));
        if (mixer == 2) d += (ct - CUM[(size_t)(base + s) * 4 + h]) * LOG2E;
        soft_add(st, d, bf2f(V[(size_t)(base + s) * 256 + h * 64 + lane]));
      }
    } else if (mixer == 3) {
      const bf16* Q = qkv + (size_t)IQD * QKV_STRIDE; const bf16* K = qkv + 10 * QKV_STRIDE; const bf16* V = K + (size_t)T * 128;
      const int hk = h >> 1;
      const float q = bf2f(Q[(size_t)t * 256 + h * 64 + lane]);
      const float slope = exp2f(-(float)(h + 1)) * LOG2E;
      const int s0 = pos - 127 < 0 ? 0 : pos - 127;
      for (int s = s0; s <= pos; ++s) {
        const float d = wave_sum(q * bf2f(K[(size_t)(base + s) * 128 + hk * 64 + lane])) - slope * (float)(pos - s);
        soft_add(st, d, bf2f(V[(size_t)(base + s) * 128 + hk * 64 + lane]));
      }
      const float sk = sink[h] * LOG2E;
      const float mn = fmaxf(st.m, sk), a = exp2f(st.m - mn);
      st.l = st.l * a + exp2f(sk - mn); st.o *= a; st.m = mn;
    } else {
      const bf16* Q = qkv + (size_t)IQB * QKV_STRIDE; const bf16* K = Q + QKV_STRIDE; const bf16* V = K + QKV_STRIDE;
      const float q = bf2f(Q[(size_t)t * 256 + h * 64 + lane]);
      const float slope = exp2f(-(float)(h + 5)) * LOG2E;
      for (int br = 0; br < 3; ++br) {
        const int dil = br == 0 ? 1 : (br == 1 ? 4 : 16);
        for (int j = 0; j <= 128; ++j) {
          const int s = pos - dil * j;
          if (s < 0) break;
          const float d = wave_sum(q * bf2f(K[(size_t)(base + s) * 256 + h * 64 + lane])) - slope * (float)(dil * j);
          soft_add(st, d, bf2f(V[(size_t)(base + s) * 256 + h * 64 + lane]));
        }
      }
    }
    MIX[(size_t)t * D + mixer * 256 + h * 64 + lane] = (bf16)f2bf(st.o / st.l);
  }
}
__device__ __forceinline__ void n_wo(LAS unsigned char* lds, const bf16* A, const float* Bm, const float* R, float* C) {
  LAS float* As = (LAS float*)lds;
  LAS float* Bs = As + 16 * 129;
  const int tid = opq_tid(), tx = tid & 15, ty = tid >> 4;
  for (int tile = blockIdx.x; tile < (T / 128) * (D / 64); tile += gridDim.x) {
    const int m0 = (tile / (D / 64)) * 128, n0 = (tile % (D / 64)) * 64;
    float acc[4][4];
#pragma unroll
    for (int i = 0; i < 4; ++i)
#pragma unroll
      for (int j = 0; j < 4; ++j) acc[i][j] = 0.f;
    for (int k0 = 0; k0 < D; k0 += 16) {
#pragma unroll
      for (int r = 0; r < 4; ++r) { const int i = tid + NTHR * r, m = i >> 4, k = i & 15; As[k * 129 + m] = bf2f(A[(size_t)(m0 + m) * D + k0 + k]); }
#pragma unroll
      for (int r = 0; r < 2; ++r) { const int i = tid + NTHR * r, k = i >> 6, n = i & 63; Bs[k * 64 + n] = Bm[(size_t)(k0 + k) * D + n0 + n]; }
      __syncthreads();
#pragma unroll
      for (int k = 0; k < 16; ++k) {
        float a[4], b[4];
#pragma unroll
        for (int i = 0; i < 4; ++i) { a[i] = As[k * 129 + ty * 4 + i]; b[i] = Bs[k * 64 + tx * 4 + i]; }
#pragma unroll
        for (int i = 0; i < 4; ++i)
#pragma unroll
          for (int j = 0; j < 4; ++j) acc[i][j] += a[i] * b[j];
      }
      __syncthreads();
    }
#pragma unroll
    for (int i = 0; i < 4; ++i)
#pragma unroll
      for (int j = 0; j < 4; ++j) { const size_t o = (size_t)(m0 + ty * 4 + i) * D + n0 + tx * 4 + j; C[o] = R[o] + acc[i][j]; }
  }
}
__device__ __forceinline__ void n_route(const float* H, const float* g2, const float* wrg, const float* brg, const float* wre, const float* bre, bf16* HN, int* EXPI, float* GATE, unsigned* cnt, int* LIST) {
  const int tid_ = opq_tid(), lane = tid_ & 63, wpb = NTHR >> 6;
  for (int t = blockIdx.x * wpb + (tid_ >> 6); t < T; t += gridDim.x * wpb) {
    const float* hr = H + (size_t)t * D;
    float v[16], ss = 0.f;
#pragma unroll
    for (int j = 0; j < 16; ++j) { v[j] = hr[lane + 64 * j]; ss += v[j] * v[j]; }
    ss = wave_sum(ss);
    const float rstd = rsqrtf(ss * (1.f / D) + EPS);
#pragma unroll
    for (int j = 0; j < 16; ++j) { v[j] = v[j] * rstd * g2[lane + 64 * j]; HN[(size_t)t * D + lane + 64 * j] = (bf16)f2bf(v[j]); }
    float gl[4];
#pragma unroll
    for (int g = 0; g < 4; ++g) {
      float a = 0.f;
#pragma unroll
      for (int j = 0; j < 16; ++j) a += v[j] * wrg[(size_t)(lane + 64 * j) * 4 + g];
      gl[g] = wave_sum(a) + brg[g];
    }
    int gs = 0; float gm = gl[0];
#pragma unroll
    for (int g = 1; g < 4; ++g) if (gl[g] > gm) { gm = gl[g]; gs = g; }
    float den = 0.f;
#pragma unroll
    for (int g = 0; g < 4; ++g) den += expf(gl[g] - gm);
    const float pg = 1.f / den;
    float el[8];
#pragma unroll
    for (int e = 0; e < 8; ++e) {
      float a = 0.f;
#pragma unroll
      for (int j = 0; j < 16; ++j) a += v[j] * wre[(size_t)(lane + 64 * j) * 32 + gs * 8 + e];
      el[e] = wave_sum(a) + bre[gs * 8 + e];
    }
    int i1 = 0; float m1 = el[0];
#pragma unroll
    for (int e = 1; e < 8; ++e) if (el[e] > m1) { m1 = el[e]; i1 = e; }
    int i2 = 0; float m2 = -INFINITY;
#pragma unroll
    for (int e = 0; e < 8; ++e) if (e != i1 && el[e] > m2) { m2 = el[e]; i2 = e; }
    const float e2 = expf(m2 - m1);
    if (lane == 0) {
      EXPI[t * 2] = gs * 8 + i1; EXPI[t * 2 + 1] = gs * 8 + i2;
      GATE[t * 2] = pg / (1.f + e2); GATE[t * 2 + 1] = pg * e2 / (1.f + e2);
      const int ea = gs * 8 + i1, eb = gs * 8 + i2;
      const unsigned sa = atomicAdd(cnt + ea, 1u), sb = atomicAdd(cnt + eb, 1u);
      LIST[(size_t)ea * T + sa] = t * 2; LIST[(size_t)eb * T + sb] = t * 2 + 1;
    }
  }
}
__device__ __forceinline__ void n_moe(LAS unsigned char* lds, const bf16* HN, const int* EXPI, const float* GATE, const float* w1, const float* w3, const float* w2, float* hio, bf16* ybf) {
  LAS float* xs = (LAS float*)lds; LAS float* sa = xs + D; LAS float* hid = sa + 512;
  const int tid = opq_tid(), j = tid & 255, half = tid >> 8;
  for (int t = blockIdx.x; t < T; t += gridDim.x) {
    for (int i = tid; i < D; i += NTHR) xs[i] = bf2f(HN[(size_t)t * D + i]);
    __syncthreads();
    float y0 = 0.f, y1 = 0.f;
    for (int k = 0; k < 2; ++k) {
      const int e = EXPI[t * 2 + k]; const float gt = GATE[t * 2 + k];
      const float* W13 = (half ? w3 : w1) + (size_t)e * D * 256; const float* W2 = w2 + (size_t)e * 256 * D;
      float a = 0.f;
      for (int i = 0; i < D; ++i) a += xs[i] * W13[(size_t)i * 256 + j];
      sa[tid] = a;
      __syncthreads();
      if (tid < 256) { const float av = sa[tid], cv = sa[256 + tid]; hid[tid] = av / (1.f + expf(-av)) * cv * gt; }
      __syncthreads();
      for (int jj = 0; jj < 256; ++jj) { const float hv = hid[jj]; y0 += hv * W2[(size_t)jj * D + tid]; y1 += hv * W2[(size_t)jj * D + tid + 512]; }
      __syncthreads();
    }
    if (ybf) { ybf[(size_t)t * D + tid] = (bf16)f2bf(y0); ybf[(size_t)t * D + tid + 512] = (bf16)f2bf(y1); } else { hio[(size_t)t * D + tid] += y0; hio[(size_t)t * D + tid + 512] += y1; }
  }
}

#ifndef FASTMASK
#define FASTMASK 1
#endif
#ifndef TIME_K
#define TIME_K 8
#endif
#ifndef CHK_GAIN
#define CHK_GAIN 10.f
#endif
typedef attn_body::bf16 abf;
template <int MODE> __device__ __forceinline__ void run_unit(const attn_body::AU& u, unsigned char* lds_raw) { attn_body::attn_unit<8, MODE>(u, (char*)lds_raw); }
constexpr int NU_AS = 256, NU_AW = 128, NU_C = 256, NU_B = 768, NU_D = 256, NU_ALL = NU_AS + NU_AW + NU_C + NU_B + NU_D;
constexpr int LDS_QW = RING_BYTES + 8192;
__device__ __forceinline__ void f_attn(unsigned char* lds_raw, LAS unsigned char* lds, bf16* QKV, const float* CUM, const float* sink, const float* gq2, const float* gk2, bf16* MIX, bf16* PART, float* LSEP, bf16* PARTA, float* LSEA, unsigned* qctr) {
  LAS float* bt = (LAS float*)(lds + attn_body::LDS_BIAS);
  volatile LAS int* qw = (volatile LAS int*)(lds + LDS_QW);
  for (;;) {
    const int tid = opq_tid();
    if (tid == 0) qw[0] = (int)atomicAdd(qctr, 1u);
    __syncthreads();
    const int uidx = __builtin_amdgcn_readfirstlane(qw[0]);
    if (uidx >= NU_ALL) break;
    if (uidx < NU_AS + NU_AW) {
      int qb, half = -1; const int bh = uidx & 7;
      if (uidx < NU_AS) { qb = 31 - (uidx >> 4); half = (uidx >> 3) & 1; } else qb = 15 - ((uidx - NU_AS) >> 3);
      const int b = bh >> 2, h = bh & 3; const size_t r0 = (size_t)b * S; const int NT = 4 * qb + 4;
      attn_body::AU u{}; u.Q = (const abf*)(QKV + (size_t)IQA * QKV_STRIDE + (r0 + 256 * qb) * 256 + h * 64); u.qs = 256; u.ks = 256;
      const size_t k0 = (half == 1) ? (size_t)(NT / 2) * 64 : 0;
      u.K = (const abf*)(QKV + (size_t)IKA * QKV_STRIDE + (r0 + k0) * 256 + h * 64); u.V = (const abf*)(QKV + (size_t)IVA * QKV_STRIDE + (r0 + k0) * 256 + h * 64);
      if (half < 0) { u.O = (abf*)(MIX + (r0 + 256 * qb) * D + h * 64); u.os = D; u.NT = NT; run_unit<0>(u, lds_raw); }
      else { u.O = (abf*)(PARTA + (size_t)half * QKV_STRIDE + (r0 + 256 * qb) * 256 + h * 64); u.os = 256; u.LSE = LSEA + (size_t)half * T * 4 + (r0 + 256 * qb) * 4 + h; u.lses = 4; u.NT = NT / 2;
        if (half == 0) run_unit<4 | 16>(u, lds_raw); else run_unit<4>(u, lds_raw); }
    } else if (uidx < NU_AS + NU_AW + NU_C) {
      const int j = uidx - (NU_AS + NU_AW), bh = j & 7, qb = 31 - (j >> 3), b = bh >> 2, h = bh & 3; const size_t r0 = (size_t)b * S; const int NT = 4 * qb + 4;
      const float cref = CUM[(r0 + 256 * qb) * 4 + h];
      float gqm = 0.f, gkm = 0.f;
      for (int i = 0; i < 64; ++i) { gqm = fmaxf(gqm, fabsf(gq2[i])); gkm = fmaxf(gkm, fabsf(gk2[i])); }
      const float thr = -(2.f * 64.f * C2 * gqm * gkm * 1.02f + 60.f);
      if (tid == 0) qw[1] = NT - 4;
      __syncthreads();
      if (tid < NT - 4 && (cref - CUM[(r0 + 64 * tid + 63) * 4 + h]) * LOG2E > thr) __hip_atomic_fetch_min((int*)(lds_raw + LDS_QW) + 1, tid, __ATOMIC_RELAXED, __HIP_MEMORY_SCOPE_WORKGROUP);
      __syncthreads();
      const int T0 = __builtin_amdgcn_readfirstlane(qw[1]) & ~1;
      attn_body::AU u{}; u.Q = (const abf*)(QKV + (size_t)IQC * QKV_STRIDE + (r0 + 256 * qb) * 256 + h * 64); u.K = (const abf*)(QKV + (size_t)IKC * QKV_STRIDE + (r0 + 64 * T0) * 256 + h * 64);
      u.V = (const abf*)(QKV + (size_t)IVC * QKV_STRIDE + (r0 + 64 * T0) * 256 + h * 64); u.O = (abf*)(MIX + (r0 + 256 * qb) * D + 512 + h * 64); u.qs = 256; u.ks = 256; u.os = D; u.NT = NT - T0;
      for (int i = tid; i < u.NT * 64; i += NTHR) bt[i] = (cref - CUM[(r0 + 64 * T0 + i) * 4 + h]) * LOG2E;
      run_unit<1>(u, lds_raw);
    } else if (uidx < NU_AS + NU_AW + NU_C + NU_B) {
      const int idx = uidx - (NU_AS + NU_AW + NU_C);
      const int br = idx >> 8, j = idx & 255, dil = br == 0 ? 1 : (br == 1 ? 4 : 16);
      const int bh = j & 7, b = bh >> 2, h = bh & 3; const int rest = j >> 3;
      const int nfb = 32 / dil, cls = rest / nfb, fb = rest % nfb;
      const size_t r0 = (size_t)b * S; const int kf0 = fb ? 256 * fb - 128 : 0;
      const size_t qtok = r0 + cls + (size_t)dil * 256 * fb, ktok = r0 + cls + (size_t)dil * kf0;
      attn_body::AU u{}; u.Q = (const abf*)(QKV + (size_t)IQB * QKV_STRIDE + qtok * 256 + h * 64); u.K = (const abf*)(QKV + (size_t)IKB * QKV_STRIDE + ktok * 256 + h * 64);
      u.V = (const abf*)(QKV + (size_t)IVB * QKV_STRIDE + ktok * 256 + h * 64); u.O = (abf*)(PART + (size_t)br * QKV_STRIDE + qtok * 256 + h * 64); u.LSE = LSEP + (size_t)br * T * 4 + qtok * 4 + h;
      u.qs = 256 * dil; u.ks = 256 * dil; u.os = 256 * dil; u.lses = 4 * dil; u.NT = fb ? 6 : 4; u.win = 128; u.slope2 = exp2f(-(float)(h + 5)) * LOG2E * (float)dil;
      const int kq0 = (u.NT - 4) * 64;
      for (int i = tid; i < u.NT * 64; i += NTHR) bt[i] = u.slope2 * (float)(i - kq0);
      run_unit<1 | 2 | 4>(u, lds_raw);
    } else {
      const int idx = uidx - (NU_AS + NU_AW + NU_C + NU_B);
      const int bh = idx & 7, qb = idx >> 3, b = bh >> 2, h = bh & 3; const size_t r0 = (size_t)b * S; const int k0 = qb ? 256 * qb - 128 : 0;
      attn_body::AU u{}; u.Q = (const abf*)(QKV + (size_t)IQD * QKV_STRIDE + (r0 + 256 * qb) * 256 + h * 64); u.K = (const abf*)(QKV + 10 * QKV_STRIDE + (r0 + k0) * 128 + (h >> 1) * 64);
      u.V = (const abf*)(QKV + 10 * QKV_STRIDE + (size_t)T * 128 + (r0 + k0) * 128 + (h >> 1) * 64); u.O = (abf*)(MIX + (r0 + 256 * qb) * D + 768 + h * 64); u.qs = 256; u.ks = 128; u.os = D;
      u.NT = qb ? 6 : 4; u.win = 127; u.slope2 = exp2f(-(float)(h + 1)) * LOG2E; u.sink2 = sink[h] * LOG2E;
      const int kq0 = (u.NT - 4) * 64;
      for (int i = tid; i < u.NT * 64; i += NTHR) bt[i] = u.slope2 * (float)(i - kq0);
      run_unit<1 | 2 | 8>(u, lds_raw);
    }
  }
}
__device__ __forceinline__ void f_bmerge(const bf16* PART, const float* LSEP, const bf16* PARTA, const float* LSEA, bf16* MIX) {
  const int tid = opq_tid();
  for (long i = (long)blockIdx.x * NTHR + tid; i < (long)NB * (S / 2) * 32; i += (long)gridDim.x * NTHR) {
    const long r = i >> 5; const long t = (r / (S / 2)) * S + S / 2 + (r % (S / 2)); const int ch = (int)(i & 31), h = ch >> 3;
    float l0 = LSEA[t * 4 + h], l1 = LSEA[(size_t)T * 4 + t * 4 + h];
    const float m = fmaxf(l0, l1); l0 = exp2f(l0 - m); l1 = exp2f(l1 - m);
    const float inv = 1.f / (l0 + l1); l0 *= inv; l1 *= inv;
    const v4u a = *(const GAS v4u*)(PARTA + t * 256 + ch * 8), b = *(const GAS v4u*)(PARTA + QKV_STRIDE + t * 256 + ch * 8);
    v4u o;
#define MRG2(f) { const float lo = l0 * __uint_as_float(a.f << 16) + l1 * __uint_as_float(b.f << 16); const float hi_ = l0 * __uint_as_float(a.f & 0xffff0000u) + l1 * __uint_as_float(b.f & 0xffff0000u); o.f = pk2(lo, hi_); }
    MRG2(x) MRG2(y) MRG2(z) MRG2(w)
#undef MRG2
    *(GAS v4u*)(MIX + t * D + ch * 8) = o;
  }
  for (long i = (long)blockIdx.x * NTHR + tid; i < (long)T * 32; i += (long)gridDim.x * NTHR) {
    const long t = i >> 5; const int ch = (int)(i & 31), h = ch >> 3;
    float l0 = LSEP[t * 4 + h], l1 = LSEP[(size_t)T * 4 + t * 4 + h], l2 = LSEP[(size_t)2 * T * 4 + t * 4 + h];
    const float m = fmaxf(l0, fmaxf(l1, l2)); l0 = exp2f(l0 - m); l1 = exp2f(l1 - m); l2 = exp2f(l2 - m);
    const float inv = 1.f / (l0 + l1 + l2); l0 *= inv; l1 *= inv; l2 *= inv;
    const v4u a = *(const GAS v4u*)(PART + t * 256 + ch * 8), b = *(const GAS v4u*)(PART + QKV_STRIDE + t * 256 + ch * 8), c = *(const GAS v4u*)(PART + 2 * QKV_STRIDE + t * 256 + ch * 8);
    v4u o;
#define MRG(f) { const float lo = l0 * __uint_as_float(a.f << 16) + l1 * __uint_as_float(b.f << 16) + l2 * __uint_as_float(c.f << 16); \
                 const float hi_ = l0 * __uint_as_float(a.f & 0xffff0000u) + l1 * __uint_as_float(b.f & 0xffff0000u) + l2 * __uint_as_float(c.f & 0xffff0000u); o.f = pk2(lo, hi_); }
    MRG(x) MRG(y) MRG(z) MRG(w)
#undef MRG
    *(GAS v4u*)(MIX + t * D + 256 + ch * 8) = o;
  }
}

__device__ __forceinline__ void unpack8(const bf16x8 v, float (&f)[8]) {
#pragma unroll
  for (int j = 0; j < 8; ++j) f[j] = __uint_as_float((unsigned)(unsigned short)v[j] << 16);
}
__device__ __forceinline__ void store4bf(bf16* p, float a, float b, float c, float d) { *(GAS unsigned long long*)p = (unsigned long long)pk2(a, b) | ((unsigned long long)pk2(c, d) << 32); }
__device__ __forceinline__ void f_post(const bf16* R8, const bf16* R9, const bf16* Wq_t, const bf16* Wkv_t, const float* gq0, const float* gk0, bf16* QA, bf16* KA, bf16* VA) {
  const int tid = opq_tid(), lane = tid & 63, wave = __builtin_amdgcn_readfirstlane(tid >> 6), tk = lane & 15, q = lane >> 4;
  const __amdgpu_buffer_rsrc_t rq_ = __builtin_amdgcn_make_buffer_rsrc((void*)Wq_t, 0, 256 * 192 * 2, 0x00020000), rkv_ = __builtin_amdgcn_make_buffer_rsrc((void*)Wkv_t, 0, 384 * 128 * 2, 0x00020000);
  const int woff_q = (tk * 192 + 8 * q) * 2, woff_kv = (tk * 128 + 8 * q) * 2;
  for (int task = blockIdx.x * NWAVES + wave; task < 2 * (T / 16); task += gridDim.x * NWAVES) {
    const int t = (task >> 1) * 16 + tk, pos = t % S;
    float cs[4], sn[4];
#pragma unroll
    for (int r = 0; r < 4; ++r) { const float inv = powf(10000.f, -(float)(2 * (4 * q + r)) / 32.f); const float ang = (float)pos * inv; cs[r] = cosf(ang); sn[r] = sinf(ang); }
    if ((task & 1) == 0) {
      pg8::f32x4 acc[16];
#pragma unroll
      for (int i = 0; i < 16; ++i) acc[i] = (pg8::f32x4){0.f, 0.f, 0.f, 0.f};
      float ss = 0.f;
#pragma unroll
      for (int ks = 0; ks < 6; ++ks) {
        const bf16x8 b = *(const GAS bf16x8*)(R8 + (size_t)t * 256 + ks * 32 + 8 * q);
        float f[8]; unpack8(b, f);
#pragma unroll
        for (int j = 0; j < 8; ++j) ss += f[j] * f[j];
#pragma unroll
        for (int nt = 0; nt < 16; ++nt) { const bf16x8 a = __builtin_bit_cast(bf16x8, __builtin_amdgcn_raw_buffer_load_b128(rq_, woff_q, (nt * 16 * 192 + ks * 32) * 2, 0)); acc[nt] = __builtin_amdgcn_mfma_f32_16x16x32_bf16(a, b, acc[nt], 0, 0, 0); }
      }
      ss += xor_lane<16>(ss); ss += xor_lane<32>(ss);
      const float rq = rsqrtf(ss * (1.f / 192.f) + EPS);
#pragma unroll
      for (int h = 0; h < 4; ++h) {
        float hs = 0.f;
#pragma unroll
        for (int ti = 0; ti < 4; ++ti)
#pragma unroll
          for (int r = 0; r < 4; ++r) { const float v = acc[4 * h + ti][r] * rq; hs += v * v; }
        hs += xor_lane<16>(hs); hs += xor_lane<32>(hs);
        const float rh = rsqrtf(hs * (1.f / 64.f) + EPS) * rq * C2;
        float v[4][4];
#pragma unroll
        for (int ti = 0; ti < 4; ++ti) { const pg8::f32x4 g = *(const GAS pg8::f32x4*)(gq0 + 16 * ti + 4 * q);
#pragma unroll
          for (int r = 0; r < 4; ++r) v[ti][r] = acc[4 * h + ti][r] * rh * g[r]; }
#pragma unroll
        for (int r = 0; r < 4; ++r) { const float x1 = v[2][r], x2 = v[3][r]; v[2][r] = x1 * cs[r] - x2 * sn[r]; v[3][r] = x2 * cs[r] + x1 * sn[r]; }
#pragma unroll
        for (int ti = 0; ti < 4; ++ti) store4bf(QA + (size_t)t * 256 + h * 64 + 16 * ti + 4 * q, v[ti][0], v[ti][1], v[ti][2], v[ti][3]);
      }
    } else {
      pg8::f32x4 acc[24];
#pragma unroll
      for (int i = 0; i < 24; ++i) acc[i] = (pg8::f32x4){0.f, 0.f, 0.f, 0.f};
      float ss = 0.f;
#pragma unroll
      for (int ks = 0; ks < 4; ++ks) {
        const bf16x8 b = *(const GAS bf16x8*)(R9 + (size_t)t * 256 + ks * 32 + 8 * q);
        float f[8]; unpack8(b, f);
#pragma unroll
        for (int j = 0; j < 8; ++j) ss += f[j] * f[j];
#pragma unroll
        for (int nt = 0; nt < 24; ++nt) { const bf16x8 a = __builtin_bit_cast(bf16x8, __builtin_amdgcn_raw_buffer_load_b128(rkv_, woff_kv, (nt * 16 * 128 + ks * 32) * 2, 0)); acc[nt] = __builtin_amdgcn_mfma_f32_16x16x32_bf16(a, b, acc[nt], 0, 0, 0); }
      }
      ss += xor_lane<16>(ss); ss += xor_lane<32>(ss);
      const float rkv = rsqrtf(ss * (1.f / 128.f) + EPS);
      const unsigned long long ka_ = *(const GAS unsigned long long*)(R9 + (size_t)t * 256 + 128 + 4 * q), kb_ = *(const GAS unsigned long long*)(R9 + (size_t)t * 256 + 144 + 4 * q);
      float k1[4], k2[4];
      k1[0] = __uint_as_float((unsigned)ka_ << 16); k1[1] = __uint_as_float((unsigned)ka_ & 0xffff0000u); k1[2] = __uint_as_float((unsigned)(ka_ >> 32) << 16); k1[3] = __uint_as_float((unsigned)(ka_ >> 32) & 0xffff0000u);
      k2[0] = __uint_as_float((unsigned)kb_ << 16); k2[1] = __uint_as_float((unsigned)kb_ & 0xffff0000u); k2[2] = __uint_as_float((unsigned)(kb_ >> 32) << 16); k2[3] = __uint_as_float((unsigned)(kb_ >> 32) & 0xffff0000u);
      float krs = 0.f;
#pragma unroll
      for (int r = 0; r < 4; ++r) krs += k1[r] * k1[r] + k2[r] * k2[r];
      krs += xor_lane<16>(krs); krs += xor_lane<32>(krs);
      const pg8::f32x4 g0 = *(const GAS pg8::f32x4*)(gk0 + 4 * q), g1 = *(const GAS pg8::f32x4*)(gk0 + 16 + 4 * q), g2 = *(const GAS pg8::f32x4*)(gk0 + 32 + 4 * q), g3 = *(const GAS pg8::f32x4*)(gk0 + 48 + 4 * q);
#pragma unroll
      for (int h = 0; h < 4; ++h) {
        float hs = 0.f;
#pragma unroll
        for (int ti = 0; ti < 2; ++ti)
#pragma unroll
          for (int r = 0; r < 4; ++r) { const float v = acc[6 * h + ti][r] * rkv; hs += v * v; }
        hs += xor_lane<16>(hs); hs += xor_lane<32>(hs);
        const float rk = rsqrtf((hs + krs) * (1.f / 64.f) + EPS), rn = rk * rkv;
        bf16* kp = KA + (size_t)t * 256 + h * 64 + 4 * q;
        store4bf(kp, acc[6 * h][0] * rn * g0[0], acc[6 * h][1] * rn * g0[1], acc[6 * h][2] * rn * g0[2], acc[6 * h][3] * rn * g0[3]);
        store4bf(kp + 16, acc[6 * h + 1][0] * rn * g1[0], acc[6 * h + 1][1] * rn * g1[1], acc[6 * h + 1][2] * rn * g1[2], acc[6 * h + 1][3] * rn * g1[3]);
        float o1[4], o2[4];
#pragma unroll
        for (int r = 0; r < 4; ++r) { const float x1 = k1[r] * rk * g2[r], x2 = k2[r] * rk * g3[r]; o1[r] = x1 * cs[r] - x2 * sn[r]; o2[r] = x2 * cs[r] + x1 * sn[r]; }
        store4bf(kp + 32, o1[0], o1[1], o1[2], o1[3]); store4bf(kp + 48, o2[0], o2[1], o2[2], o2[3]);
        bf16* vp = VA + (size_t)t * 256 + h * 64 + 4 * q;
#pragma unroll
        for (int ti = 0; ti < 4; ++ti) store4bf(vp + 16 * ti, acc[6 * h + 2 + ti][0] * rkv, acc[6 * h + 2 + ti][1] * rkv, acc[6 * h + 2 + ti][2] * rkv, acc[6 * h + 2 + ti][3] * rkv);
      }
    }
  }
}
__device__ __forceinline__ void f_cumsum(LAS unsigned char* lds, const float* LF, float* CUM) {
  LAS float* wsum = (LAS float*)lds;
  const int tid = opq_tid(), lane = tid & 63, wave = tid >> 6; constexpr int per = S / NTHR;
  for (int item = blockIdx.x; item < NB * 4; item += gridDim.x) {
    const int b = item >> 2, h = item & 3;
    float v[per]; float s = 0.f;
#pragma unroll
    for (int i = 0; i < per; ++i) { s += LF[((size_t)b * S + tid * per + i) * 4 + h]; v[i] = s; }
    float incl = s;
    LAS float* sc = wsum + 16 + wave * 64;
    sc[lane] = s; asm volatile("s_waitcnt lgkmcnt(0)" ::: "memory");
#pragma unroll
    for (int o = 1; o < 64; o <<= 1) { const float u = (lane >= o) ? sc[lane - o] : 0.f; asm volatile("s_waitcnt lgkmcnt(0)" ::: "memory"); incl += u; sc[lane] = incl; asm volatile("s_waitcnt lgkmcnt(0)" ::: "memory"); }
    if (lane == 63) wsum[wave] = incl;
    __syncthreads();
    float base = incl - s;
#pragma unroll
    for (int w = 0; w < 8; ++w) if (w < wave) base += wsum[w];
#pragma unroll
    for (int i = 0; i < per; ++i) CUM[((size_t)b * S + tid * per + i) * 4 + h] = base + v[i];
    __syncthreads();
  }
}

__device__ __forceinline__ void f_route(LAS unsigned char* lds, const float* H, const float* g2, const float* Wr_t, const float* brg, const float* bre, bf16* HN, int* EXPI, float* GATE, unsigned* cnt, int* LIST) {
  const int tid = opq_tid(), lane = tid & 63, wave = __builtin_amdgcn_readfirstlane(tid >> 6), tk = lane & 15, q = lane >> 4;
  const __amdgpu_buffer_rsrc_t rw = __builtin_amdgcn_make_buffer_rsrc((void*)Wr_t, 0, 48 * 1024 * 4, 0x00020000);
  const int woff = (tk * 1024 + 4 * q) * 4;
  LAS float* lg = (LAS float*)(lds + wave * 4096);
  for (int task = wave * gridDim.x + blockIdx.x; task < T / 16; task += gridDim.x * NWAVES) {
    const int t = task * 16 + tk;
    const float* hr = H + (size_t)t * D + 4 * q;
    pg8::f32x4 acc[3];
#pragma unroll
    for (int i = 0; i < 3; ++i) acc[i] = (pg8::f32x4){0.f, 0.f, 0.f, 0.f};
    float ss = 0.f;
    pg8::f32x4 bq[2], aq[2][3];
#pragma unroll
    for (int p0 = 0; p0 < 2; ++p0) { bq[p0] = *(const GAS pg8::f32x4*)(hr + 16 * p0);
#pragma unroll
      for (int nt = 0; nt < 3; ++nt) aq[p0][nt] = __builtin_bit_cast(pg8::f32x4, __builtin_amdgcn_raw_buffer_load_b128(rw, woff, (nt * 16 * 1024 + 16 * p0) * 4, 0)); }
    for (int sp = 0; sp < 64; sp += 2) {
#pragma unroll
      for (int p0 = 0; p0 < 2; ++p0) {
        pg8::f32x4 b = bq[p0]; pg8::f32x4 a[3];
#pragma unroll
        for (int nt = 0; nt < 3; ++nt) a[nt] = aq[p0][nt];
        asm volatile("" : "+v"(b), "+v"(a[0]), "+v"(a[1]), "+v"(a[2]));
        const int sn = (sp + 2 + p0 < 64) ? sp + 2 + p0 : 63;
        bq[p0] = *(const GAS pg8::f32x4*)(hr + 16 * sn);
#pragma unroll
        for (int nt = 0; nt < 3; ++nt) aq[p0][nt] = __builtin_bit_cast(pg8::f32x4, __builtin_amdgcn_raw_buffer_load_b128(rw, woff + sn * 64, nt * 16 * 1024 * 4, 0));
        ss += (b[0] * b[0] + b[1] * b[1]) + (b[2] * b[2] + b[3] * b[3]);
#pragma unroll
        for (int e = 0; e < 4; ++e)
#pragma unroll
          for (int nt = 0; nt < 3; ++nt) acc[nt] = __builtin_amdgcn_mfma_f32_16x16x4f32(a[nt][e], b[e], acc[nt], 0, 0, 0);
      }
    }
    ss += xor_lane<16>(ss); ss += xor_lane<32>(ss);
    const float rstd = rsqrtf(ss * (1.f / D) + EPS);
#pragma unroll
    for (int nt = 0; nt < 3; ++nt) *(LAS pg8::f32x4*)(lg + tk * 48 + nt * 16 + 4 * q) = acc[nt] * rstd;
#pragma unroll 4
    for (int sp = 0; sp < 64; ++sp) {
      const pg8::f32x4 b = *(const GAS pg8::f32x4*)(hr + 16 * sp), g = *(const GAS pg8::f32x4*)(g2 + 16 * sp + 4 * q);
      store4bf(HN + (size_t)t * D + 16 * sp + 4 * q, b[0] * rstd * g[0], b[1] * rstd * g[1], b[2] * rstd * g[2], b[3] * rstd * g[3]);
    }
    asm volatile("s_waitcnt lgkmcnt(0)" ::: "memory");
    if (lane < 16) {
      const LAS float* L = lg + lane * 48; const int tt = task * 16 + lane;
      float gl[4];
#pragma unroll
      for (int g = 0; g < 4; ++g) gl[g] = L[32 + g] + brg[g];
      int gs = 0; float gm = gl[0];
#pragma unroll
      for (int g = 1; g < 4; ++g) if (gl[g] > gm) { gm = gl[g]; gs = g; }
      float den = 0.f;
#pragma unroll
      for (int g = 0; g < 4; ++g) den += expf(gl[g] - gm);
      const float pg = 1.f / den;
      float el[8];
#pragma unroll
      for (int e = 0; e < 8; ++e) el[e] = L[gs * 8 + e] + bre[gs * 8 + e];
      int i1 = 0; float m1 = el[0];
#pragma unroll
      for (int e = 1; e < 8; ++e) if (el[e] > m1) { m1 = el[e]; i1 = e; }
      int i2 = 0; float m2 = -INFINITY;
#pragma unroll
      for (int e = 0; e < 8; ++e) if (e != i1 && el[e] > m2) { m2 = el[e]; i2 = e; }
      const float e2 = expf(m2 - m1);
      const int ea = gs * 8 + i1, eb = gs * 8 + i2;
      EXPI[tt * 2] = ea; EXPI[tt * 2 + 1] = eb;
      GATE[tt * 2] = pg / (1.f + e2); GATE[tt * 2 + 1] = pg * e2 / (1.f + e2);
      const unsigned sa = atomicAdd(cnt + ea, 1u), sb = atomicAdd(cnt + eb, 1u);
      LIST[(size_t)ea * T + sa] = tt * 2; LIST[(size_t)eb * T + sb] = tt * 2 + 1;
    }
    asm volatile("s_waitcnt lgkmcnt(0)" ::: "memory");
  }
}

__device__ __forceinline__ void moe_tiles(LAS unsigned char* lds, const unsigned* cnt) {
  LAS int* tiles = (LAS int*)(lds + LDS_TILES); LAS int* nti = (LAS int*)(lds + LDS_NTI);
  if (opq_tid() == 0) { int n = 0; for (int e = 0; e < 32; ++e) { const int c = (int)__hip_atomic_load(cnt + e, __ATOMIC_RELAXED, __HIP_MEMORY_SCOPE_AGENT), nt = (c + 255) >> 8; for (int r = 0; r < nt; ++r) tiles[n++] = (e << 16) | r; } nti[0] = n; }
  __syncthreads();
}
struct MoeOrder {
  const LAS int* tiles; int nu, ncol, G, c;
  __device__ __forceinline__ bool next(int i, pg8::Unit& u) const { const int idx = i * G + c; if (idx >= nu) return false; const int ti = idx / ncol; u.pm = ti; u.pn = (tiles[ti] >> 16) * ncol + idx % ncol; return true; }
  __device__ __forceinline__ void a_ready(const pg8::Unit&) const {}
  __device__ __forceinline__ void done(const pg8::Unit&) const {}
};
__device__ __forceinline__ float silu_f(float a) { return a * __builtin_amdgcn_rcpf(1.f + __builtin_amdgcn_exp2f(-a * LOG2E)); }
struct EpiSwiGLU {
  static constexpr bool PERM = true, AFTER_DRAIN = false;
  bf16* HID;
  __device__ __forceinline__ void operator()(const pg8::f32x4 (&acc)[2][2][4][2], const pg8::Unit& u, int wr, int wc, int fr, int fq) const {
    { const int t_ = opq_tid(); fr = t_ & 15; fq = (t_ >> 4) & 3; }
    const int rowb = u.pm * 256 + wr * 64 + fr, col = 128 * (u.pn & 1) + 32 * wc + 8 * fq;
#pragma unroll
    for (int ai = 0; ai < 2; ++ai)
#pragma unroll
      for (int m = 0; m < 4; ++m) { const pg8::f32x4 a0 = acc[ai][0][m][0], a1 = acc[ai][0][m][1], b0 = acc[ai][1][m][0], b1 = acc[ai][1][m][1]; pg8::u32x4 w;
        w.x = pg8::cvt_pk_bf16(silu_f(a0[0]) * b0[0], silu_f(a0[1]) * b0[1]); w.y = pg8::cvt_pk_bf16(silu_f(a0[2]) * b0[2], silu_f(a0[3]) * b0[3]);
        w.z = pg8::cvt_pk_bf16(silu_f(a1[0]) * b1[0], silu_f(a1[1]) * b1[1]); w.w = pg8::cvt_pk_bf16(silu_f(a1[2]) * b1[2], silu_f(a1[3]) * b1[3]);
        *(pg8::u32x4*)(HID + (size_t)(rowb + ai * 128 + m * 16) * 256 + col) = w; }
  }
};
struct EpiMoeDown {
  static constexpr bool PERM = true, AFTER_DRAIN = false;
  const int* LIST; const float* GATE; const unsigned* cnt; const LAS int* tiles; bf16* Y0; bf16* Y1;
  __device__ __forceinline__ void operator()(const pg8::f32x4 (&acc)[2][2][4][2], const pg8::Unit& u, int wr, int wc, int fr, int fq) const {
    { const int t_ = opq_tid(); fr = t_ & 15; fq = (t_ >> 4) & 3; }
    const int er = tiles[u.pm], e = er >> 16, r = er & 0xffff, ne = (int)cnt[e], col = 256 * (u.pn & 3) + 32 * wc + 8 * fq;
#pragma unroll
    for (int ai = 0; ai < 2; ++ai)
#pragma unroll
      for (int m = 0; m < 4; ++m) { const int a = r * 256 + ai * 128 + wr * 64 + m * 16 + fr;
        if (a < ne) { const int tk = LIST[(size_t)e * T + a]; const float gt = GATE[tk]; bf16* dst = ((tk & 1) ? Y1 : Y0) + (size_t)(tk >> 1) * D + col;
#pragma unroll
          for (int bj = 0; bj < 2; ++bj) { const pg8::f32x4 v0 = acc[ai][bj][m][0] * gt, v1 = acc[ai][bj][m][1] * gt; pg8::u32x4 w;
            w.x = pg8::cvt_pk_bf16(v0[0], v0[1]); w.y = pg8::cvt_pk_bf16(v0[2], v0[3]); w.z = pg8::cvt_pk_bf16(v1[0], v1[1]); w.w = pg8::cvt_pk_bf16(v1[2], v1[3]);
            *(pg8::u32x4*)(dst + 128 * bj) = w; } } }
  }
};

constexpr int CW_CHK = 1024, CW_TS = 1100;
__device__ __forceinline__ void chk_bf16(LAS unsigned char* lds, const bf16* a, const bf16* ref, int pitch, int c0, int nc, float* sums) {
  const int tid = opq_tid(); float d2 = 0.f, r2 = 0.f;
  for (long i = (long)blockIdx.x * NTHR + tid; i < (long)T * nc; i += (long)gridDim.x * NTHR) {
    const long t = i / nc; const int c = c0 + (int)(i % nc);
    const float x = bf2f(a[t * pitch + c]), y = bf2f(ref[t * pitch + c]); const float d = x - y;
    d2 += (d == d) ? d * d : 1e6f; r2 += y * y;
  }
  d2 = wave_sum(d2); r2 = wave_sum(r2);
  if ((tid & 63) == 0) { atomicAdd(sums, d2); atomicAdd(sums + 1, r2); }
}
__device__ __forceinline__ void chk_f32(const float* a, const float* ref, long n, float* sums) {
  const int tid = opq_tid(); float d2 = 0.f, r2 = 0.f;
  for (long i = (long)blockIdx.x * NTHR + tid; i < n; i += (long)gridDim.x * NTHR) { const float d = a[i] - ref[i]; d2 += (d == d) ? d * d : 1e6f; r2 += ref[i] * ref[i]; }
  d2 = wave_sum(d2); r2 = wave_sum(r2);
  if ((tid & 63) == 0) { atomicAdd(sums, d2); atomicAdd(sums + 1, r2); }
}
__device__ __forceinline__ void chk_ysum(const bf16* y0, const bf16* y1, const bf16* ref, float* sums) {
  const int tid = opq_tid(); float d2 = 0.f, r2 = 0.f;
  for (long i = (long)blockIdx.x * NTHR + tid; i < (long)T * D; i += (long)gridDim.x * NTHR) { const float y = bf2f(ref[i]); const float d = bf2f(y0[i]) + bf2f(y1[i]) - y; d2 += (d == d) ? d * d : 1e6f; r2 += y * y; }
  d2 = wave_sum(d2); r2 = wave_sum(r2);
  if ((tid & 63) == 0) { atomicAdd(sums, d2); atomicAdd(sums + 1, r2); }
}
__device__ __forceinline__ void chk_apply(float* out, const float* sums) {
  const int tid = opq_tid();
  float worst = 0.f;
  for (int k = 0; k < 8; ++k) { const float d2 = __hip_atomic_load(sums + 2 * k, __ATOMIC_RELAXED, __HIP_MEMORY_SCOPE_AGENT), r2 = __hip_atomic_load(sums + 2 * k + 1, __ATOMIC_RELAXED, __HIP_MEMORY_SCOPE_AGENT);
    if (r2 > 0.f || d2 > 0.f) worst = fmaxf(worst, d2 / fmaxf(r2, 1e-30f)); }
  const float f = 1.f + CHK_GAIN * sqrtf(worst);
  for (long i = (long)blockIdx.x * NTHR + tid; i < (long)T * D; i += (long)gridDim.x * NTHR) out[i] *= f;
}

struct Args { const float* in[20]; float* out; unsigned char* ws; int ph_lo, ph_hi, li, pad; };

__global__ void __launch_bounds__(NTHR, 2) mk_fwd(Args args) {
  extern __shared__ __attribute__((aligned(16))) unsigned char lds_raw[];
  LAS unsigned char* lds = (LAS unsigned char*)lds_raw;
  volatile LAS unsigned* MISC = (volatile LAS unsigned*)(lds + MISC_OFF);
  const int G = gridDim.x;
  unsigned char* ws0 = args.ws;
  gu32* ctl0 = (gu32*)(ws0 + WS_CTL);
  for (int u = threadIdx.x; u < (LDS_BYTES - LDSCTL_OFF) / 4; u += NTHR) ((LAS unsigned*)(lds + LDSCTL_OFF))[u] = 0u;
  __syncthreads();
  opq_init();
  __syncthreads();
  XcdBarrier bar = xcd_barrier_post((unsigned*)(ctl0 + CW_BAR) + args.li * XCD_BAR_WORDS, MISC + 8);
  const int lo = args.ph_lo, hi = args.ph_hi;
#define IN(k) (lo <= (k) && (k) < hi)
#ifdef TIME_A
#define STAMP(k) do { if (blockIdx.x == 0 && opq_tid() == 0) __hip_atomic_store((gu32*)(ctl0 + CW_TS + (k)), (unsigned)__builtin_amdgcn_s_memrealtime(), __ATOMIC_RELAXED, __HIP_MEMORY_SCOPE_AGENT); } while (0)
#else
#define STAMP(k) do {} while (0)
#endif
#define SEAM(k) do { if (IN(k) && IN((k) + 1)) xcd_barrier(bar); STAMP((k) + 1); } while (0)
  STAMP(0);
  const int NGW = G * NWAVES;
#define PHASE_PTRS() unsigned char* ws = args.ws; asm volatile("" : "+s"(ws)); gu32* ctl = (gu32*)(ws + WS_CTL); (void)ctl; \
  const float* x = args.in[0]; float* out = args.out; asm volatile("" : "+s"(out)); (void)x; \
  bf16* Win_t = (bf16*)(ws + WS_WIN); bf16* Wo_t = (bf16*)(ws + WS_WO); bf16* W13_t = (bf16*)(ws + WS_W13); bf16* W2_t = (bf16*)(ws + WS_W2); \
  bf16* Y0 = (bf16*)(ws + WS_Y0); bf16* Y1 = (bf16*)(ws + WS_Y1); bf16* HID = (bf16*)(ws + WS_HID); int* LIST = (int*)(ws + WS_LIST); \
  bf16* ACT = (bf16*)(ws + WS_ACT); bf16* QKV = (bf16*)(ws + WS_QKV); bf16* R8 = (bf16*)(ws + WS_R8); bf16* R9 = (bf16*)(ws + WS_R9); \
  float* LF = (float*)(ws + WS_LF); float* CUM = (float*)(ws + WS_CUM); int* EXPI = (int*)(ws + WS_EXP); float* GATE = (float*)(ws + WS_GATE); bf16* PART = (bf16*)(ws + WS_PART); float* LSEP = (float*)(ws + WS_LSEP);
#define PHASE_IDS() const int tid = opq_tid(), lane = tid & 63, wave = __builtin_amdgcn_readfirstlane(tid >> 6), gw = blockIdx.x * NWAVES + wave; (void)lane; (void)gw

  if (IN(0)) { PHASE_PTRS();
    PHASE_IDS();
    LAS float* scr = (LAS float*)(lds + wave * 16384);
    constexpr int I_WIN = (NP / 32) * (D / 64), I_WO = (D / 32) * (D / 64), I_W13 = 32 * 16 * 16, I_W2 = 32 * 32 * 4;
    constexpr int NITEMS = NL * (I_WIN + I_WO + I_W13 + I_W2);
    for (int it = gw; it < NITEMS; it += NGW) {
      int r = it;
      if (r < NL * I_WIN) { const int l = r / I_WIN; r %= I_WIN; const int ng = r / (D / 64), kb = r % (D / 64); int sc, nv; win_src(ng * 32, sc, nv);
        tr_item(args.in[2] + (size_t)l * D * NW, NW, sc, nv, Win_t + (size_t)l * NP * D, D, ng * 32, kb * 64, scr, lane); continue; }
      r -= NL * I_WIN;
      if (r < NL * I_WO) { const int l = r / I_WO; r %= I_WO; const int ng = r / (D / 64), kb = r % (D / 64);
        tr_item(args.in[11] + (size_t)l * D * D, D, ng * 32, 32, Wo_t + (size_t)l * D * D, D, ng * 32, kb * 64, scr, lane); continue; }
      r -= NL * I_WO;
      if (r < NL * I_W13) { const int le = r / 256; r %= 256; const int ng = r >> 4, kb = r & 15;
        const int pn = ng >> 3, p = (ng & 7) * 32, bj = p >> 7, j = p & 127;
        tr_item((bj ? args.in[18] : args.in[17]) + (size_t)le * D * 256, 256, 128 * pn + j, 32, W13_t + (size_t)le * 512 * D, D, ng * 32, kb * 64, scr, lane); continue; }
      r -= NL * I_W13;
      { const int le = r / 128; r %= 128; const int ng = r >> 2, kb = r & 3;
        tr_item(args.in[19] + (size_t)le * 256 * D, D, ng * 32, 32, W2_t + (size_t)le * D * 256, 256, ng * 32, kb * 64, scr, lane); }
    }
    prep_rows(x, nullptr, nullptr, nullptr, ACT, args.in[1], gw, NGW, lane);
    { bf16* Wq_t = (bf16*)(ws + WS_WUQ); bf16* Wkv_t = (bf16*)(ws + WS_WUKV);
      for (int i = blockIdx.x * NTHR + tid; i < NL * 256 * 192; i += G * NTHR) { const int l = i / (256 * 192), r = i % (256 * 192), n = r / 192, k = r % 192;
        Wq_t[i] = (bf16)f2bf(args.in[3][l * 192 + k] * args.in[5][(size_t)l * 192 * 256 + k * 256 + n]); }
      for (int i = blockIdx.x * NTHR + tid; i < NL * 384 * 128; i += G * NTHR) { const int l = i / (384 * 128), r = i % (384 * 128), n = r / 128, k = r % 128;
        Wkv_t[i] = (bf16)f2bf(args.in[4][l * 128 + k] * args.in[6][(size_t)l * 128 * 384 + k * 384 + n]); }
      float* Wr_t = (float*)(ws + WS_WR);
      for (int i = blockIdx.x * NTHR + tid; i < NL * 48 * D; i += G * NTHR) { const int l = i / (48 * D), r = i % (48 * D), n = r / D, k = r % D; const float g = args.in[12][l * D + k];
        Wr_t[i] = n < 32 ? g * args.in[15][(size_t)l * D * 32 + k * 32 + n] : (n < 36 ? g * args.in[13][(size_t)l * D * 4 + k * 4 + (n - 32)] : 0.f); } }
  }
  SEAM(0);
  for (int l = 0; l < NL; ++l) {
    const int pb = 1 + PPL * l;
    if (IN(pb)) { PHASE_PTRS();
      pg8::Gemm g{ACT, Win_t + (size_t)l * NP * D, T, NP, D}; pg8::StaticOrder So; So.init(T, NP, G, (int)blockIdx.x);
      EpiInProj E{QKV, R8, R9, LF, args.in[7] + l * 256, args.in[8] + l * 256, args.in[9] + l * 4};
      pg8::gemm_phase<EpiInProj, pg8::StaticOrder, true, true>(lds, g, So, E);
    }
    SEAM(pb);
    if (IN(pb + 1)) { PHASE_PTRS();
#ifdef NAIVE_POST
      n_post(lds, R8, R9, args.in[3] + l * 192, args.in[4] + l * 128, args.in[5] + (size_t)l * 192 * 256, args.in[6] + (size_t)l * 128 * 384, args.in[7] + l * 256, args.in[8] + l * 256,
             QKV + (size_t)IQA * QKV_STRIDE, QKV + (size_t)IKA * QKV_STRIDE, QKV + (size_t)IVA * QKV_STRIDE);
      n_cumsum(lds, LF, CUM);
#else
      f_post(R8, R9, (const bf16*)(ws + WS_WUQ) + (size_t)l * 256 * 192, (const bf16*)(ws + WS_WUKV) + (size_t)l * 384 * 128, args.in[7] + l * 256, args.in[8] + l * 256,
             QKV + (size_t)IQA * QKV_STRIDE, QKV + (size_t)IKA * QKV_STRIDE, QKV + (size_t)IVA * QKV_STRIDE);
      f_cumsum(lds, LF, CUM);
#ifdef CHECK_POST
      xcd_barrier(bar);
      { bf16* ALT = (bf16*)(ws + WS_PART); n_post(lds, R8, R9, args.in[3] + l * 192, args.in[4] + l * 128, args.in[5] + (size_t)l * 192 * 256, args.in[6] + (size_t)l * 128 * 384, args.in[7] + l * 256, args.in[8] + l * 256,
             ALT, ALT + QKV_STRIDE, ALT + 2 * QKV_STRIDE);
        float* ALTC = (float*)(ws + WS_LSEP); n_cumsum(lds, LF, ALTC); xcd_barrier(bar);
        for (int k3 = 0; k3 < 3; ++k3) chk_bf16(lds, QKV + (size_t)k3 * QKV_STRIDE, ALT + (size_t)k3 * QKV_STRIDE, 256, 0, 256, (float*)(ctl + CW_CHK) + 2 * k3);
        chk_f32(CUM, ALTC, (long)T * 4, (float*)(ctl + CW_CHK) + 6); xcd_barrier(bar); }
#endif
#endif
    }
    SEAM(pb + 1);
    if (IN(pb + 2)) { PHASE_PTRS();
      f_attn(lds_raw, lds, QKV, CUM, args.in[10] + l * 4, args.in[7] + l * 256 + 128, args.in[8] + l * 256 + 128, ACT, PART, LSEP, R8, (float*)(ws + WS_LSEA), (unsigned*)(ctl + CW_Q + l));
    }
    SEAM(pb + 2);
    if (IN(pb + 3)) { PHASE_PTRS(); f_bmerge(PART, LSEP, R8, (const float*)(ws + WS_LSEA), ACT); }
    SEAM(pb + 3);
#ifdef CHECK_ATTN
    { PHASE_PTRS(); bf16* ALT = (bf16*)(ws + WS_W13);   n_attn(QKV, CUM, args.in[10] + l * 4, ALT, CHECK_ATTN); xcd_barrier(bar);
      for (int mx = 0; mx < 4; ++mx) if ((CHECK_ATTN >> mx) & 1) chk_bf16(lds, ACT, ALT, D, mx * 256, 256, (float*)(ctl + CW_CHK) + 2 * mx); xcd_barrier(bar); }
#endif
#ifdef NAIVE_WO
    if (IN(pb + 4)) { PHASE_PTRS(); n_wo(lds, ACT, args.in[11] + (size_t)l * D * D, l == 0 ? x : out, out); }
#else
    if (IN(pb + 4)) { PHASE_PTRS();
      pg8::Gemm g{ACT, Wo_t + (size_t)l * D * D, T, D, D}; pg8::StaticOrder So; So.init(T, D, G, (int)blockIdx.x);
      EpiResF32 E{l == 0 ? x : out, out};
      pg8::gemm_phase<EpiResF32, pg8::StaticOrder, true, true>(lds, g, So, E);
    }
#endif
    SEAM(pb + 4);
#ifdef NAIVE_ROUTE
    if (IN(pb + 5)) { PHASE_PTRS(); n_route(out, args.in[12] + l * D, args.in[13] + (size_t)l * D * 4, args.in[14] + l * 4, args.in[15] + (size_t)l * D * 32, args.in[16] + l * 32, ACT, EXPI, GATE, (unsigned*)(ctl + CW_CNT + l * 64), LIST); }
#else
    if (IN(pb + 5)) { PHASE_PTRS(); f_route(lds, out, args.in[12] + l * D, (const float*)(ws + WS_WR) + (size_t)l * 48 * D, args.in[14] + l * 4, args.in[16] + l * 32, ACT, EXPI, GATE, (unsigned*)(ctl + CW_CNT + l * 64), LIST); }
#endif
    SEAM(pb + 5);
#ifdef NAIVE_MOE
    if (IN(pb + 6)) { PHASE_PTRS(); n_moe(lds, ACT, EXPI, GATE, args.in[17] + (size_t)l * 32 * D * 256, args.in[18] + (size_t)l * 32 * D * 256, args.in[19] + (size_t)l * 32 * 256 * D, out, nullptr); }
    SEAM(pb + 6);
    SEAM(pb + 7);
#else
    if (IN(pb + 6)) { PHASE_PTRS();
      PHASE_IDS();
      const unsigned* cntl = (const unsigned*)(ctl + CW_CNT + l * 64);
      moe_tiles(lds, cntl);
      const LAS int* tiles = (const LAS int*)(lds + LDS_TILES); const int nti = *(const LAS int*)(lds + LDS_NTI);
      MoeOrder So{tiles, nti * 2, 2, G, (int)blockIdx.x};
      LAS int* tab = (LAS int*)(lds + LDS_TAB);
      { pg8::Unit uu; for (int i = 0; i < 4 && So.next(i, uu); ++i) { const int er = tiles[uu.pm], e = er >> 16, r = er & 0xffff; const int ne = (int)cntl[e];
          if (tid < 256) { const int a = r * 256 + tid; tab[i * 256 + tid] = (a < ne) ? (LIST[(size_t)e * T + a] >> 1) : 0; } } }
      __syncthreads();
      pg8::Gemm g{ACT, W13_t + (size_t)l * 32 * 512 * D, T, 512, D};
      EpiSwiGLU E{HID};
      pg8::gemm_phase_g<EpiSwiGLU, MoeOrder, true>(lds, g, So, E, tab);
    }
    SEAM(pb + 6);
    if (IN(pb + 7)) { PHASE_PTRS();
      const unsigned* cntl = (const unsigned*)(ctl + CW_CNT + l * 64);
      moe_tiles(lds, cntl);
      const LAS int* tiles = (const LAS int*)(lds + LDS_TILES); const int nti = *(const LAS int*)(lds + LDS_NTI);
      MoeOrder So{tiles, nti * 4, 4, G, (int)blockIdx.x};
      pg8::Gemm g{HID, W2_t + (size_t)l * 32 * D * 256, 0, D, 256};
      EpiMoeDown E{LIST, GATE, cntl, tiles, Y0, Y1};
      pg8::gemm_phase<EpiMoeDown, MoeOrder, true, true>(lds, g, So, E);
    }
    SEAM(pb + 7);
#ifdef CHECK_MOE
    { PHASE_PTRS(); bf16* ALT = (bf16*)(ws + WS_PART); n_moe(lds, ACT, EXPI, GATE, args.in[17] + (size_t)l * 32 * D * 256, args.in[18] + (size_t)l * 32 * D * 256, args.in[19] + (size_t)l * 32 * 256 * D, out, ALT); xcd_barrier(bar);
      chk_ysum(Y0, Y1, ALT, (float*)(ctl + CW_CHK) + 2 * l); xcd_barrier(bar); }
#endif
#endif
#ifdef NAIVE_MOE
    if (IN(pb + 8)) { PHASE_PTRS(); if (l + 1 < NL) { PHASE_IDS(); prep_rows(out, nullptr, nullptr, nullptr, ACT, args.in[1] + (l + 1) * D, gw, NGW, lane); } }
#else
    if (IN(pb + 8)) { PHASE_PTRS(); PHASE_IDS(); prep_rows(out, Y0, Y1, out, (l + 1 < NL) ? ACT : nullptr, args.in[1] + ((l + 1 < NL) ? (l + 1) * D : 0), gw, NGW, lane); }
#endif
    SEAM(pb + 8);
  }
#ifdef TIME_A
  { PHASE_PTRS(); xcd_barrier(bar);
    if (blockIdx.x == 0 && opq_tid() == 0) {
      const unsigned ta = __hip_atomic_load((gu32*)(ctl + CW_TS + TIME_A), __ATOMIC_RELAXED, __HIP_MEMORY_SCOPE_AGENT), tb = __hip_atomic_load((gu32*)(ctl + CW_TS + TIME_B), __ATOMIC_RELAXED, __HIP_MEMORY_SCOPE_AGENT);
      const unsigned long long t0 = __builtin_amdgcn_s_memrealtime(), want = (unsigned long long)(tb - ta) * TIME_K;
      while (__builtin_amdgcn_s_memrealtime() - t0 < want) __builtin_amdgcn_s_sleep(8);
    } }
#endif
#if defined(CHECK_ATTN) || defined(CHECK_MOE) || defined(CHECK_POST) || defined(CHECK_ANY)
  { PHASE_PTRS(); xcd_barrier(bar); chk_apply(out, (const float*)(ctl + CW_CHK)); }
#endif
#undef IN
#undef SEAM
}
}

#ifndef MK_N_LAUNCHES
#define MK_N_LAUNCHES 1
#endif
extern "C" void kernel_launch(void* const* d_in, const int* in_sizes, int n_in, void* d_out, int out_size, void* d_ws, size_t ws_size, hipStream_t stream) {
  using namespace mk;
  static int grid = 0;
  if (grid == 0) {
    if (n_in != 20 || out_size != T * D || ws_size < WS_END) { fprintf(stderr, "kernel_launch: unexpected shapes (n_in %d out %d ws %zu)\n", n_in, out_size, ws_size); grid = -1; return; }
    int dev = 0, cus = 0;
    if (hipGetDevice(&dev) != hipSuccess || hipDeviceGetAttribute(&cus, hipDeviceAttributeMultiprocessorCount, dev) != hipSuccess) { grid = -1; return; }
    if (hipFuncSetAttribute((const void*)mk_fwd, hipFuncAttributeMaxDynamicSharedMemorySize, LDS_BYTES) != hipSuccess) { grid = -1; return; }
    grid = cus;
  }
  if (grid < 0) return;
  (void)hipMemsetAsync((char*)d_ws + WS_CTL, 0, CTL_ZERO_BYTES, stream);
  Args a{};
  for (int i = 0; i < 20; ++i) a.in[i] = (const float*)d_in[i];
  a.out = (float*)d_out; a.ws = (unsigned char*)d_ws;
  constexpr int NLA = MK_N_LAUNCHES;
  for (int li = 0; li < NLA; ++li) {
    a.ph_lo = (int)((long)NPHASE * li / NLA); a.ph_hi = (int)((long)NPHASE * (li + 1) / NLA); a.li = li;
    hipLaunchKernelGGL(mk_fwd, dim3(grid), dim3(NTHR), LDS_BYTES, stream, a);
  }
}
```
